# Optimizing an MI355X kernel written in HIP

```python
import jax
import jax.numpy as jnp
from jax import lax
import numpy as np

D_MODEL = 2048
BATCH = 2
SEQ = 16384
DEPTH = 2

N_META = 16
GRID_W = 64
QBLK = 128
EPS = 1e-6
NEG_INF = -1e30

MLA_HEADS = 8
MLA_NOPE = 128
MLA_ROPE = 64
MLA_V = 128
MLA_Q_LORA = 512
MLA_KV_LORA = 512
ROPE_THETA = 10000.0

NA_HEADS = 8
NA_DIM = 128
NA_KH_MAX = 8
NA_KW = 16

IN_AB = MLA_Q_LORA + MLA_KV_LORA + MLA_ROPE + 3 * NA_HEADS * NA_DIM
MIX_AB = MLA_HEADS * MLA_V + NA_HEADS * NA_DIM

SWA_HEADS = 32
SWA_KV_HEADS = 4
SWA_GROUP = SWA_HEADS // SWA_KV_HEADS
SWA_DIM = 64
SWA_WINDOW = 128
IN_C = (SWA_HEADS + 2 * SWA_KV_HEADS) * SWA_DIM
MIX_C = SWA_HEADS * SWA_DIM

N_EXPERTS = 16
EC_CAPACITY_FACTOR = 2
D_EXPERT = 2048

F32 = jnp.float32

kernel_name = "hybrid_mla_natten_swa_ec_encoder"


def rmsnorm(x, g):
    xf = x.astype(F32)
    y = xf * lax.rsqrt(jnp.mean(xf * xf, axis=-1, keepdims=True) + EPS)
    return (y * g.astype(F32)).astype(x.dtype)


def rope_tables(length, dim):
    inv_freq = 1.0 / (ROPE_THETA ** (jnp.arange(0, dim, 2, dtype=F32) / dim))
    ang = jnp.arange(length, dtype=F32)[:, None] * inv_freq[None, :]
    return jnp.cos(ang), jnp.sin(ang)


def apply_rope(x, cos, sin):
    xf = x.astype(F32)
    x1, x2 = jnp.split(xf, 2, axis=-1)
    return jnp.concatenate([x1 * cos - x2 * sin, x2 * cos + x1 * sin], axis=-1).astype(x.dtype)


def mla_attention(c_q, c_kv, k_rope, q_norm, kv_norm, w_uq, w_ukv):
    B, L, _ = c_q.shape
    q = (rmsnorm(c_q, q_norm) @ w_uq).reshape(B, L, MLA_HEADS, MLA_NOPE + MLA_ROPE)
    kv = (rmsnorm(c_kv, kv_norm) @ w_ukv).reshape(B, L, MLA_HEADS, MLA_NOPE + MLA_V)
    q_nope, q_pe = q[..., :MLA_NOPE], q[..., MLA_NOPE:]
    k_nope, v = kv[..., :MLA_NOPE], kv[..., MLA_NOPE:]
    cos, sin = rope_tables(L, MLA_ROPE)
    q_pe = apply_rope(q_pe, cos[None, :, None, :], sin[None, :, None, :])
    k_pe = apply_rope(k_rope, cos[None], sin[None])
    scale = (MLA_NOPE + MLA_ROPE) ** -0.5

    def attend(qn, qp):
        s = (jnp.einsum("bqhd,bkhd->bhqk", qn, k_nope, preferred_element_type=F32)
             + jnp.einsum("bqhr,bkr->bhqk", qp, k_pe, preferred_element_type=F32)) * scale
        p = jax.nn.softmax(s, axis=-1).astype(v.dtype)
        return jnp.einsum("bhqk,bkhd->bqhd", p, v)

    n = L - N_META
    nb = n // QBLK
    out_meta = attend(q_nope[:, :N_META], q_pe[:, :N_META])
    qn_blk = q_nope[:, N_META:].reshape(B, nb, QBLK, MLA_HEADS, MLA_NOPE).transpose(1, 0, 2, 3, 4)
    qp_blk = q_pe[:, N_META:].reshape(B, nb, QBLK, MLA_HEADS, MLA_ROPE).transpose(1, 0, 2, 3, 4)
    out_real = lax.map(lambda a: attend(a[0], a[1]), (qn_blk, qp_blk))
    out_real = out_real.transpose(1, 0, 2, 3, 4).reshape(B, n, MLA_HEADS, MLA_V)
    return jnp.concatenate([out_meta, out_real], axis=1).reshape(B, L, MLA_HEADS * MLA_V)


def neighbourhood_attention(q, k, v, rpb):
    B, L, H, d = q.shape
    n = L - N_META
    rows = n // GRID_W
    kh = min(NA_KH_MAX, rows)
    scale = d ** -0.5
    qm, km, vm = q[:, :N_META], k[:, :N_META], v[:, :N_META]
    qr, kr, vr = q[:, N_META:], k[:, N_META:], v[:, N_META:]

    s_mm = jnp.einsum("bqhd,bkhd->bhqk", qm, km, preferred_element_type=F32) * scale
    out_meta = jnp.einsum("bhqk,bkhd->bqhd", jax.nn.softmax(s_mm, axis=-1).astype(v.dtype), vm)

    col = jnp.arange(GRID_W)
    col_start = jnp.clip(col - NA_KW // 2, 0, GRID_W - NA_KW)
    key_local = jnp.arange(kh * GRID_W)
    key_row = key_local // GRID_W
    key_col = key_local % GRID_W
    col_ok = (key_col[None, :] >= col_start[:, None]) & (key_col[None, :] < col_start[:, None] + NA_KW)
    dc_idx = jnp.clip(key_col[None, :] - col[:, None], -(NA_KW - 1), NA_KW - 1) + (NA_KW - 1)

    def row_step(r):
        rs = jnp.clip(r - kh // 2, 0, rows - kh)
        q_row = lax.dynamic_slice_in_dim(qr, r * GRID_W, GRID_W, axis=1)
        k_win = lax.dynamic_slice_in_dim(kr, rs * GRID_W, kh * GRID_W, axis=1)
        v_win = lax.dynamic_slice_in_dim(vr, rs * GRID_W, kh * GRID_W, axis=1)
        dr_idx = rs + key_row - r + (NA_KH_MAX - 1)
        bias = rpb[:, dr_idx[None, :], dc_idx].astype(F32)
        s_win = jnp.einsum("bqhd,bkhd->bhqk", q_row, k_win, preferred_element_type=F32) * scale + bias
        s_win = jnp.where(col_ok, s_win, NEG_INF)
        s_met = jnp.einsum("bqhd,bkhd->bhqk", q_row, km, preferred_element_type=F32) * scale
        p = jax.nn.softmax(jnp.concatenate([s_met, s_win], axis=-1), axis=-1).astype(v.dtype)
        return (jnp.einsum("bhqk,bkhd->bqhd", p[..., :N_META], vm)
                + jnp.einsum("bhqk,bkhd->bqhd", p[..., N_META:], v_win))

    out_real = lax.map(row_step, jnp.arange(rows))
    out_real = out_real.transpose(1, 0, 2, 3, 4).reshape(B, n, H, d)
    return jnp.concatenate([out_meta, out_real], axis=1).reshape(B, L, H * d)


def sink_softmax(s, sink):
    col = jnp.broadcast_to(sink[None, :, :, None, None].astype(F32), s.shape[:-1] + (1,))
    return jax.nn.softmax(jnp.concatenate([s, col], axis=-1), axis=-1)[..., :-1]


def window_sink_attention(q, k, v, sinks):
    B, L = q.shape[0], q.shape[1]
    n = L - N_META
    nb = n // QBLK
    scale = SWA_DIM ** -0.5
    slopes = (2.0 ** (-8.0 * jnp.arange(1, SWA_HEADS + 1, dtype=F32) / SWA_HEADS)).reshape(SWA_KV_HEADS, SWA_GROUP)
    sink = sinks.reshape(SWA_KV_HEADS, SWA_GROUP)
    qm, km, vm = q[:, :N_META], k[:, :N_META], v[:, :N_META]
    qr, kr, vr = q[:, N_META:], k[:, N_META:], v[:, N_META:]

    s_mm = jnp.einsum("bqhgd,bshd->bhgqs", qm, km, preferred_element_type=F32) * scale
    s_mf = jnp.einsum("bqhgd,bshd->bhgqs", qm, kr[:, :QBLK], preferred_element_type=F32) * scale
    ok_m = (N_META + jnp.arange(QBLK)[None, :] - jnp.arange(N_META)[:, None]) <= SWA_WINDOW
    s_mf = jnp.where(ok_m, s_mf, NEG_INF)
    p_m = sink_softmax(jnp.concatenate([s_mm, s_mf], axis=-1), sink).astype(v.dtype)
    out_meta = (jnp.einsum("bhgqs,bshd->bqhgd", p_m[..., :N_META], vm)
                + jnp.einsum("bhgqs,bshd->bqhgd", p_m[..., N_META:], vr[:, :QBLK]))

    kp = jnp.pad(kr, ((0, 0), (QBLK, QBLK), (0, 0), (0, 0)))
    vp = jnp.pad(vr, ((0, 0), (QBLK, QBLK), (0, 0), (0, 0)))
    a = jnp.arange(QBLK)
    j = jnp.arange(3 * QBLK)
    dist = jnp.abs(j[None, :] - QBLK - a[:, None])
    alibi = -slopes[:, :, None, None] * dist.astype(F32)

    def blk(i):
        qb = lax.dynamic_slice_in_dim(qr, i * QBLK, QBLK, axis=1)
        kb = lax.dynamic_slice_in_dim(kp, i * QBLK, 3 * QBLK, axis=1)
        vb = lax.dynamic_slice_in_dim(vp, i * QBLK, 3 * QBLK, axis=1)
        key_real = i * QBLK - QBLK + j
        ok = (dist <= SWA_WINDOW) & ((key_real >= 0) & (key_real < n))[None, :]
        s_loc = jnp.einsum("bqhgd,bshd->bhgqs", qb, kb, preferred_element_type=F32) * scale + alibi
        s_loc = jnp.where(ok, s_loc, NEG_INF)
        s_met = jnp.einsum("bqhgd,bshd->bhgqs", qb, km, preferred_element_type=F32) * scale
        p = sink_softmax(jnp.concatenate([s_met, s_loc], axis=-1), sink).astype(v.dtype)
        return (jnp.einsum("bhgqs,bshd->bqhgd", p[..., :N_META], vm)
                + jnp.einsum("bhgqs,bshd->bqhgd", p[..., N_META:], vb))

    out_real = lax.map(blk, jnp.arange(nb))
    out_real = out_real.transpose(1, 0, 2, 3, 4, 5).reshape(B, n, MIX_C)
    return jnp.concatenate([out_meta.reshape(B, N_META, MIX_C), out_real], axis=1)


def expert_choice_ffn(x, w_router, w_gate, w_up, w_down):
    B, L, D = x.shape
    cap = (EC_CAPACITY_FACTOR * L) // N_EXPERTS
    logits = jnp.einsum("bld,de->ble", x, w_router, preferred_element_type=F32)
    aff = jax.nn.softmax(logits, axis=-1)
    gate, idx = lax.top_k(aff.transpose(0, 2, 1), cap)
    xs = jax.vmap(lambda xb, ib: xb[ib])(x, idx)
    h = jax.nn.silu(jnp.einsum("becd,edf->becf", xs, w_gate)) * jnp.einsum("becd,edf->becf", xs, w_up)
    y = jnp.einsum("becf,efd->becd", h, w_down) * gate[..., None].astype(x.dtype)
    return jax.vmap(lambda ib, yb: jnp.zeros((L, D), yb.dtype).at[ib.reshape(-1)].add(yb.reshape(-1, D)))(idx, y)


def even_mixer(u, w_in, q_norm, kv_norm, w_uq, w_ukv, rpb, w_out):
    B, L, _ = u.shape
    z = u @ w_in
    o1 = MLA_Q_LORA
    o2 = o1 + MLA_KV_LORA
    o3 = o2 + MLA_ROPE
    y_mla = mla_attention(z[..., :o1], z[..., o1:o2], z[..., o2:o3], q_norm, kv_norm, w_uq, w_ukv)
    na_qkv = z[..., o3:].reshape(B, L, 3, NA_HEADS, NA_DIM)
    y_na = neighbourhood_attention(na_qkv[:, :, 0], na_qkv[:, :, 1], na_qkv[:, :, 2], rpb)
    return jnp.concatenate([y_mla, y_na], axis=-1) @ w_out


def odd_mixer(u, w_in, sinks, w_out):
    B, L, _ = u.shape
    z = u @ w_in
    kvw = SWA_KV_HEADS * SWA_DIM
    q = z[..., :MIX_C].reshape(B, L, SWA_KV_HEADS, SWA_GROUP, SWA_DIM)
    k = z[..., MIX_C:MIX_C + kvw].reshape(B, L, SWA_KV_HEADS, SWA_DIM)
    v = z[..., MIX_C + kvw:].reshape(B, L, SWA_KV_HEADS, SWA_DIM)
    return window_sink_attention(q, k, v, sinks) @ w_out


def setup_inputs(seed: int = 0) -> dict:
    key = jax.random.key(seed)
    ks = jax.random.split(key, 20)
    n_even = (DEPTH + 1) // 2
    n_odd = DEPTH // 2
    D = D_MODEL

    def w(k, shape, fan_in):
        return jax.random.normal(k, shape, F32) * fan_in ** -0.5

    def gain(k, shape):
        return 1.0 + 0.05 * jax.random.normal(k, shape, F32)

    return {
        "x": jax.random.normal(ks[0], (BATCH, SEQ, D), F32),
        "meta_tokens": jax.random.normal(ks[1], (N_META, D), F32),
        "norm_mix": gain(ks[2], (DEPTH, D)),
        "norm_ffn": gain(ks[3], (DEPTH, D)),
        "norm_final": gain(ks[4], (D,)),
        "ab_w_in": w(ks[5], (n_even, D, IN_AB), D),
        "ab_q_norm": gain(ks[6], (n_even, MLA_Q_LORA)),
        "ab_kv_norm": gain(ks[7], (n_even, MLA_KV_LORA)),
        "ab_w_uq": w(ks[8], (n_even, MLA_Q_LORA, MLA_HEADS * (MLA_NOPE + MLA_ROPE)), MLA_Q_LORA),
        "ab_w_ukv": w(ks[9], (n_even, MLA_KV_LORA, MLA_HEADS * (MLA_NOPE + MLA_V)), MLA_KV_LORA),
        "ab_rpb": 0.1 * jax.random.normal(ks[10], (n_even, NA_HEADS, 2 * NA_KH_MAX - 1, 2 * NA_KW - 1), F32),
        "ab_w_out": w(ks[11], (n_even, MIX_AB, D), MIX_AB),
        "c_w_in": w(ks[12], (n_odd, D, IN_C), D),
        "c_sinks": 0.5 * jax.random.normal(ks[13], (n_odd, SWA_HEADS), F32),
        "c_w_out": w(ks[14], (n_odd, MIX_C, D), MIX_C),
        "ec_w_router": w(ks[15], (DEPTH, D, N_EXPERTS), D),
        "ec_w_gate": w(ks[16], (DEPTH, N_EXPERTS, D, D_EXPERT), D),
        "ec_w_up": w(ks[17], (DEPTH, N_EXPERTS, D, D_EXPERT), D),
        "ec_w_down": w(ks[18], (DEPTH, N_EXPERTS, D_EXPERT, D), D_EXPERT),
    }


def reference(x, meta_tokens, norm_mix, norm_ffn, norm_final,
              ab_w_in, ab_q_norm, ab_kv_norm, ab_w_uq, ab_w_ukv, ab_rpb, ab_w_out,
              c_w_in, c_sinks, c_w_out,
              ec_w_router, ec_w_gate, ec_w_up, ec_w_down):
    B = x.shape[0]
    meta = jnp.broadcast_to(meta_tokens[None].astype(x.dtype), (B, N_META, x.shape[-1]))
    h = jnp.concatenate([meta, x], axis=1)
    for layer in range(DEPTH):
        u = rmsnorm(h, norm_mix[layer])
        if layer % 2 == 0:
            e = layer // 2
            y = even_mixer(u, ab_w_in[e], ab_q_norm[e], ab_kv_norm[e], ab_w_uq[e], ab_w_ukv[e],
                           ab_rpb[e], ab_w_out[e])
        else:
            o = layer // 2
            y = odd_mixer(u, c_w_in[o], c_sinks[o], c_w_out[o])
        h = h + y
        h = h + expert_choice_ffn(rmsnorm(h, norm_ffn[layer]), ec_w_router[layer], ec_w_gate[layer],
                                  ec_w_up[layer], ec_w_down[layer])
    h = rmsnorm(h, norm_final)
    return h[:, N_META:]
```

```cpp
#include <hip/hip_runtime.h>
#include <cstdio>
#include <cstdint>

#define GAS __attribute__((address_space(1)))
#define LAS __attribute__((address_space(3)))
typedef unsigned short bf16;
typedef short bf16x8 __attribute__((ext_vector_type(8)));
typedef short s16x4 __attribute__((ext_vector_type(4)));
typedef float f32x2 __attribute__((ext_vector_type(2)));
typedef float f32x4 __attribute__((ext_vector_type(4)));
typedef float f32x16 __attribute__((ext_vector_type(16)));
typedef unsigned u32x2 __attribute__((ext_vector_type(2)));
typedef unsigned u32x4 __attribute__((ext_vector_type(4)));

constexpr int D = 2048, NBATCH = 2, SEQ = 16384, NMETA = 16, LTOK = 16400, NTOK = 32800, NR = 33024, RMETA = 32768;
constexpr int ZW = 4352, ZQL = 0, ZKVL = 512, ZNAQ = 1024, ZNAK = 2048, ZNAV = 3072, ZKR = 4096;
constexpr int QW = 1536, KCW = 1536, VMW = 1024, Z1W = 2560, AOW = 2048;
constexpr int NE = 16, CAP = 2050, XPE = 4352, XROWS = NE * XPE;
constexpr float EPS = 1e-6f, LOG2E = 1.4426950408889634f;
constexpr float C_MLA = 0.07216878364870322f * LOG2E, C_NA = 0.08838834764831845f * LOG2E, C_SWA = 0.125f * LOG2E;
constexpr int NWAVES = 8, NTHREADS = 512;

constexpr size_t al256(size_t x) { return (x + 255) & ~(size_t)255; }
constexpr size_t WS_CTL = 0, CTL_BYTES = 1u << 20;
constexpr size_t WS_ROPE = WS_CTL + CTL_BYTES;
constexpr size_t WS_RSQ = al256(WS_ROPE + (size_t)LTOK * 32 * 2 * 4);
constexpr size_t WS_RSKV = al256(WS_RSQ + (size_t)NR * 4);
constexpr size_t WS_AFF = al256(WS_RSKV + (size_t)NR * 4);
constexpr size_t WS_TOKSLOT = al256(WS_AFF + (size_t)32 * LTOK * 4);
constexpr size_t WS_SLOTTOK = al256(WS_TOKSLOT + (size_t)32 * LTOK * 4);
constexpr size_t WS_XGATE = al256(WS_SLOTTOK + (size_t)32 * CAP * 4);
constexpr size_t WS_XMAP = al256(WS_XGATE + (size_t)XROWS * 4);
constexpr size_t WS_PART = al256(WS_XMAP + (size_t)XROWS * 4);
constexpr size_t WS_WIN0 = al256(WS_PART + (size_t)2 * 8 * 8 * 16 * 132 * 4);
constexpr size_t WS_WUQ = al256(WS_WIN0 + (size_t)ZW * D * 2);
constexpr size_t WS_WUKV = al256(WS_WUQ + (size_t)1536 * 512 * 2);
constexpr size_t WS_WOUT0 = al256(WS_WUKV + (size_t)2048 * 512 * 2);
constexpr size_t WS_WIN1 = al256(WS_WOUT0 + (size_t)D * D * 2);
constexpr size_t WS_WOUT1 = al256(WS_WIN1 + (size_t)Z1W * D * 2);
constexpr size_t WS_WGU = al256(WS_WOUT1 + (size_t)D * D * 2);
constexpr size_t WS_WD = al256(WS_WGU + (size_t)NE * 4096 * D * 2);
constexpr size_t WS_H = al256(WS_WD + (size_t)NE * D * D * 2);
constexpr size_t WS_RSF = al256(WS_H + (size_t)NR * D * 2);
constexpr size_t WS_XRS = al256(WS_RSF + (size_t)NR * 4);
constexpr size_t WS_RSM = al256(WS_XRS + (size_t)XROWS * 4);
static_assert(WS_RSM + (size_t)NR * 4 <= WS_H + (size_t)NR * D * 4, "h region");
constexpr size_t WS_U = al256(WS_H + (size_t)NR * D * 4);
constexpr size_t WS_R = al256(WS_U + (size_t)NR * D * 2);
constexpr size_t WS_Z = WS_R;
constexpr size_t WS_Q = al256(WS_Z + (size_t)NR * ZW * 2);
constexpr size_t WS_KC = al256(WS_Q + (size_t)NR * QW * 2);
constexpr size_t WS_VM = al256(WS_KC + (size_t)NR * KCW * 2);
constexpr size_t WS_AO = al256(WS_VM + (size_t)NR * VMW * 2);
constexpr size_t WS_END_ATT = al256(WS_AO + (size_t)NR * AOW * 2);
constexpr size_t WS_XS = WS_R;
constexpr size_t WS_HMID = al256(WS_XS + (size_t)XROWS * D * 2);
constexpr size_t WS_END_MOE = al256(WS_HMID + (size_t)XROWS * D * 2);
constexpr size_t WS_END = WS_END_ATT > WS_END_MOE ? WS_END_ATT : WS_END_MOE;
static_assert(WS_END < (size_t)2000 * 1024 * 1024, "workspace map must fit 2 GiB with margin");

constexpr int CW_BAR = 4096, CW_TICKET = 65536;

constexpr int LDS_BYTES = 147456;
constexpr int MISC_OFF = 147456 - 256;

__device__ __forceinline__ unsigned f2bf(float f) { unsigned u = __builtin_bit_cast(unsigned, f); return (u + 0x7fffu + ((u >> 16) & 1u)) >> 16; }
__device__ __forceinline__ unsigned pk2(float lo, float hi) { return f2bf(lo) | (f2bf(hi) << 16); }
__device__ __forceinline__ float bf2f(unsigned short x) { return __builtin_bit_cast(float, (unsigned)x << 16); }
__device__ __forceinline__ float bflo(unsigned w) { return __builtin_bit_cast(float, w << 16); }
__device__ __forceinline__ float bfhi(unsigned w) { return __builtin_bit_cast(float, w & 0xffff0000u); }
__device__ __forceinline__ float wave_sum(float v) {
#pragma unroll
    for (int o = 1; o < 64; o <<= 1) v += __shfl_xor(v, o);
    return v;
}
#define LDS_WAIT() asm volatile("s_waitcnt lgkmcnt(0)" ::: "memory")

#define XB_TMO      128
#define XB_XCNT(j)  (256  + 64 * (j))
#define XB_XSUB(j)  (1280 + 64 * (j))
#define XB_XGEN(j)  (2304 + 64 * (j))
#define XB_TOP      3328
#define XB_TOPGEN   3392
#define XCD_BAR_WORDS 3456
#define XB_SPIN_CAP (1u << 22)

__device__ __forceinline__ unsigned xb_ld(unsigned* p)              { return __hip_atomic_load(p, __ATOMIC_RELAXED, __HIP_MEMORY_SCOPE_AGENT); }
__device__ __forceinline__ unsigned xb_add(unsigned* p, unsigned v) { return __hip_atomic_fetch_add(p, v, __ATOMIC_RELAXED, __HIP_MEMORY_SCOPE_AGENT); }
__device__ __forceinline__ unsigned xb_xcc_id() { return (unsigned)__builtin_amdgcn_readfirstlane((int)((unsigned)__builtin_amdgcn_s_getreg((3 << 11) | 20) & 0xFu)); }
#define XB_SPIN(cond, bar) do { unsigned _sp = 0; while (cond) { __builtin_amdgcn_s_sleep(1); \
    if ((++_sp & 255u) == 0u) { if (xb_ld(&(bar)[XB_TMO])) break; if (_sp > XB_SPIN_CAP) { atomicAdd(&(bar)[XB_TMO], 1u); break; } } } } while (0)

struct XcdBarrier { unsigned* bar; unsigned x; volatile LAS unsigned* st; };

__device__ __forceinline__ XcdBarrier xcd_barrier_post(unsigned* bar, volatile LAS unsigned* st) {
    XcdBarrier b; b.bar = bar; b.x = xb_xcc_id(); b.st = st;
    if (threadIdx.x == 0) (void)xb_add(&bar[XB_XCNT(b.x)], 1u);
    return b;
}
__device__ __forceinline__ void xcd_barrier_complete(unsigned* bar, unsigned x, unsigned& nloc, unsigned& nx) {
    const unsigned G = gridDim.x * gridDim.y * gridDim.z;
    unsigned sum, cnt, mine, sp = 0u;
    for (;;) {
        sum = 0u; cnt = 0u; mine = 0u;
#pragma unroll
        for (unsigned j = 0; j < 16; ++j) { const unsigned c = xb_ld(&bar[XB_XCNT(j)]); sum += c; cnt += (c > 0u) ? 1u : 0u; mine = (j == x) ? c : mine; }
        if (sum == G) break;
        __builtin_amdgcn_s_sleep(1);
        if ((++sp & 255u) == 0u) { if (xb_ld(&bar[XB_TMO])) break; if (sp > XB_SPIN_CAP) { atomicAdd(&bar[XB_TMO], 1u); break; } }
    }
    nloc = mine > 0u ? mine : 1u; nx = cnt > 0u ? cnt : 1u;
}
__device__ __forceinline__ void xcd_barrier(const XcdBarrier& b) {
    asm volatile("s_waitcnt vmcnt(0)" ::: "memory");
    __syncthreads();
    if (threadIdx.x == 0) {
        unsigned* bar = b.bar; asm volatile("" : "+s"(bar));
        __builtin_amdgcn_s_waitcnt(0);
        const unsigned bx_ = xb_xcc_id();
        unsigned nloc = b.st[0], nx = b.st[1];
        if (nloc == 0u) { xcd_barrier_complete(bar, bx_, nloc, nx); b.st[0] = nloc; b.st[1] = nx; }
        const unsigned old = xb_add(&bar[XB_XSUB(bx_)], 1u);
        const unsigned gen = old / nloc;
        if (old + 1u == (gen + 1u) * nloc) {
            __builtin_amdgcn_fence(__ATOMIC_RELEASE, "agent");
            asm volatile("s_waitcnt vmcnt(0)" ::: "memory");
            const unsigned og = xb_add(&bar[XB_TOP], 1u);
            const unsigned tg = og / nx;
            if (og + 1u == (tg + 1u) * nx) xb_add(&bar[XB_TOPGEN], 1u);
            else XB_SPIN(xb_ld(&bar[XB_TOPGEN]) == tg, bar);
            __builtin_amdgcn_fence(__ATOMIC_ACQUIRE, "agent");
            xb_add(&bar[XB_XGEN(bx_)], 1u);
            asm volatile("s_waitcnt vmcnt(0)" ::: "memory");
        } else {
            XB_SPIN(xb_ld(&bar[XB_XGEN(bx_)]) == gen, bar);
            __builtin_amdgcn_fence(__ATOMIC_ACQUIRE, "agent");
            asm volatile("s_waitcnt vmcnt(0)" ::: "memory");
        }
    }
    __syncthreads();
}

namespace pg8 {
constexpr int BM = 256, BK = 64, HALF = 128, HTB = HALF * BK * 2, STAGE_BYTES = 8 * HTB, NXCD = 8, WGM = 8;
__host__ __device__ __forceinline__ int lds_byte(int r, int c) { const int st = (r >> 4) * 2 + (c >> 5), rr = r & 15, cc = c & 31, ob = rr * 64 + cc * 2; return st * 1024 + (ob ^ (((ob >> 9) & 1) << 5)); }
__host__ __device__ __forceinline__ void stage_rc(int b, int& R, int& C) { const int st = b / 1024, sb = b % 1024, swz = sb ^ (((sb >> 9) & 1) << 5); R = (st >> 1) * 16 + swz / 64; C = (st & 1) * 32 + (swz % 64) / 2; }
__host__ __device__ __forceinline__ int perm32(int rho) { const int n = rho >> 4, i = rho & 15; return 8 * (i >> 2) + 4 * n + (i & 3); }

struct Unit { int pm, pn, pb; };
struct Gemm { const bf16* A; const bf16* Bt; int lda, ldb, K; const int* amap; };

struct TileOrder {
    int nM, nN, nwg, G, c, grp;
    __device__ void init(int nM_, int nN_, int G_, int c_, int grp_) { nM = nM_; nN = nN_; nwg = nM * nN; G = G_; c = c_; grp = grp_; }
    __device__ bool next(int i, Unit& u) const {
        const long L = (long)i * G + c; if (L >= nwg) return false;
        int wgid = (int)L; { const int q = nwg / NXCD, r = nwg % NXCD, xcd = wgid % NXCD, off = wgid / NXCD; wgid = (xcd < r ? xcd * (q + 1) : r * (q + 1) + (xcd - r) * q) + off; }
        const int nig = WGM * nN, gid = wgid / nig, fm = gid * WGM, gsz = (nM - fm) < WGM ? (nM - fm) : WGM;
        u.pm = fm + ((wgid % nig) % gsz); u.pn = (wgid % nig) / gsz; u.pb = grp ? (u.pm / grp) * nN + u.pn : u.pn; return true;
    }
};

__device__ __forceinline__ unsigned cvt_pk_bf16(float lo, float hi) { unsigned r; asm volatile("v_cvt_pk_bf16_f32 %0, %1, %2" : "=v"(r) : "v"(lo), "v"(hi)); return r; }

struct EpiBf16S {
    static constexpr bool PERM = true;
    bf16* O; int ldc; const float* rowscale; int cs_lo, cs_hi; float cscale;
    __device__ __forceinline__ void operator()(const f32x4 (&acc)[2][2][4][2], const Unit& u, int wr, int wc, int fr, int fq) const {
        const int row0 = u.pm * BM + wr * 64 + fr, col0 = u.pn * BM + wc * 32 + 8 * fq;
        const float cs = (u.pn >= cs_lo && u.pn < cs_hi) ? cscale : 1.f;
#pragma unroll
        for (int ai = 0; ai < 2; ++ai)
#pragma unroll
            for (int m = 0; m < 4; ++m) { const int row = row0 + ai * HALF + m * 16; const float s = (rowscale ? rowscale[row] : 1.f) * cs; bf16* rowp = O + (size_t)row * ldc + col0;
#pragma unroll
                for (int bj = 0; bj < 2; ++bj) { const f32x4 v0 = acc[ai][bj][m][0] * s, v1 = acc[ai][bj][m][1] * s;
                    u32x4 w; w.x = cvt_pk_bf16(v0[0], v0[1]); w.y = cvt_pk_bf16(v0[2], v0[3]); w.z = cvt_pk_bf16(v1[0], v1[1]); w.w = cvt_pk_bf16(v1[2], v1[3]);
                    *(u32x4*)(rowp + bj * HALF) = w; } }
    }
};
struct EpiKV {
    static constexpr bool PERM = true;
    bf16* Kc; bf16* Vm; const float* rowscale;
    __device__ __forceinline__ void operator()(const f32x4 (&acc)[2][2][4][2], const Unit& u, int wr, int wc, int fr, int fq) const {
        const int row0 = u.pm * BM + wr * 64 + fr, cc = wc * 32 + 8 * fq;
#pragma unroll
        for (int ai = 0; ai < 2; ++ai)
#pragma unroll
            for (int m = 0; m < 4; ++m) { const int row = row0 + ai * HALF + m * 16; const float s = rowscale[row];
#pragma unroll
                for (int bj = 0; bj < 2; ++bj) { const f32x4 v0 = acc[ai][bj][m][0] * s, v1 = acc[ai][bj][m][1] * s;
                    u32x4 w; w.x = cvt_pk_bf16(v0[0], v0[1]); w.y = cvt_pk_bf16(v0[2], v0[3]); w.z = cvt_pk_bf16(v1[0], v1[1]); w.w = cvt_pk_bf16(v1[2], v1[3]);
                    bf16* p = bj == 0 ? Kc + (size_t)row * KCW + u.pn * 192 + cc : Vm + (size_t)row * VMW + u.pn * 128 + cc;
                    *(u32x4*)p = w; } }
    }
};
struct EpiResid {
    static constexpr bool PERM = true;
    bf16* Hm; int ldc; const float* X; const float* Mt;
    __device__ __forceinline__ void operator()(const f32x4 (&acc)[2][2][4][2], const Unit& u, int wr, int wc, int fr, int fq) const {
        const int row0 = u.pm * BM + wr * 64 + fr, col0 = u.pn * BM + wc * 32 + 8 * fq;
#pragma unroll
        for (int ai = 0; ai < 2; ++ai)
#pragma unroll
            for (int m = 0; m < 4; ++m) { const int row = row0 + ai * HALF + m * 16; bf16* rowp = Hm + (size_t)row * ldc + col0;
                if (X) {
                    const float* sp = (row < RMETA ? X + (size_t)row * ldc : Mt + (size_t)((row - RMETA) & 15) * ldc) + col0; const float z = row < NTOK ? 1.f : 0.f;
#pragma unroll
                    for (int bj = 0; bj < 2; ++bj) { const f32x4 v0 = *(const f32x4*)(sp + bj * HALF) * z + acc[ai][bj][m][0], v1 = *(const f32x4*)(sp + bj * HALF + 4) * z + acc[ai][bj][m][1];
                        u32x4 w; w.x = cvt_pk_bf16(v0[0], v0[1]); w.y = cvt_pk_bf16(v0[2], v0[3]); w.z = cvt_pk_bf16(v1[0], v1[1]); w.w = cvt_pk_bf16(v1[2], v1[3]);
                        *(u32x4*)(rowp + bj * HALF) = w; }
                } else {
#pragma unroll
                    for (int bj = 0; bj < 2; ++bj) { const u32x4 s = *(const u32x4*)(rowp + bj * HALF);
                        const f32x4 v0 = (f32x4){bflo(s.x), bfhi(s.x), bflo(s.y), bfhi(s.y)} + acc[ai][bj][m][0], v1 = (f32x4){bflo(s.z), bfhi(s.z), bflo(s.w), bfhi(s.w)} + acc[ai][bj][m][1];
                        u32x4 w; w.x = cvt_pk_bf16(v0[0], v0[1]); w.y = cvt_pk_bf16(v0[2], v0[3]); w.z = cvt_pk_bf16(v1[0], v1[1]); w.w = cvt_pk_bf16(v1[2], v1[3]);
                        *(u32x4*)(rowp + bj * HALF) = w; }
                }
            }
    }
};
struct EpiSwiGLU {
    static constexpr bool PERM = true;
    bf16* O; int ldc; const float* rowscale;
    __device__ __forceinline__ void operator()(const f32x4 (&acc)[2][2][4][2], const Unit& u, int wr, int wc, int fr, int fq) const {
        const int row0 = u.pm * BM + wr * 64 + fr, col0 = u.pn * HALF + wc * 32 + 8 * fq;
#pragma unroll
        for (int ai = 0; ai < 2; ++ai)
#pragma unroll
            for (int m = 0; m < 4; ++m) { const int row = row0 + ai * HALF + m * 16; bf16* rowp = O + (size_t)row * ldc + col0; float r[8]; const float rs = rowscale[row];
#pragma unroll
                for (int n = 0; n < 2; ++n)
#pragma unroll
                    for (int j = 0; j < 4; ++j) { const float g = acc[ai][0][m][n][j] * rs, up = acc[ai][1][m][n][j] * rs;
                        const float sg = g * __builtin_amdgcn_rcpf(1.f + __builtin_amdgcn_exp2f(-g * LOG2E)); r[n * 4 + j] = sg * up; }
                u32x4 w; w.x = cvt_pk_bf16(r[0], r[1]); w.y = cvt_pk_bf16(r[2], r[3]); w.z = cvt_pk_bf16(r[4], r[5]); w.w = cvt_pk_bf16(r[6], r[7]);
                *(u32x4*)rowp = w; }
    }
};

template <bool GATHER = false, class Epi, class Sched>
__device__ __forceinline__ void gemm_phase(LAS unsigned char* lds, const Gemm g, const Sched& S, const Epi& E) {
    int tid_ = threadIdx.x; asm volatile("" : "+v"(tid_));
    const int tid = tid_, wid = __builtin_amdgcn_readfirstlane(tid >> 6), lane = tid & 63, wr = wid >> 2, wc = wid & 3, fr = lane & 15, fq = lane >> 4;
    const int K = g.K, nt = K / BK;
    unsigned voffA[2], voffB[2];
#pragma unroll
    for (int i = 0; i < 2; ++i) { int R, C; stage_rc(tid * 16 + i * 8192, R, C); const int Rb = Epi::PERM ? ((R & ~31) + perm32(R & 31)) : R;
        voffA[i] = (unsigned)(R * g.lda + C) * 2u; voffB[i] = (unsigned)(Rb * g.ldb + C) * 2u; }
    int RA[2], CA[2];
#pragma unroll
    for (int i = 0; i < 2; ++i) stage_rc(tid * 16 + i * 8192, RA[i], CA[i]);
    unsigned offC[2][2], offN[2][2]; int rawN[2][2];
#define PG8_GRAW(pm_) do { _Pragma("unroll") for (int h_ = 0; h_ < 2; ++h_) _Pragma("unroll") for (int i_ = 0; i_ < 2; ++i_) rawN[h_][i_] = g.amap[(pm_) * BM + h_ * HALF + RA[i_]]; } while (0)
#define PG8_GCONV(dst) do { _Pragma("unroll") for (int h_ = 0; h_ < 2; ++h_) _Pragma("unroll") for (int i_ = 0; i_ < 2; ++i_) dst[h_][i_] = (unsigned)(rawN[h_][i_] * g.lda + CA[i_]) * 2u; } while (0)
    const size_t kstep = (size_t)(BK * 2);
    const size_t hstepA = (size_t)HALF * g.lda * 2, hstepB = (size_t)HALF * g.ldb * 2;
    const size_t tstepA = 2 * hstepA, tstepB = 2 * hstepB;
    const unsigned ldsw = (unsigned)wid * 1024u;
    const int aoff = lds_byte(wr * 64 + fr, fq * 8), boff = lds_byte(wc * 32 + fr, fq * 8);
#define PG8_SA(b, h) (((b) * 2 + (h)) * HTB)
#define PG8_SB(b, h) ((4 + (b) * 2 + (h)) * HTB)
#define PG8_STAGE(bufoff, gbase, voff) do { _Pragma("unroll") for (int _i = 0; _i < 2; ++_i) \
        __builtin_amdgcn_global_load_lds((const unsigned*)((const char*)(gbase) + (voff)[_i]), (LAS unsigned*)(lds + (bufoff) + ldsw + _i * 8192), 16, 0, 0); } while (0)
#define PG8_LDA(dst, b, h) do { _Pragma("unroll") for (int m = 0; m < 4; ++m) _Pragma("unroll") for (int k = 0; k < 2; ++k) dst[m][k] = *(const LAS bf16x8*)(lds + PG8_SA(b, h) + aoff + m * 2048 + k * 1024); } while (0)
#define PG8_LDB(dst, b, h) do { _Pragma("unroll") for (int n = 0; n < 2; ++n) _Pragma("unroll") for (int k = 0; k < 2; ++k) dst[n][k] = *(const LAS bf16x8*)(lds + PG8_SB(b, h) + boff + n * 2048 + k * 1024); } while (0)
#define PG8_MMA(ai, bj, At, Bt) do { __builtin_amdgcn_s_setprio(1); _Pragma("unroll") for (int m = 0; m < 4; ++m) _Pragma("unroll") for (int n = 0; n < 2; ++n) _Pragma("unroll") for (int k = 0; k < 2; ++k) \
        acc[ai][bj][m][n] = __builtin_amdgcn_mfma_f32_16x16x32_bf16(Bt[n][k], At[m][k], acc[ai][bj][m][n], 0, 0, 0); __builtin_amdgcn_s_setprio(0); } while (0)
#define PG8_WAIT_V(n) asm volatile("s_waitcnt vmcnt(" #n ")" ::: "memory")
#define PG8_WAIT_L(n) asm volatile("s_waitcnt lgkmcnt(" #n ")" ::: "memory")
#define PG8_BAR __builtin_amdgcn_s_barrier()
#define PG8_SCHED __builtin_amdgcn_sched_barrier(0)
    Unit cur, nxt; int ui = 0;
    if (!S.next(0, cur)) return;
    f32x4 acc[2][2][4][2];
#pragma unroll
    for (int a = 0; a < 2; ++a)
#pragma unroll
        for (int b = 0; b < 2; ++b)
#pragma unroll
            for (int m = 0; m < 4; ++m)
#pragma unroll
                for (int n = 0; n < 2; ++n) acc[a][b][m][n] = (f32x4){0.f, 0.f, 0.f, 0.f};
    bf16x8 At[4][2], B0[2][2], B1[2][2];
    const char* cA = GATHER ? (const char*)g.A : (const char*)g.A + (size_t)cur.pm * tstepA; const char* cB = (const char*)g.Bt + (size_t)cur.pb * tstepB;
    if constexpr (GATHER) { PG8_GRAW(cur.pm); PG8_GCONV(offC); }
#define PG8_STAGE_A(bufoff, kbase, h_, offs) do { if constexpr (GATHER) { PG8_STAGE(bufoff, kbase, offs[h_]); } else { PG8_STAGE(bufoff, (kbase) + (h_) * hstepA, voffA); } } while (0)
    PG8_STAGE(PG8_SB(0, 0), cB, voffB); PG8_STAGE(PG8_SB(0, 1), cB + hstepB, voffB); PG8_STAGE_A(PG8_SA(0, 0), cA, 0, offC); PG8_STAGE_A(PG8_SA(0, 1), cA, 1, offC);
    if (wr == 1) PG8_BAR;
    PG8_WAIT_V(2); PG8_BAR;
    PG8_STAGE(PG8_SB(1, 0), cB + kstep, voffB); PG8_STAGE_A(PG8_SA(1, 0), cA + kstep, 0, offC); PG8_STAGE(PG8_SB(1, 1), cB + hstepB + kstep, voffB);
    PG8_WAIT_V(6); PG8_BAR;
    for (;;) {
        const bool has_next = S.next(ui + 1, nxt);
        const char* nA = GATHER ? cA : (has_next ? (const char*)g.A + (size_t)nxt.pm * tstepA : cA); const char* nB = has_next ? (const char*)g.Bt + (size_t)nxt.pb * tstepB : cB;
        if constexpr (GATHER) { if (has_next) PG8_GRAW(nxt.pm); }
        for (int t = 0; t < nt; t += 2) {
            const bool last = (t == nt - 2);
            const char* a1 = cA + (size_t)(t + 1) * kstep;
            const char* a2 = last ? nA : cA + (size_t)(t + 2) * kstep; const char* b2 = last ? nB : cB + (size_t)(t + 2) * kstep;
            unsigned off2[2][2];
            if constexpr (GATHER) { if (last && has_next) { PG8_GCONV(offN); } else if (last) { _Pragma("unroll") for (int h_ = 0; h_ < 2; ++h_) _Pragma("unroll") for (int i_ = 0; i_ < 2; ++i_) offN[h_][i_] = offC[h_][i_]; }
                _Pragma("unroll") for (int h_ = 0; h_ < 2; ++h_) _Pragma("unroll") for (int i_ = 0; i_ < 2; ++i_) off2[h_][i_] = last ? offN[h_][i_] : offC[h_][i_]; }
            const char* a3 = a2 + kstep; const char* b3 = b2 + kstep;
            PG8_LDB(B0, 0, 0); PG8_LDB(B1, 0, 1); PG8_SCHED; PG8_LDA(At, 0, 0); PG8_STAGE_A(PG8_SA(1, 1), a1, 1, offC);
            PG8_WAIT_V(8); PG8_WAIT_L(0); PG8_BAR; PG8_MMA(0, 0, At, B0); PG8_MMA(0, 1, At, B1); PG8_BAR; PG8_SCHED;
            PG8_LDA(At, 0, 1); PG8_STAGE(PG8_SB(0, 0), b2, voffB); PG8_STAGE(PG8_SB(0, 1), b2 + hstepB, voffB); PG8_STAGE_A(PG8_SA(0, 0), a2, 0, off2);
            PG8_WAIT_V(8); PG8_WAIT_L(0); PG8_BAR; PG8_MMA(1, 0, At, B0); PG8_MMA(1, 1, At, B1); PG8_BAR; PG8_SCHED;
            PG8_LDB(B0, 1, 0); PG8_LDB(B1, 1, 1); PG8_SCHED; PG8_LDA(At, 1, 0); PG8_STAGE_A(PG8_SA(0, 1), a2, 1, off2);
            PG8_WAIT_V(8); PG8_WAIT_L(0); PG8_BAR; PG8_MMA(0, 0, At, B0); PG8_MMA(0, 1, At, B1); PG8_BAR; PG8_SCHED;
            PG8_LDA(At, 1, 1); PG8_STAGE(PG8_SB(1, 0), b3, voffB); PG8_STAGE(PG8_SB(1, 1), b3 + hstepB, voffB); PG8_STAGE_A(PG8_SA(1, 0), a3, 0, off2);
            PG8_WAIT_V(8); PG8_WAIT_L(0); PG8_BAR; PG8_MMA(1, 0, At, B0); PG8_MMA(1, 1, At, B1); PG8_BAR; PG8_SCHED;
        }
        if (wr == 0) PG8_BAR;
        E(acc, cur, wr, wc, fr, fq);
        if (!has_next) break;
#pragma unroll
        for (int a = 0; a < 2; ++a)
#pragma unroll
            for (int b = 0; b < 2; ++b)
#pragma unroll
                for (int m = 0; m < 4; ++m)
#pragma unroll
                    for (int n = 0; n < 2; ++n) acc[a][b][m][n] = (f32x4){0.f, 0.f, 0.f, 0.f};
        cur = nxt; cA = nA; cB = nB; ++ui;
        if constexpr (GATHER) { _Pragma("unroll") for (int h_ = 0; h_ < 2; ++h_) _Pragma("unroll") for (int i_ = 0; i_ < 2; ++i_) offC[h_][i_] = offN[h_][i_]; }
        if (wr == 1) PG8_BAR;
    }
    PG8_WAIT_V(0);
    PG8_BAR;
#undef PG8_SA
#undef PG8_SB
#undef PG8_STAGE
#undef PG8_STAGE_A
#undef PG8_GRAW
#undef PG8_GCONV
#undef PG8_LDA
#undef PG8_LDB
#undef PG8_MMA
#undef PG8_WAIT_V
#undef PG8_WAIT_L
#undef PG8_BAR
#undef PG8_SCHED
}
}

namespace att {
#define SBAR() __builtin_amdgcn_sched_barrier(0)
constexpr float NEGBIG = -1e30f, THR = 8.f;
__device__ __forceinline__ int crow(int r, int hi) { return (r & 3) + 8 * (r >> 2) + 4 * hi; }
typedef __bf16 bf16x2_t __attribute__((ext_vector_type(2)));
__device__ __forceinline__ unsigned cvtpk(float lo, float hi) { f32x2 v = {lo, hi}; bf16x2_t b = __builtin_convertvector(v, bf16x2_t); return __builtin_bit_cast(unsigned, b); }

__device__ __forceinline__ void partialSM(f32x16& p0, f32x16& p1, float& m_reg, float& alpha) {
    float pmax = p0[0];
#pragma unroll
    for (int r = 1; r < 16; ++r) pmax = fmaxf(pmax, p0[r]);
#pragma unroll
    for (int r = 0; r < 16; ++r) pmax = fmaxf(pmax, p1[r]);
    { auto rr = __builtin_amdgcn_permlane32_swap(__float_as_uint(pmax), __float_as_uint(pmax), false, false);
      pmax = fmaxf(__uint_as_float(rr[0]), __uint_as_float(rr[1])); }
    float mn;
    if (__builtin_expect(__all(pmax - m_reg <= THR), 1)) { mn = m_reg; alpha = 1.f; }
    else { mn = fmaxf(m_reg, pmax); alpha = __builtin_amdgcn_exp2f(m_reg - mn); m_reg = mn; }
#pragma unroll
    for (int r = 0; r < 16; ++r) { p0[r] = p0[r] - mn; p1[r] = p1[r] - mn; }
#pragma unroll
    for (int r = 0; r < 16; ++r) p0[r] = __builtin_amdgcn_exp2f(p0[r]);
}
__device__ __forceinline__ void finishSM(f32x16& p0, f32x16& p1, float alpha, float& l_reg, bf16x8& pa0, bf16x8& pa1, bf16x8& pa2, bf16x8& pa3) {
#pragma unroll
    for (int r = 0; r < 16; ++r) p1[r] = __builtin_amdgcn_exp2f(p1[r]);
    float ps = 0;
#pragma unroll
    for (int r = 0; r < 16; ++r) ps += p0[r];
#pragma unroll
    for (int r = 0; r < 16; ++r) ps += p1[r];
    { auto rr = __builtin_amdgcn_permlane32_swap(__float_as_uint(ps), __float_as_uint(ps), false, false);
      ps = __uint_as_float(rr[0]) + __uint_as_float(rr[1]); }
    l_reg = l_reg * alpha + ps;
#define PK4(P, BASE, OUT) do { unsigned a0 = cvtpk(P[BASE + 0], P[BASE + 1]), a1 = cvtpk(P[BASE + 2], P[BASE + 3]);   \
    unsigned b0 = cvtpk(P[BASE + 4], P[BASE + 5]), b1 = cvtpk(P[BASE + 6], P[BASE + 7]);                              \
    auto r0 = __builtin_amdgcn_permlane32_swap(a0, b0, false, false); auto r1 = __builtin_amdgcn_permlane32_swap(a1, b1, false, false); \
    u32x4 w = {r0[0], r1[0], r0[1], r1[1]}; OUT = __builtin_bit_cast(bf16x8, w); } while (0)
    PK4(p0, 0, pa0); PK4(p0, 8, pa1); PK4(p1, 0, pa2); PK4(p1, 8, pa3);
#undef PK4
}
template <int NQC>
__device__ __forceinline__ void qkt(f32x16& p0, f32x16& p1, const char* Ks, const bf16x8* qr, int r32, int hi) {
    p0 = f32x16{}; p1 = f32x16{};
#pragma unroll
    for (int d0 = 0; d0 < NQC; ++d0) { const int c = 2 * d0 + hi; const int a = c * 1024 + ((r32 ^ (c & 7)) << 4);
        const bf16x8 b0 = *reinterpret_cast<const bf16x8*>(Ks + a);
        const bf16x8 b1 = *reinterpret_cast<const bf16x8*>(Ks + a + 512);
        p0 = __builtin_amdgcn_mfma_f32_32x32x16_bf16(b0, qr[d0], p0, 0, 0, 0);
        p1 = __builtin_amdgcn_mfma_f32_32x32x16_bf16(b1, qr[d0], p1, 0, 0, 0); }
}
template <int NDB> __device__ __forceinline__ int v_st(int k, int c) { const int kk = (k & ~0xC) | ((k & 4) << 1) | ((k & 8) >> 1); return ((kk >> 3) * NDB + (c >> 5)) * 512 + ((kk & 7) * 32 + (c & 31)) * 2; }
__device__ __forceinline__ int v_rd_base(int lane) { return ((lane & 3) << 3) | (((lane >> 2) & 3) << 6) | (((lane >> 4) & 1) << 5) | (((lane >> 5) & 1) << 8); }
template <int NDB> constexpr int v_rd_off(int d0, int ks, int half) { return d0 * 512 + ks * (NDB * 1024) + half * (NDB * 512); }
template <int OFF> __device__ __forceinline__ s16x4 tr_read(int vb) { s16x4 r; asm volatile("ds_read_b64_tr_b16 %0, %1 offset:%2" : "=&v"(r) : "v"(vb), "i"(OFF) : "memory"); return r; }
template <int D0, int NDB> __device__ __forceinline__ void pv_one(f32x16& od, int vb, bf16x8 pa0, bf16x8 pa1, bf16x8 pa2, bf16x8 pa3) {
    const s16x4 l0 = tr_read<v_rd_off<NDB>(D0, 0, 0)>(vb), h0 = tr_read<v_rd_off<NDB>(D0, 0, 1)>(vb), l1 = tr_read<v_rd_off<NDB>(D0, 1, 0)>(vb), h1 = tr_read<v_rd_off<NDB>(D0, 1, 1)>(vb);
    const s16x4 l2 = tr_read<v_rd_off<NDB>(D0, 2, 0)>(vb), h2 = tr_read<v_rd_off<NDB>(D0, 2, 1)>(vb), l3 = tr_read<v_rd_off<NDB>(D0, 3, 0)>(vb), h3 = tr_read<v_rd_off<NDB>(D0, 3, 1)>(vb);
    asm volatile("s_waitcnt lgkmcnt(0)" ::: "memory"); SBAR();
#define PK(L, H) (bf16x8){L[0], L[1], L[2], L[3], H[0], H[1], H[2], H[3]}
    od = __builtin_amdgcn_mfma_f32_32x32x16_bf16(pa0, PK(l0, h0), od, 0, 0, 0);
    od = __builtin_amdgcn_mfma_f32_32x32x16_bf16(pa1, PK(l1, h1), od, 0, 0, 0);
    od = __builtin_amdgcn_mfma_f32_32x32x16_bf16(pa2, PK(l2, h2), od, 0, 0, 0);
    od = __builtin_amdgcn_mfma_f32_32x32x16_bf16(pa3, PK(l3, h3), od, 0, 0, 0);
#undef PK
}
template <int NDB> __device__ __forceinline__ void pv_all(f32x16* o, int vb, bf16x8 pa0, bf16x8 pa1, bf16x8 pa2, bf16x8 pa3) {
    pv_one<0, NDB>(o[0], vb, pa0, pa1, pa2, pa3); pv_one<1, NDB>(o[1], vb, pa0, pa1, pa2, pa3);
    if constexpr (NDB == 4) { pv_one<2, NDB>(o[2], vb, pa0, pa1, pa2, pa3); pv_one<3, NDB>(o[3], vb, pa0, pa1, pa2, pa3); }
}
__device__ __forceinline__ void mask_meta(f32x16& p0, f32x16& p1) {
#pragma unroll
    for (int r = 8; r < 16; ++r) p0[r] = NEGBIG;
#pragma unroll
    for (int r = 0; r < 16; ++r) p1[r] = NEGBIG;
}
__device__ __forceinline__ void mask_all(f32x16& p0, f32x16& p1) {
#pragma unroll
    for (int r = 0; r < 16; ++r) { p0[r] = NEGBIG; p1[r] = NEGBIG; }
}

template <int DQK, int DV, class P>
__device__ __forceinline__ void attn_unit(const P& pol, char* lds) {
    constexpr int NQC = DQK / 16, NDB = DV / 32, KB = 64 * DQK * 2, VB = 64 * DV * 2;
    constexpr int KCH = DQK / 8, VCH = DV / 8, NKS = (64 * KCH) / 512, NVS = (64 * VCH) / 512;
    int tid_ = threadIdx.x; asm volatile("" : "+v"(tid_));
    const int tid = tid_, wid = tid >> 6, lane = tid & 63, r32 = lane & 31, hi = lane >> 5;
    char* V_lds = lds; char* K_lds = lds + 3 * VB;
    float* ws = (float*)(lds + 3 * VB + 3 * KB) + wid * 64; float* li_l = ws; float* al_l = ws + 32;
    float m_reg = NEGBIG, l_reg = 0.f; f32x16 o[NDB];
#pragma unroll
    for (int d = 0; d < NDB; ++d) o[d] = f32x16{};
    bf16x8 qr[NQC];
    { const bf16* Qw = pol.qptr(wid * 32 + r32) + hi * 8;
#pragma unroll
      for (int d0 = 0; d0 < NQC; ++d0) qr[d0] = *reinterpret_cast<const bf16x8*>(Qw + d0 * 16); }
    pol.qfix(qr, wid * 32 + r32, hi);
    const int vb0 = (int)(uintptr_t)V_lds + v_rd_base(lane);
    bf16x8 ks[NKS], vs[NVS];
    const int srow = tid >> 3, c0 = tid & 7;
    const unsigned koff = (unsigned)(srow * pol.kstride + c0 * 8) * 2u, voff = (unsigned)(srow * pol.vstride + c0 * 8) * 2u;
    const int kst = c0 * 1024 + ((srow ^ c0) << 4), vst = v_st<NDB>(srow, c0 * 8);
    static_assert(NKS == KCH / 8 && NVS == VCH / 8, "staging map");
#define SLOAD(t) do { const char* kb_ = (const char*)pol.kbase(t) + koff; const char* vb_ = (const char*)pol.vbase(t) + voff; \
    _Pragma("unroll") for (int i = 0; i < NKS; ++i) ks[i] = *reinterpret_cast<const bf16x8*>(kb_ + i * 128); \
    _Pragma("unroll") for (int i = 0; i < NVS; ++i) vs[i] = *reinterpret_cast<const bf16x8*>(vb_ + i * 128); } while (0)
#define SWRITE(b) do { \
    _Pragma("unroll") for (int i = 0; i < NKS; ++i) *reinterpret_cast<bf16x8*>(K_lds + (b) * KB + kst + i * 8192) = ks[i]; \
    _Pragma("unroll") for (int i = 0; i < NVS; ++i) *reinterpret_cast<bf16x8*>(V_lds + (b) * VB + vst + i * 1024) = vs[i]; } while (0)
#define RESC(a) do { if (__any((a) < 1.f)) { if (hi == 0) al_l[r32] = (a); asm volatile("s_waitcnt lgkmcnt(0)" ::: "memory"); \
    _Pragma("unroll") for (int d = 0; d < NDB; ++d) _Pragma("unroll") for (int r = 0; r < 16; ++r) o[d][r] *= al_l[crow(r, hi)]; } } while (0)
#define XFORM(pa_, pb_, t) do { if (pol.needs_xform(t)) pol.xform(pa_, pb_, (t), wid, r32, hi); } while (0)
    f32x16 pA0, pA1, pB0, pB1; float alA, alB; bf16x8 pa0, pa1, pa2, pa3; const int NT = pol.nt;
    SLOAD(0); asm volatile("s_waitcnt vmcnt(0)" ::: "memory"); SWRITE(0); __syncthreads();
    qkt<NQC>(pA0, pA1, K_lds, qr, r32, hi); XFORM(pA0, pA1, 0); partialSM(pA0, pA1, m_reg, alA);
    SLOAD(1); asm volatile("s_waitcnt vmcnt(0)" ::: "memory"); SWRITE(1); __syncthreads();
    int bprev = 0, bcur = 1, bnext = 2;
#define ROT3() do { bprev = bcur; bcur = bnext; bnext = (bnext == 2) ? 0 : bnext + 1; } while (0)
    for (int j = 1; j + 1 < NT; j += 2) {
        SBAR(); qkt<NQC>(pB0, pB1, K_lds + bcur * KB, qr, r32, hi);
        finishSM(pA0, pA1, alA, l_reg, pa0, pa1, pa2, pa3); SBAR();
        SLOAD(j + 1); SBAR();
        pv_all<NDB>(o, vb0 + bprev * VB, pa0, pa1, pa2, pa3); XFORM(pB0, pB1, j); partialSM(pB0, pB1, m_reg, alB);
        asm volatile("s_waitcnt vmcnt(0)" ::: "memory"); SWRITE(bnext);
        RESC(alB); __syncthreads(); ROT3();
        SBAR(); qkt<NQC>(pA0, pA1, K_lds + bcur * KB, qr, r32, hi);
        finishSM(pB0, pB1, alB, l_reg, pa0, pa1, pa2, pa3); SBAR();
        SLOAD(j + 2); SBAR();
        pv_all<NDB>(o, vb0 + bprev * VB, pa0, pa1, pa2, pa3); XFORM(pA0, pA1, j + 1); partialSM(pA0, pA1, m_reg, alA);
        asm volatile("s_waitcnt vmcnt(0)" ::: "memory"); SWRITE(bnext);
        RESC(alA); __syncthreads(); ROT3();
    }
    SBAR(); qkt<NQC>(pB0, pB1, K_lds + bcur * KB, qr, r32, hi);
    finishSM(pA0, pA1, alA, l_reg, pa0, pa1, pa2, pa3); SBAR();
    pv_all<NDB>(o, vb0 + bprev * VB, pa0, pa1, pa2, pa3); XFORM(pB0, pB1, NT - 1); partialSM(pB0, pB1, m_reg, alB);
    RESC(alB);
    finishSM(pB0, pB1, alB, l_reg, pa0, pa1, pa2, pa3); SBAR();
    pv_all<NDB>(o, vb0 + bcur * VB, pa0, pa1, pa2, pa3);
#undef ROT3
    l_reg += pol.sink_term(m_reg);
    if (pol.partial()) {
        if (wid == 0) {
            if (lane < 16) { float* pp = pol.pptr(lane); pp[128] = m_reg; pp[129] = l_reg; }
#pragma unroll
            for (int r = 0; r < 8; ++r) { float* pp = pol.pptr(crow(r, hi));
#pragma unroll
                for (int d0 = 0; d0 < NDB; ++d0) pp[d0 * 32 + r32] = o[d0][r]; }
        }
    } else {
    if (hi == 0) li_l[r32] = l_reg; asm volatile("s_waitcnt lgkmcnt(0)" ::: "memory");
    float rli[16];
#pragma unroll
    for (int r = 0; r < 16; ++r) rli[r] = __builtin_amdgcn_rcpf(li_l[crow(r, hi)]);
#pragma unroll
    for (int r = 0; r < 16; ++r) { const int orow = wid * 32 + crow(r, hi);
        if (pol.ovalid(orow)) { bf16* op = pol.optr(orow);
#pragma unroll
            for (int d0 = 0; d0 < NDB; ++d0) op[d0 * 32 + r32] = (bf16)f2bf(o[d0][r] * rli[r]); } }
    }
    __syncthreads();
#undef SLOAD
#undef SWRITE
#undef RESC
#undef XFORM
}

__device__ __forceinline__ int unit_row(int b, int qb, int r) { int row = qb < 64 ? b * SEQ + qb * 256 + r : RMETA + 16 * b + r; return row < NR ? row : NR - 1; }

struct PolMLA {
    const bf16 *Kc, *Vm, *Q; bf16* O; float* part; const float* rope_; int b, h, qb, nt, kstride, vstride, split;
    __device__ __forceinline__ void init(const bf16* Kc_, const bf16* Vm_, const bf16* Q_, bf16* O_, float* part_, const float* rope__, int b_, int h_, int qb_, int split_) {
        Kc = Kc_; Vm = Vm_; Q = Q_; O = O_; part = part_; rope_ = rope__; b = b_; h = h_; qb = qb_; split = split_; kstride = KCW; vstride = VMW;
        nt = split < 0 ? 258 : (split == 0 ? 34 : 32); }
    __device__ __forceinline__ int krow0(int t) const {
        if (split < 0) return (t == 0 || t == 257) ? RMETA + 16 * b : b * SEQ + (t - 1) * 64;
        if (split == 0) return (t == 0 || t == 33) ? RMETA + 16 * b : b * SEQ + (t - 1) * 64;
        return b * SEQ + (32 * split + t) * 64; }
    __device__ __forceinline__ const bf16* kbase(int t) const { return Kc + (size_t)krow0(t) * KCW + h * 192; }
    __device__ __forceinline__ const bf16* vbase(int t) const { return Vm + (size_t)krow0(t) * VMW + h * 128; }
    __device__ __forceinline__ const bf16* qptr(int r) const { return Q + (size_t)unit_row(b, qb, r) * QW + h * 192; }
    __device__ __forceinline__ bf16* optr(int r) const { return O + (size_t)unit_row(b, qb, r) * AOW + h * 128; }
    __device__ __forceinline__ bool ovalid(int r) const { return qb < 64 || r < 16; }
    __device__ __forceinline__ bool needs_xform(int t) const { return split < 0 ? (t == 0 || t == 257) : (split == 0 && (t == 0 || t == 33)); }
    __device__ __forceinline__ void xform(f32x16& p0, f32x16& p1, int t, int, int, int) const { if (t == 0) mask_meta(p0, p1); else mask_all(p0, p1); }
    __device__ __forceinline__ float sink_term(float) const { return 0.f; }
    __device__ __forceinline__ bool partial() const { return split >= 0; }
    __device__ __forceinline__ void qfix(bf16x8* qr, int r, int hi) const {
        const int row = unit_row(b, qb, r); const int pos = row < RMETA ? NMETA + (row & (SEQ - 1)) : ((row - RMETA) & 15);
        const float* rp = rope_ + 2 * (size_t)(pos * 32);
#pragma unroll
        for (int blk = 0; blk < 2; ++blk) { const f32x4* cs = (const f32x4*)(rp + 2 * (16 * blk + 8 * hi)); f32x4 t[4];
#pragma unroll
            for (int q = 0; q < 4; ++q) t[q] = cs[q];
            bf16x8 x1 = qr[8 + blk], x2 = qr[10 + blk];
#pragma unroll
            for (int e = 0; e < 8; ++e) { const float c = t[e >> 1][(e & 1) * 2], sn = t[e >> 1][(e & 1) * 2 + 1];
                const float a = bf2f((unsigned short)x1[e]), bb = bf2f((unsigned short)x2[e]);
                x1[e] = (short)f2bf(a * c - bb * sn); x2[e] = (short)f2bf(bb * c + a * sn); }
            qr[8 + blk] = x1; qr[10 + blk] = x2; } }
    __device__ __forceinline__ float* pptr(int r) const { return part + ((size_t)((b * 8 + h) * 8 + split) * 16 + r) * 132; }
};

struct PolNA {
    const bf16* Z; bf16* O; const float* tab; int b, h, qb, nt, kstride, vstride, glo, n;
    __device__ __forceinline__ void init(const bf16* Z_, bf16* O_, const float* tab_, int b_, int h_, int qb_) {
        Z = Z_; O = O_; tab = tab_; b = b_; h = h_; qb = qb_; kstride = ZW; vstride = ZW;
        if (qb < 64) { int lo = 4 * qb - 4; lo = lo < 0 ? 0 : (lo > 248 ? 248 : lo); int hi_ = 4 * qb + 3 - 4; hi_ = hi_ < 0 ? 0 : (hi_ > 248 ? 248 : hi_); hi_ += 7; glo = lo; n = hi_ - lo + 1; }
        else { glo = 0; n = 0; }
        nt = (n + 1 + 1) & ~1; }
    __device__ __forceinline__ int krow0(int t) const { return (t == 0 || t > n) ? RMETA + 16 * b : b * SEQ + (glo + t - 1) * 64; }
    __device__ __forceinline__ const bf16* kbase(int t) const { return Z + (size_t)krow0(t) * ZW + ZNAK + h * 128; }
    __device__ __forceinline__ const bf16* vbase(int t) const { return Z + (size_t)krow0(t) * ZW + ZNAV + h * 128; }
    __device__ __forceinline__ const bf16* qptr(int r) const { return Z + (size_t)unit_row(b, qb, r) * ZW + ZNAQ + h * 128; }
    __device__ __forceinline__ bf16* optr(int r) const { return O + (size_t)unit_row(b, qb, r) * AOW + 1024 + h * 128; }
    __device__ __forceinline__ bool ovalid(int r) const { return qb < 64 || r < 16; }
    __device__ __forceinline__ bool needs_xform(int) const { return true; }
    __device__ __forceinline__ void xform(f32x16& p0, f32x16& p1, int t, int wid, int r32, int hi) const {
        if (t == 0) { mask_meta(p0, p1); return; }
        if (t > n) { mask_all(p0, p1); return; }
        const int g = glo + t - 1, r = 4 * qb + (wid >> 1), c = 32 * (wid & 1) + r32;
        int rs = r - 4; rs = rs < 0 ? 0 : (rs > 248 ? 248 : rs);
        if (g < rs || g >= rs + 8) { mask_all(p0, p1); return; }
        int cs = c - 8; cs = cs < 0 ? 0 : (cs > 48 ? 48 : cs);
        const float* trow = tab + (g - r + 7) * 31 + 15 - c;
#pragma unroll
        for (int i = 0; i < 16; ++i) { const int kc = crow(i, hi); const bool ok = kc >= cs && kc < cs + 16; const int kcc = ok ? kc : c;
            const float bv = trow[kcc]; p0[i] = ok ? p0[i] + bv : NEGBIG; }
#pragma unroll
        for (int i = 0; i < 16; ++i) { const int kc = 32 + crow(i, hi); const bool ok = kc >= cs && kc < cs + 16; const int kcc = ok ? kc : c;
            const float bv = trow[kcc]; p1[i] = ok ? p1[i] + bv : NEGBIG; }
    }
    __device__ __forceinline__ float sink_term(float) const { return 0.f; }
    __device__ __forceinline__ bool partial() const { return false; }
    __device__ __forceinline__ float* pptr(int) const { return nullptr; }
    __device__ __forceinline__ void qfix(bf16x8*, int, int) const {}
};

struct PolSWA {
    const bf16* Z; bf16* O; int b, hq, qb, nt, kstride, vstride, klo, n; float slope_l2, sink_l2;
    __device__ __forceinline__ void init(const bf16* Z_, bf16* O_, const float* sinks, int b_, int hq_, int qb_) {
        Z = Z_; O = O_; b = b_; hq = hq_; qb = qb_; kstride = Z1W; vstride = Z1W;
        if (qb < 64) { klo = 4 * qb - 2; if (klo < 0) klo = 0; int khi = 4 * qb + 5; if (khi > 255) khi = 255; n = khi - klo + 1; }
        else { klo = 0; n = 2; }
        nt = (n + 1 + 1) & ~1;
        slope_l2 = __builtin_amdgcn_exp2f(-0.25f * (float)(hq + 1)) * LOG2E; sink_l2 = sinks[hq] * LOG2E; }
    __device__ __forceinline__ int krow0(int t) const { return (t == 0 || t > n) ? RMETA + 16 * b : b * SEQ + (klo + t - 1) * 64; }
    __device__ __forceinline__ const bf16* kbase(int t) const { return Z + (size_t)krow0(t) * Z1W + 2048 + (hq >> 3) * 64; }
    __device__ __forceinline__ const bf16* vbase(int t) const { return Z + (size_t)krow0(t) * Z1W + 2304 + (hq >> 3) * 64; }
    __device__ __forceinline__ const bf16* qptr(int r) const { return Z + (size_t)unit_row(b, qb, r) * Z1W + hq * 64; }
    __device__ __forceinline__ bf16* optr(int r) const { return O + (size_t)unit_row(b, qb, r) * AOW + hq * 64; }
    __device__ __forceinline__ bool ovalid(int r) const { return qb < 64 || r < 16; }
    __device__ __forceinline__ bool needs_xform(int) const { return true; }
    __device__ __forceinline__ void xform(f32x16& p0, f32x16& p1, int t, int wid, int r32, int hi) const {
        if (t == 0) { mask_meta(p0, p1); return; }
        if (t > n) { mask_all(p0, p1); return; }
        const int kt = klo + t - 1;
        if (qb < 64) {
            const int d0 = 64 * kt - (256 * qb + 32 * wid + r32);
#pragma unroll
            for (int i = 0; i < 16; ++i) { int d = d0 + crow(i, hi); d = max(d, -d); const int m = min(max(d - 128, 0), 1); p0[i] = (p0[i] - slope_l2 * (float)d) + NEGBIG * (float)m; }
#pragma unroll
            for (int i = 0; i < 16; ++i) { int d = d0 + 32 + crow(i, hi); d = max(d, -d); const int m = min(max(d - 128, 0), 1); p1[i] = (p1[i] - slope_l2 * (float)d) + NEGBIG * (float)m; }
        } else {
            const int qi = 32 * wid + r32, j0 = 64 * kt;
#pragma unroll
            for (int i = 0; i < 16; ++i) { const int j = j0 + crow(i, hi); const int m = min(max(16 + j - qi - 128, 0), 1); p0[i] = p0[i] + NEGBIG * (float)m; }
#pragma unroll
            for (int i = 0; i < 16; ++i) { const int j = j0 + 32 + crow(i, hi); const int m = min(max(16 + j - qi - 128, 0), 1); p1[i] = p1[i] + NEGBIG * (float)m; }
        }
    }
    __device__ __forceinline__ float sink_term(float m) const { return __builtin_amdgcn_exp2f(sink_l2 - m); }
    __device__ __forceinline__ bool partial() const { return false; }
    __device__ __forceinline__ float* pptr(int) const { return nullptr; }
    __device__ __forceinline__ void qfix(bf16x8*, int, int) const {}
};
struct PolSWAG {
    const bf16* Z; bf16* O; int b, kvh, pb, nt, kstride, vstride, klo, n; float slope_l2, sink_l2;
    __device__ __forceinline__ void init(const bf16* Z_, bf16* O_, const float* sinks, int b_, int kvh_, int pb_, int wv) {
        Z = Z_; O = O_; b = b_; kvh = kvh_; pb = pb_; kstride = Z1W; vstride = Z1W;
        klo = (pb - 4) >> 1; if (klo < 0) klo = 0; int khi = (pb + 4) >> 1; if (khi > 255) khi = 255; n = khi - klo + 1;
        nt = (n + 1 + 1) & ~1;
        const int hq = kvh * 8 + wv;
        slope_l2 = __builtin_amdgcn_exp2f(-0.25f * (float)(hq + 1)) * LOG2E; sink_l2 = sinks[hq] * LOG2E; }
    __device__ __forceinline__ int krow0(int t) const { return (t == 0 || t > n) ? RMETA + 16 * b : b * SEQ + (klo + t - 1) * 64; }
    __device__ __forceinline__ const bf16* kbase(int t) const { return Z + (size_t)krow0(t) * Z1W + 2048 + kvh * 64; }
    __device__ __forceinline__ const bf16* vbase(int t) const { return Z + (size_t)krow0(t) * Z1W + 2304 + kvh * 64; }
    __device__ __forceinline__ const bf16* qptr(int r) const { return Z + (size_t)(b * SEQ + 32 * pb + (r & 31)) * Z1W + (kvh * 8 + (r >> 5)) * 64; }
    __device__ __forceinline__ bf16* optr(int r) const { return O + (size_t)(b * SEQ + 32 * pb + (r & 31)) * AOW + (kvh * 8 + (r >> 5)) * 64; }
    __device__ __forceinline__ bool ovalid(int) const { return true; }
    __device__ __forceinline__ bool needs_xform(int) const { return true; }
    __device__ __forceinline__ void xform(f32x16& p0, f32x16& p1, int t, int, int r32, int hi) const {
        if (t == 0) { mask_meta(p0, p1); return; }
        if (t > n) { mask_all(p0, p1); return; }
        const int d0 = 64 * (klo + t - 1) - (32 * pb + r32);
#pragma unroll
        for (int i = 0; i < 16; ++i) { int d = d0 + crow(i, hi); d = max(d, -d); const int m = min(max(d - 128, 0), 1); p0[i] = (p0[i] - slope_l2 * (float)d) + NEGBIG * (float)m; }
#pragma unroll
        for (int i = 0; i < 16; ++i) { int d = d0 + 32 + crow(i, hi); d = max(d, -d); const int m = min(max(d - 128, 0), 1); p1[i] = (p1[i] - slope_l2 * (float)d) + NEGBIG * (float)m; }
    }
    __device__ __forceinline__ float sink_term(float m) const { return __builtin_amdgcn_exp2f(sink_l2 - m); }
    __device__ __forceinline__ bool partial() const { return false; }
    __device__ __forceinline__ float* pptr(int) const { return nullptr; }
    __device__ __forceinline__ void qfix(bf16x8*, int, int) const {}
};
#undef SBAR
}

struct Params {
    const float* x; const float* meta; const float* norm_mix; const float* norm_ffn; const float* norm_final;
    const float* ab_w_in; const float* ab_q_norm; const float* ab_kv_norm; const float* ab_w_uq; const float* ab_w_ukv; const float* ab_rpb; const float* ab_w_out;
    const float* c_w_in; const float* c_sinks; const float* c_w_out;
    const float* ec_w_router; const float* ec_w_gate; const float* ec_w_up; const float* ec_w_down;
    float* out; unsigned char* ws;
};

__device__ __forceinline__ void load_row(const float* row, int lane, f32x4 (&v)[8]) {
    const f32x4* r = (const f32x4*)row + lane;
#pragma unroll
    for (int j = 0; j < 8; ++j) v[j] = r[64 * j];
}
__device__ __forceinline__ void load_row_bf16(const bf16* row, int lane, f32x4 (&v)[8]) {
    const u32x2* r = (const u32x2*)row + lane;
#pragma unroll
    for (int j = 0; j < 8; ++j) { const u32x2 w = r[64 * j]; v[j] = (f32x4){bflo(w.x), bfhi(w.x), bflo(w.y), bfhi(w.y)}; }
}
__device__ __forceinline__ void store_row_bf16(bf16* row, int lane, const f32x4 (&v)[8]) {
    u32x2* o8 = (u32x2*)row + lane;
#pragma unroll
    for (int j = 0; j < 8; ++j) { u32x2 w; w.x = pk2(v[j].x, v[j].y); w.y = pk2(v[j].z, v[j].w); o8[64 * j] = w; }
}
__device__ __forceinline__ float row_rs(const f32x4 (&v)[8]) {
    float s = 0.f;
#pragma unroll
    for (int j = 0; j < 8; ++j) s += (v[j].x * v[j].x + v[j].y * v[j].y) + (v[j].z * v[j].z + v[j].w * v[j].w);
    return 1.0f / sqrtf(wave_sum(s) * (1.f / D) + EPS);
}
__device__ __forceinline__ void store_norm_bf16(bf16* urow, int lane, const f32x4 (&v)[8], float rs, const float* g) {
    const f32x4* gp = (const f32x4*)g + lane; u32x2* o8 = (u32x2*)urow + lane;
#pragma unroll
    for (int j = 0; j < 8; ++j) { const f32x4 gg = gp[64 * j]; u32x2 w; w.x = pk2(v[j].x * rs * gg.x, v[j].y * rs * gg.y); w.y = pk2(v[j].z * rs * gg.z, v[j].w * rs * gg.w); o8[64 * j] = w; }
}
__device__ __forceinline__ void store_zero_bf16(bf16* urow, int lane) {
    u32x2* o8 = (u32x2*)urow + lane;
#pragma unroll
    for (int j = 0; j < 8; ++j) o8[64 * j] = (u32x2){0u, 0u};
}

__device__ __forceinline__ void transpose_item(const float* src, int srcN, int k0, int n0, bf16* dst, int dstK, int dst_row0, const float* kscale, LAS float*, int lane) {
    const int kg = lane >> 4, ng = lane & 15;
#pragma unroll
    for (int half = 0; half < 2; ++half) {
        const int kk0 = k0 + 32 * half + 8 * kg;
        f32x4 v[8];
#pragma unroll
        for (int j = 0; j < 8; ++j) v[j] = *(const f32x4*)(src + (size_t)(kk0 + j) * srcN + n0 + 4 * ng);
        if (kscale) {
#pragma unroll
            for (int j = 0; j < 8; ++j) v[j] = v[j] * kscale[kk0 + j]; }
#pragma unroll
        for (int q = 0; q < 4; ++q) { u32x4 o; o.x = pk2(v[0][q], v[1][q]); o.y = pk2(v[2][q], v[3][q]); o.z = pk2(v[4][q], v[5][q]); o.w = pk2(v[6][q], v[7][q]);
            *(u32x4*)(dst + (size_t)(dst_row0 + 4 * ng + q) * dstK + kk0) = o; }
    }
}
template <class Map>
__device__ __forceinline__ void transpose_matrix(const float* W, int K, int N, bf16* WT, const float* kscale, LAS float* scr, int gw, int ngw, int lane, const Map& map) {
    const int nkb = K / 64, nnb = N / 64, items = nkb * nnb;
    for (int it = gw; it < items; it += ngw) { const int kb = it / nnb, nb = it % nnb; transpose_item(W, N, kb * 64, nb * 64, WT, K, map(nb * 64), kscale, scr, lane); }
}
__device__ __forceinline__ void convert_experts(const float* wg, const float* wu, const float* wd, const float* gk, bf16* Wgu, bf16* Wd, LAS float* scr, int gw, int ngw, int lane, int lo, int hi) {
    constexpr int PER = 32 * 32;
    for (int it = lo + gw; it < hi; it += ngw) {
        const int e = it / (3 * PER), r = it % (3 * PER), which = r / PER, q = r % PER, kb = q / 32, nb = q % 32, n0 = nb * 64;
        const size_t eoff = (size_t)e * D * D;
        if (which == 0) transpose_item(wg + eoff, D, kb * 64, n0, Wgu + (size_t)e * 4096 * D, D, (n0 >> 7) * 256 + (n0 & 127), gk, scr, lane);
        else if (which == 1) transpose_item(wu + eoff, D, kb * 64, n0, Wgu + (size_t)e * 4096 * D, D, (n0 >> 7) * 256 + 128 + (n0 & 127), gk, scr, lane);
        else transpose_item(wd + eoff, D, kb * 64, n0, Wd + eoff, D, n0, nullptr, scr, lane);
    }
}

constexpr int CV_ITEMS = NE * 3 * 32 * 32, CV_TAIL_PER_CU = 80;
constexpr int CV_TOPK = 224 * 30;
constexpr int CV_CHUNK = 64;
constexpr int CV_IN0 = (256 - (129 * 17) % 256) * CV_TAIL_PER_CU, CV_OUT = (256 - (129 * 8) % 256) * CV_TAIL_PER_CU, CV_IN1 = (256 - (129 * 10) % 256) * CV_TAIL_PER_CU;
constexpr int CV_MAIN0 = CV_ITEMS - CV_IN0 - CV_OUT - CV_TOPK;
#ifndef PHASES
#define PHASES 0xffffffffu
#endif
#define EN(k) (((PHASES) >> (k)) & 1u)
#define PH_IDS() int tid = threadIdx.x; asm volatile("" : "+v"(tid)); const int lane = tid & 63, wave = __builtin_amdgcn_readfirstlane(tid >> 6), gw = vcu * NWAVES + wave; (void)lane; (void)wave; (void)gw; WSL()
__global__ void __launch_bounds__(NTHREADS, 2) fwd_kernel(Params P) {
    extern __shared__ __attribute__((aligned(16))) unsigned char lds[];
    LAS unsigned char* ldsl = (LAS unsigned char*)lds;
    volatile LAS unsigned* MISC = (volatile LAS unsigned*)(ldsl + MISC_OFF);
    const int G = gridDim.x, bx = blockIdx.x;
    const int vcu = (G % 8 == 0) ? (bx % 8) * (G / 8) + bx / 8 : bx;
    const int NGW = G * NWAVES;
    unsigned* ctl = (unsigned*)(P.ws + WS_CTL);
    for (int u = threadIdx.x; u < 64; u += NTHREADS) MISC[u] = 0u;
    __syncthreads();
    XcdBarrier bar = xcd_barrier_post(ctl + CW_BAR, MISC + 8);
#define GRID_BAR() xcd_barrier(bar)

#define WSL() GAS unsigned char* wsg_ = (GAS unsigned char*)P.ws; asm volatile("" : "+s"(wsg_)); unsigned char* wsl = (unsigned char*)wsg_
#define rope ((float*)(wsl + WS_ROPE))
#define rsq ((float*)(wsl + WS_RSQ))
#define rskv ((float*)(wsl + WS_RSKV))
#define aff ((float*)(wsl + WS_AFF))
#define tokslot ((int*)(wsl + WS_TOKSLOT))
#define slottok ((int*)(wsl + WS_SLOTTOK))
#define xgate ((float*)(wsl + WS_XGATE))
#define xmap ((int*)(wsl + WS_XMAP))
#define rsf ((float*)(wsl + WS_RSF))
#define xrs ((float*)(wsl + WS_XRS))
#define rsm ((float*)(wsl + WS_RSM))
#define Win0 ((bf16*)(wsl + WS_WIN0))
#define Wuq ((bf16*)(wsl + WS_WUQ))
#define Wukv ((bf16*)(wsl + WS_WUKV))
#define Wout0 ((bf16*)(wsl + WS_WOUT0))
#define Win1 ((bf16*)(wsl + WS_WIN1))
#define Wout1 ((bf16*)(wsl + WS_WOUT1))
#define Wgu ((bf16*)(wsl + WS_WGU))
#define Wd ((bf16*)(wsl + WS_WD))
#define Hm ((bf16*)(wsl + WS_H))
#define U ((bf16*)(wsl + WS_U))
#define Z ((bf16*)(wsl + WS_Z))
#define Qb ((bf16*)(wsl + WS_Q))
#define Kc ((bf16*)(wsl + WS_KC))
#define Vm ((bf16*)(wsl + WS_VM))
#define AO ((bf16*)(wsl + WS_AO))
#define XS ((bf16*)(wsl + WS_XS))
#define HMID ((bf16*)(wsl + WS_HMID))

    if (EN(0)) {
        PH_IDS();
        LAS float* scr = (LAS float*)(ldsl + wave * 16640);
#define TRG(off) ((gw + NGW - (off) % NGW) % NGW)
        transpose_matrix(P.ab_w_in, D, 4160, Win0, nullptr, scr, gw, NGW, lane, [](int n0) { return n0 < 1024 ? n0 : (n0 < 1088 ? 4096 + (n0 - 1024) : n0 - 64); });
        transpose_matrix(P.ab_w_uq, 512, 1536, Wuq, P.ab_q_norm, scr, TRG(2080), NGW, lane, [](int n0) { return n0; });
        transpose_matrix(P.ab_w_ukv, 512, 2048, Wukv, P.ab_kv_norm, scr, TRG(2272), NGW, lane, [](int n0) { return n0; });
        transpose_matrix(P.ab_w_out, D, D, Wout0, nullptr, scr, TRG(2528), NGW, lane, [](int n0) { return n0; });
        transpose_matrix(P.c_w_in, D, Z1W, Win1, P.norm_mix + D, scr, TRG(3552), NGW, lane, [](int n0) { return n0; });
        transpose_matrix(P.c_w_out, D, D, Wout1, nullptr, scr, TRG(4832), NGW, lane, [](int n0) { return n0; });
#undef TRG
        if (G != 256) convert_experts(P.ec_w_gate, P.ec_w_up, P.ec_w_down, P.norm_ffn, Wgu, Wd, scr, gw, NGW, lane, 0, CV_ITEMS);
        for (int row = NTOK + gw * 64 + lane; row < NR; row += NGW * 64) rsm[row] = 0.f;
        for (int i = gw * 64 + lane; i < 192 * D / 8; i += NGW * 64) ((u32x4*)(Win0 + (size_t)4160 * D))[i] = (u32x4){0u, 0u, 0u, 0u};
        for (int row = gw; row < NR; row += NGW) {
            bf16* urow = U + (size_t)row * D;
            if (row < NTOK) {
                const float* src = row < RMETA ? P.x + (size_t)row * D : P.meta + (size_t)((row - RMETA) & 15) * D;
                f32x4 v[8]; load_row(src, lane, v);
                const float rs = row_rs(v); store_norm_bf16(urow, lane, v, rs, P.norm_mix);
            } else store_zero_bf16(urow, lane);
        }
        for (int i = gw * 64 + lane; i < LTOK * 32; i += NGW * 64) {
            const int pos = i >> 5, j = i & 31;
            double f = 1.0; { double r = 0.74989420933245582730;   for (int q = 0; q < j; ++q) f *= r; }
            const double rev = (double)pos * f * 0.15915494309189533577;
            const float fr = (float)(rev - __builtin_floor(rev));
            rope[2 * i] = __builtin_amdgcn_cosf(fr); rope[2 * i + 1] = __builtin_amdgcn_sinf(fr);
        }
    }
    GRID_BAR();

    for (int layer = 0; layer < 2; ++layer) {
        if (EN(1)) {
            WSL();
            const int nN = layer == 0 ? 17 : 10, ldz = layer == 0 ? ZW : Z1W;
            pg8::Gemm g{layer == 0 ? U : Hm, layer == 0 ? Win0 : Win1, D, D, D};
            pg8::TileOrder S; S.init(NR / 256, nN, G, bx, 0);
            pg8::EpiBf16S E{Z, ldz, layer == 0 ? nullptr : rsm, layer == 0 ? 4 : 0, 8, layer == 0 ? C_NA : C_SWA};
            pg8::gemm_phase(ldsl, g, S, E);
            if (G == 256) {
                const int rem = (129 * nN) % 256;
                if (bx >= rem) { PH_IDS(); const int cnt = layer == 0 ? CV_IN0 : CV_IN1, base = CV_ITEMS - CV_OUT - cnt; const size_t lo = (size_t)layer * NE * D * D;
                    convert_experts(P.ec_w_gate + lo, P.ec_w_up + lo, P.ec_w_down + lo, P.norm_ffn + (size_t)layer * D, Wgu, Wd, (LAS float*)ldsl, (bx - rem) * NWAVES + wave, (256 - rem) * NWAVES, lane, base, base + cnt); }
            }
        }
        GRID_BAR();
        if (layer == 0) {
            if (EN(2)) { PH_IDS();
                const int sub = lane >> 4, l16 = lane & 15;
                for (int row4 = gw * 4; row4 < NR; row4 += NGW * 4) {
                    const int row = row4 + sub;
                    const bf16* zr = Z + (size_t)row * ZW;
                    u32x4 a[4], bq[4];
#pragma unroll
                    for (int i = 0; i < 4; ++i) { a[i] = *(const u32x4*)(zr + ZQL + 128 * i + 8 * l16); bq[i] = *(const u32x4*)(zr + ZKVL + 128 * i + 8 * l16); }
                    const int pos = row < RMETA ? NMETA + (row & (SEQ - 1)) : ((row - RMETA) & 15);
                    const unsigned x1w = *(const unsigned*)(zr + ZKR + 2 * l16), x2w = *(const unsigned*)(zr + ZKR + 32 + 2 * l16);
                    const f32x4 cs = *(const f32x4*)(rope + 2 * (pos * 32 + 2 * l16));
                    float s1 = 0.f, s2 = 0.f;
#pragma unroll
                    for (int i = 0; i < 4; ++i)
#pragma unroll
                        for (int q = 0; q < 4; ++q) { const float a0 = bflo(a[i][q]), a1 = bfhi(a[i][q]), b0 = bflo(bq[i][q]), b1 = bfhi(bq[i][q]); s1 += a0 * a0 + a1 * a1; s2 += b0 * b0 + b1 * b1; }
#pragma unroll
                    for (int o = 1; o < 16; o <<= 1) { s1 += __shfl_xor(s1, o); s2 += __shfl_xor(s2, o); }
                    if (l16 == 0) { rsq[row] = C_MLA / sqrtf(s1 * (1.f / 512) + EPS); rskv[row] = 1.0f / sqrtf(s2 * (1.f / 512) + EPS); }
                    const float z = row < NTOK ? 1.f : 0.f;
                    const float x1a = bflo(x1w) * z, x1b = bfhi(x1w) * z, x2a = bflo(x2w) * z, x2b = bfhi(x2w) * z;
                    const unsigned w1 = pk2(x1a * cs[0] - x2a * cs[1], x1b * cs[2] - x2b * cs[3]), w2 = pk2(x2a * cs[0] + x1a * cs[1], x2b * cs[2] + x1b * cs[3]);
                    bf16* kr = Kc + (size_t)row * KCW + 128 + 2 * l16;
#pragma unroll
                    for (int h = 0; h < 8; ++h) { *(unsigned*)(kr + h * 192) = w1; *(unsigned*)(kr + h * 192 + 32) = w2; }
                } }
            GRID_BAR();
            if (EN(3)) {
                WSL();
                pg8::Gemm g{Z + ZQL, Wuq, ZW, 512, 512};
                pg8::TileOrder S; S.init(NR / 256, 6, G, bx, 0);
                pg8::EpiBf16S E{Qb, QW, rsq, 0, 0, 1.f};
                pg8::gemm_phase(ldsl, g, S, E);
            }
            if (EN(4)) {
                WSL();
                pg8::Gemm g{Z + ZKVL, Wukv, ZW, 512, 512};
                pg8::TileOrder S; S.init(NR / 256, 8, G, G == 256 ? (bx + 248) & 255 : bx, 0);
                pg8::EpiKV E{Kc, Vm, rskv};
                pg8::gemm_phase(ldsl, g, S, E);
            }
            GRID_BAR();
            {
                WSL();
                constexpr int N_MLA = 1024 + 128, N_NA = 1040;
                float* tab = (float*)(lds + 3 * 16384 + 3 * 16384 + 2048);
                float* PART = (float*)(wsl + WS_PART);
                unsigned* ticket = (unsigned*)(wsl + WS_CTL) + CW_TICKET;
                for (int u0 = vcu; ; ) {
                    int u;
                    if (u0 < 1024) { u = u0; u0 += G; }
                    else {
                        if (threadIdx.x == 0) MISC[16] = 1024u + __hip_atomic_fetch_add(ticket, 1u, __ATOMIC_RELAXED, __HIP_MEMORY_SCOPE_AGENT);
                        __syncthreads();
                        u = (int)MISC[16];
                        if (u >= N_MLA + N_NA) {
                            const int c = u - (N_MLA + N_NA);
                            if (G != 256 || c >= (CV_MAIN0 + CV_CHUNK - 1) / CV_CHUNK) break;
                            const int ln = threadIdx.x & 63, wv = __builtin_amdgcn_readfirstlane((int)threadIdx.x >> 6), hi_ = (c + 1) * CV_CHUNK < CV_MAIN0 ? (c + 1) * CV_CHUNK : CV_MAIN0;
                            convert_experts(P.ec_w_gate, P.ec_w_up, P.ec_w_down, P.norm_ffn, Wgu, Wd, (LAS float*)ldsl, wv, NWAVES, ln, c * CV_CHUNK, hi_);
                            __syncthreads();
                            continue;
                        }
                    }
                    if (u < N_MLA) { if (EN(6)) {
                        int b, h, qb, sp; if (u < 1024) { const int bh = u >> 6; b = bh >> 3; h = bh & 7; qb = u & 63; sp = -1; } else { const int v = u - 1024; const int bh = v >> 3; b = bh >> 3; h = bh & 7; qb = 64; sp = v & 7; }
                        att::PolMLA pol; pol.init(Kc, Vm, Qb, AO, PART, rope, b, h, qb, sp);
                        att::attn_unit<192, 128>(pol, (char*)lds); }
                    } else if (EN(7)) {
                        const int v = u - N_MLA; int b, h, qb; if (v < 1024) { const int bh = v >> 6; b = bh >> 3; h = bh & 7; qb = v & 63; } else { const int bh = v - 1024; b = bh >> 3; h = bh & 7; qb = 64; }
                        for (int i = threadIdx.x; i < 15 * 31; i += NTHREADS) tab[i] = P.ab_rpb[h * 465 + i] * LOG2E;
                        __syncthreads();
                        att::PolNA pol; pol.init(Z, AO, tab, b, h, qb);
                        att::attn_unit<128, 128>(pol, (char*)lds);
                    }
                }
            }
            GRID_BAR();
            {
                PH_IDS();
                const float* PART = (const float*)(wsl + WS_PART);
                for (int it = gw; it < 2 * 8 * 16; it += NGW) {
                    const int row = it & 15, bh = it >> 4, b = bh >> 3, h = bh & 7;
                    const float* pp = PART + ((size_t)(bh * 8) * 16 + row) * 132;
                    float M = -3e38f;
#pragma unroll
                    for (int sp = 0; sp < 8; ++sp) M = fmaxf(M, pp[(size_t)sp * 16 * 132 + 128]);
                    float L = 0.f, o0 = 0.f, o1 = 0.f;
#pragma unroll
                    for (int sp = 0; sp < 8; ++sp) { const float* q = pp + (size_t)sp * 16 * 132; const float w = __builtin_amdgcn_exp2f(q[128] - M); L += w * q[129]; o0 += w * q[lane]; o1 += w * q[64 + lane]; }
                    const float rl = 1.0f / L; bf16* op = AO + (size_t)(RMETA + 16 * b + row) * AOW + h * 128;
                    op[lane] = (bf16)f2bf(o0 * rl); op[64 + lane] = (bf16)f2bf(o1 * rl);
                }
            }
        } else {
            WSL();
            if (EN(8)) {
                const int wv = __builtin_amdgcn_readfirstlane((int)threadIdx.x >> 6);
                for (int u = vcu; u < 4096; u += G) {
                    att::PolSWAG pol; pol.init(Z, AO, P.c_sinks, u >> 11, (u >> 9) & 3, u & 511, wv);
                    att::attn_unit<64, 64>(pol, (char*)lds);
                }
                for (int u = vcu; u < 64; u += G) {
                    att::PolSWA pol; pol.init(Z, AO, P.c_sinks, u >> 5, u & 31, 64);
                    att::attn_unit<64, 64>(pol, (char*)lds);
                }
            }
        }
        GRID_BAR();
        if (EN(9)) {
            WSL();
            pg8::Gemm g{AO, layer == 0 ? Wout0 : Wout1, AOW, D, D};
            pg8::TileOrder S; S.init(NR / 256, 8, G, bx, 0);
            pg8::EpiResid E{Hm, D, layer == 0 ? P.x : nullptr, P.meta};
            pg8::gemm_phase(ldsl, g, S, E);
            if (G == 256) {
                const int rem = (129 * 8) % 256;
                if (bx >= rem) { PH_IDS(); const size_t lo = (size_t)layer * NE * D * D;
                    convert_experts(P.ec_w_gate + lo, P.ec_w_up + lo, P.ec_w_down + lo, P.norm_ffn + (size_t)layer * D, Wgu, Wd, (LAS float*)ldsl, (bx - rem) * NWAVES + wave, (256 - rem) * NWAVES, lane, CV_ITEMS - CV_OUT, CV_ITEMS); }
            }
        }
        GRID_BAR();
        if (EN(10)) {
            PH_IDS();
            LAS float* wb = (LAS float*)ldsl;
            LAS float* red = (LAS float*)(ldsl + 131072);
            const float* wsrc = P.ec_w_router + (size_t)layer * D * NE; const float* gf = P.norm_ffn + (size_t)layer * D;
            for (int i = tid; i < D * 4; i += NTHREADS) { const int k = i >> 2, eg = i & 3; const f32x4 w4 = *(const f32x4*)(wsrc + (size_t)k * NE + 4 * eg) * gf[k];
                const int base = ((k >> 2) * 16 + 4 * eg) * 4 + (k & 3);
                wb[base] = w4.x; wb[base + 4] = w4.y; wb[base + 8] = w4.z; wb[base + 12] = w4.w; }
            __syncthreads();
            const int r = lane & 15, kq = lane >> 4;
            u32x4 hv[8];
            { const bf16* hp = Hm + (size_t)(vcu * 16 + r) * D + 256 * wave + 8 * kq;
#pragma unroll
              for (int i = 0; i < 8; ++i) hv[i] = *(const u32x4*)(hp + 32 * i); }
            for (int blk = vcu; blk < NTOK / 16; blk += G) {
                const int row0 = blk * 16;
                f32x4 acc = {0.f, 0.f, 0.f, 0.f}; float ss = 0.f;
#pragma unroll
                for (int i = 0; i < 8; ++i) {
                    const LAS f32x4* bp = (const LAS f32x4*)wb + (((wave * 8 + i) * 4 + kq) * 2) * 16 + r;
                    const f32x4 b0 = bp[0], b1 = bp[16];
                    const float a0 = bflo(hv[i].x), a1 = bfhi(hv[i].x), a2 = bflo(hv[i].y), a3 = bfhi(hv[i].y), a4 = bflo(hv[i].z), a5 = bfhi(hv[i].z), a6 = bflo(hv[i].w), a7 = bfhi(hv[i].w);
                    acc = __builtin_amdgcn_mfma_f32_16x16x4f32(a0, b0.x, acc, 0, 0, 0); acc = __builtin_amdgcn_mfma_f32_16x16x4f32(a1, b0.y, acc, 0, 0, 0);
                    acc = __builtin_amdgcn_mfma_f32_16x16x4f32(a2, b0.z, acc, 0, 0, 0); acc = __builtin_amdgcn_mfma_f32_16x16x4f32(a3, b0.w, acc, 0, 0, 0);
                    acc = __builtin_amdgcn_mfma_f32_16x16x4f32(a4, b1.x, acc, 0, 0, 0); acc = __builtin_amdgcn_mfma_f32_16x16x4f32(a5, b1.y, acc, 0, 0, 0);
                    acc = __builtin_amdgcn_mfma_f32_16x16x4f32(a6, b1.z, acc, 0, 0, 0); acc = __builtin_amdgcn_mfma_f32_16x16x4f32(a7, b1.w, acc, 0, 0, 0);
                    ss += (a0 * a0 + a1 * a1) + (a2 * a2 + a3 * a3) + (a4 * a4 + a5 * a5) + (a6 * a6 + a7 * a7);
                }
                if (blk + G < NTOK / 16) {
                    const bf16* hp = Hm + (size_t)((blk + G) * 16 + r) * D + 256 * wave + 8 * kq;
#pragma unroll
                    for (int i = 0; i < 8; ++i) hv[i] = *(const u32x4*)(hp + 32 * i); }
                ss += __shfl_xor(ss, 16); ss += __shfl_xor(ss, 32);
                LAS float* rw = red + wave * 272;
                *(LAS f32x4*)(rw + 4 * lane) = acc;
                if (lane < 16) rw[256 + lane] = ss;
                __syncthreads();
                if (wave == 0) {
                    f32x4 lg = {0.f, 0.f, 0.f, 0.f}; float sq[4] = {0.f, 0.f, 0.f, 0.f};
#pragma unroll
                    for (int w = 0; w < 8; ++w) { lg = lg + *(const LAS f32x4*)(red + w * 272 + 4 * lane);
#pragma unroll
                        for (int j = 0; j < 4; ++j) sq[j] += red[w * 272 + 256 + 4 * kq + j]; }
#pragma unroll
                    for (int j = 0; j < 4; ++j) {
                        const int row = row0 + 4 * kq + j; const float rs = 1.0f / sqrtf(sq[j] * (1.f / D) + EPS);
                        const float x = lg[j] * rs;
                        float mx = x; mx = fmaxf(mx, __shfl_xor(mx, 1)); mx = fmaxf(mx, __shfl_xor(mx, 2)); mx = fmaxf(mx, __shfl_xor(mx, 4)); mx = fmaxf(mx, __shfl_xor(mx, 8));
                        const float p = __expf(x - mx); float sum = p;
                        sum += __shfl_xor(sum, 1); sum += __shfl_xor(sum, 2); sum += __shfl_xor(sum, 4); sum += __shfl_xor(sum, 8);
                        const int b = row < RMETA ? (row >> 14) : ((row - RMETA) >> 4); const int tok = row < RMETA ? NMETA + (row & (SEQ - 1)) : ((row - RMETA) & 15);
                        aff[(size_t)(b * NE + r) * LTOK + tok] = p / sum;
                        if (r == 0) rsf[row] = rs;
                    }
                }
                __syncthreads();
            }
        }
        GRID_BAR();
        if (EN(11) && vcu < 32) {
            PH_IDS();
            const int be = vcu, b = be >> 4, e = be & 15;
            LAS unsigned* keys = (LAS unsigned*)ldsl;
            LAS unsigned* hist = (LAS unsigned*)(ldsl + 66560);
            LAS unsigned* sh = (LAS unsigned*)(ldsl + 66560 + 1024);
            const float* av = aff + (size_t)be * LTOK;
            for (int i = tid; i < LTOK; i += NTHREADS) keys[i] = __float_as_uint(av[i]);
            __syncthreads();
            const int i0 = tid * 33, i1 = (i0 + 33 < LTOK) ? i0 + 33 : LTOK;
            unsigned kv[33];
#pragma unroll
            for (int q = 0; q < 33; ++q) kv[q] = (i0 + q < LTOK) ? keys[i0 + q] : 0u;
            unsigned T = 0u;
            for (int bit = 30; bit >= 0; --bit) {
                const unsigned cand = T | (1u << bit); unsigned c = 0u;
#pragma unroll
                for (int q = 0; q < 33; ++q) c += 1u - ((kv[q] - cand) >> 31);
#pragma unroll
                for (int o = 1; o < 64; o <<= 1) c += __shfl_xor(c, o);
                LAS unsigned* slot = sh + 32 + (bit & 1) * 8;
                if (lane == 0) slot[wave] = c;
                __syncthreads();
                unsigned tot = 0u;
#pragma unroll
                for (int w = 0; w < 8; ++w) tot += slot[w];
                T |= (1u - ((tot - (unsigned)CAP) >> 31)) << bit;
            }
            unsigned cgt = 0u, ceq = 0u;
#pragma unroll
            for (int q = 0; q < 33; ++q) { const unsigned k = kv[q]; cgt += k > T ? 1u : 0u; ceq += (k == T && i0 + q < LTOK) ? 1u : 0u; }
            unsigned pk = cgt | (ceq << 16), incl = pk;
#pragma unroll
            for (int o = 1; o < 64; o <<= 1) { const unsigned t = __shfl_up(incl, o); if (lane >= o) incl += t; }
            if (lane == 63) sh[16 + wave] = incl;
            __syncthreads();
            unsigned wbase = 0u, totgt = 0u;
            for (int w = 0; w < 8; ++w) { const unsigned x = sh[16 + w]; totgt += x & 0xffffu; if (w < wave) wbase += x; }
            const unsigned krem = (unsigned)CAP - totgt;
            const unsigned excl = wbase + incl - pk;
            unsigned ngt = excl & 0xffffu, neq = excl >> 16;
            int* tsl = tokslot + (size_t)be * LTOK; int* stk = slottok + (size_t)be * CAP; float* xg = xgate + (size_t)e * XPE + b * CAP; int* xm = xmap + (size_t)e * XPE + b * CAP; float* xr = xrs + (size_t)e * XPE + b * CAP;
            for (int i = i0; i < i1; ++i) { const unsigned k = keys[i]; bool sel = k > T; if (k == T) { sel = neq < krem; }
                int slot = -1;
                if (sel) { slot = (int)(ngt + (neq < krem ? neq : krem)); if (slot < CAP) { const int trow = i < NMETA ? RMETA + 16 * b + i : b * SEQ + (i - NMETA); stk[slot] = trow; xm[slot] = trow; xg[slot] = __uint_as_float(k); xr[slot] = rsf[trow]; } else slot = -1; }
                if (k > T) ++ngt; if (k == T) ++neq;
                tsl[i] = slot; }
            if (b == 1) for (int i = tid; i < XPE - 2 * CAP; i += NTHREADS) { xgate[(size_t)e * XPE + 2 * CAP + i] = 0.f; xmap[(size_t)e * XPE + 2 * CAP + i] = NR - 1; xrs[(size_t)e * XPE + 2 * CAP + i] = 0.f; }
        }
        else if (EN(11) && G == 256) {
            PH_IDS(); const int cin = layer == 0 ? CV_IN0 : CV_IN1, hi_ = CV_ITEMS - CV_OUT - cin; const size_t lo = (size_t)layer * NE * D * D;
            convert_experts(P.ec_w_gate + lo, P.ec_w_up + lo, P.ec_w_down + lo, P.norm_ffn + (size_t)layer * D, Wgu, Wd, (LAS float*)ldsl, (vcu - 32) * NWAVES + wave, 224 * NWAVES, lane, hi_ - CV_TOPK, hi_);
        }
        GRID_BAR();
        if (EN(13)) {
            WSL();
            pg8::Gemm g{Hm, Wgu, D, D, D, xmap};
            pg8::TileOrder S; S.init(XROWS / 256, 16, G, bx, 17);
            pg8::EpiSwiGLU E{HMID, D, xrs};
            pg8::gemm_phase<true>(ldsl, g, S, E);
        }
        GRID_BAR();
        if (EN(14)) {
            WSL();
            pg8::Gemm g{HMID, Wd, D, D, D};
            pg8::TileOrder S; S.init(XROWS / 256, 8, G, bx, 17);
            pg8::EpiBf16S E{XS, D, xgate, 0, 0, 1.f};
            pg8::gemm_phase(ldsl, g, S, E);
        }
        GRID_BAR();
        if (EN(15)) {
            PH_IDS();
            const float* gn = layer == 0 ? P.norm_mix + D : P.norm_final;
            for (int row = gw; row < (layer == 0 ? NTOK : RMETA); row += NGW) {
                const int b = row < RMETA ? (row >> 14) : ((row - RMETA) >> 4); const int tok = row < RMETA ? NMETA + (row & (SEQ - 1)) : ((row - RMETA) & 15);
                f32x4 v[8]; bf16* hrow = Hm + (size_t)row * D; load_row_bf16(hrow, lane, v);
                int sl[NE];
#pragma unroll
                for (int e = 0; e < NE; ++e) sl[e] = tokslot[(size_t)(b * NE + e) * LTOK + tok];
                int cnt = 0, o0 = 0, o1 = 0, o2 = 0, o3 = 0;
#pragma unroll
                for (int e = 0; e < NE; ++e) {
                    const int s = __builtin_amdgcn_readfirstlane(sl[e]); const int ok = s >= 0 ? 1 : 0, xr_ = e * XPE + b * CAP + s;
                    o0 = (ok && cnt == 0) ? xr_ : o0; o1 = (ok && cnt == 1) ? xr_ : o1; o2 = (ok && cnt == 2) ? xr_ : o2; o3 = (ok && cnt == 3) ? xr_ : o3; cnt += ok;
                }
                { const float w0 = cnt > 0 ? 1.f : 0.f, w1 = cnt > 1 ? 1.f : 0.f, w2 = cnt > 2 ? 1.f : 0.f, w3 = cnt > 3 ? 1.f : 0.f;
                  o1 = cnt > 1 ? o1 : o0; o2 = cnt > 2 ? o2 : o0; o3 = cnt > 3 ? o3 : o0;
                  const u32x2* p0 = (const u32x2*)(XS + (size_t)o0 * D) + lane; const u32x2* p1 = (const u32x2*)(XS + (size_t)o1 * D) + lane;
                  const u32x2* p2 = (const u32x2*)(XS + (size_t)o2 * D) + lane; const u32x2* p3 = (const u32x2*)(XS + (size_t)o3 * D) + lane;
                  u32x2 y0[8], y1[8], y2[8], y3[8];
#pragma unroll
                  for (int j = 0; j < 8; ++j) { y0[j] = p0[64 * j]; y1[j] = p1[64 * j]; y2[j] = p2[64 * j]; y3[j] = p3[64 * j]; }
#pragma unroll
                  for (int j = 0; j < 8; ++j) {
                      v[j].x += (w0 * bflo(y0[j].x) + w1 * bflo(y1[j].x)) + (w2 * bflo(y2[j].x) + w3 * bflo(y3[j].x)); v[j].y += (w0 * bfhi(y0[j].x) + w1 * bfhi(y1[j].x)) + (w2 * bfhi(y2[j].x) + w3 * bfhi(y3[j].x));
                      v[j].z += (w0 * bflo(y0[j].y) + w1 * bflo(y1[j].y)) + (w2 * bflo(y2[j].y) + w3 * bflo(y3[j].y)); v[j].w += (w0 * bfhi(y0[j].y) + w1 * bfhi(y1[j].y)) + (w2 * bfhi(y2[j].y) + w3 * bfhi(y3[j].y)); } }
                if (cnt > 4) {
                    int seen = 0;
#pragma unroll
                    for (int e = 0; e < NE; ++e) {
                        const int s = __builtin_amdgcn_readfirstlane(sl[e]);
                        if (s >= 0) { if (seen >= 4) { const u32x2* yp = (const u32x2*)(XS + (size_t)(e * XPE + b * CAP + s) * D) + lane;
#pragma unroll
                            for (int j = 0; j < 8; ++j) { const u32x2 w = yp[64 * j]; v[j].x += bflo(w.x); v[j].y += bfhi(w.x); v[j].z += bflo(w.y); v[j].w += bfhi(w.y); } }
                          ++seen; }
                    }
                }
                const float rs = row_rs(v);
                if (layer == 0) {
                    store_row_bf16(hrow, lane, v);
                    if (lane == 0) rsm[row] = rs;
                } else {
                    const f32x4* gp = (const f32x4*)gn + lane; f32x4* op = (f32x4*)(P.out + (size_t)row * D) + lane;
#pragma unroll
                    for (int j = 0; j < 8; ++j) op[64 * j] = v[j] * rs * gp[64 * j];
                }
            }
            if (layer == 0) {
                LAS float* scr = (LAS float*)(ldsl + wave * 16640);
                const size_t lo = (size_t)NE * D * D;
                convert_experts(P.ec_w_gate + lo, P.ec_w_up + lo, P.ec_w_down + lo, P.norm_ffn + D, Wgu, Wd, scr, gw, NGW, lane, 0, G == 256 ? CV_ITEMS - CV_IN1 - CV_OUT - CV_TOPK : CV_ITEMS);
            }
        }
        if (layer == 0) GRID_BAR();
    }
#undef GRID_BAR
}

extern "C" void kernel_launch(void* const* d_in, const int* in_sizes, int n_in, void* d_out, int out_size, void* d_ws, size_t ws_size, hipStream_t stream) {
    static int grid = 0;
    if (grid == 0) {
        if (n_in != 19 || ws_size < WS_END) { fprintf(stderr, "kernel_launch: unexpected n_in %d / ws %zu (need %zu)\n", n_in, ws_size, (size_t)WS_END); grid = -1; return; }
        int dev = 0, cus = 0, per_cu = 0;
        if (hipGetDevice(&dev) != hipSuccess || hipDeviceGetAttribute(&cus, hipDeviceAttributeMultiprocessorCount, dev) != hipSuccess) { grid = -1; return; }
        if (hipFuncSetAttribute((const void*)fwd_kernel, hipFuncAttributeMaxDynamicSharedMemorySize, LDS_BYTES) != hipSuccess) { fprintf(stderr, "kernel_launch: hipFuncSetAttribute failed\n"); grid = -1; return; }
        if (hipOccupancyMaxActiveBlocksPerMultiprocessor(&per_cu, (const void*)fwd_kernel, NTHREADS, LDS_BYTES) != hipSuccess || per_cu < 1) { fprintf(stderr, "kernel_launch: occupancy query reports %d\n", per_cu); }
        (void)hipGetLastError();
        grid = cus;
    }
    if (grid < 0) return;
    if (hipMemsetAsync((char*)d_ws + WS_CTL, 0, CTL_BYTES, stream) != hipSuccess) return;
    Params p{};
    p.x = (const float*)d_in[0]; p.meta = (const float*)d_in[1]; p.norm_mix = (const float*)d_in[2]; p.norm_ffn = (const float*)d_in[3]; p.norm_final = (const float*)d_in[4];
    p.ab_w_in = (const float*)d_in[5]; p.ab_q_norm = (const float*)d_in[6]; p.ab_kv_norm = (const float*)d_in[7]; p.ab_w_uq = (const float*)d_in[8]; p.ab_w_ukv = (const float*)d_in[9];
    p.ab_rpb = (const float*)d_in[10]; p.ab_w_out = (const float*)d_in[11]; p.c_w_in = (const float*)d_in[12]; p.c_sinks = (const float*)d_in[13]; p.c_w_out = (const float*)d_in[14];
    p.ec_w_router = (const float*)d_in[15]; p.ec_w_gate = (const float*)d_in[16]; p.ec_w_up = (const float*)d_in[17]; p.ec_w_down = (const float*)d_in[18];
    p.out = (float*)d_out; p.ws = (unsigned char*)d_ws;
    hipLaunchKernelGGL(fwd_kernel, dim3(grid), dim3(NTHREADS), LDS_BYTES, stream, p);
    const hipError_t le = hipPeekAtLastError();
    if (le != hipSuccess) fprintf(stderr, "kernel_launch: launch failed: %s\n", hipGetErrorName(le));
}
```

```cpp
#include <hip/hip_runtime.h>
#include <cstdio>
#include <cstdint>

#define GAS __attribute__((address_space(1)))
#define LAS __attribute__((address_space(3)))
typedef unsigned short bf16;
typedef short bf16x8 __attribute__((ext_vector_type(8)));
typedef short s16x4 __attribute__((ext_vector_type(4)));
typedef float f32x2 __attribute__((ext_vector_type(2)));
typedef float f32x4 __attribute__((ext_vector_type(4)));
typedef float f32x16 __attribute__((ext_vector_type(16)));
typedef unsigned u32x2 __attribute__((ext_vector_type(2)));
typedef unsigned u32x4 __attribute__((ext_vector_type(4)));

constexpr int D = 2048, NBATCH = 2, SEQ = 16384, NMETA = 16, LTOK = 16400, NTOK = 32800, NR = 33024, RMETA = 32768;
constexpr int ZW = 4352, ZQL = 0, ZKVL = 512, ZNAQ = 1024, ZNAK = 2048, ZNAV = 3072, ZKR = 4096;
constexpr int QW = 1536, KCW = 1536, VMW = 1024, Z1W = 2560, AOW = 2048;
constexpr int NE = 16, CAP = 2050, XPE = 4352, XROWS = NE * XPE;
constexpr float EPS = 1e-6f, LOG2E = 1.4426950408889634f;
constexpr float C_MLA = 0.07216878364870322f * LOG2E, C_NA = 0.08838834764831845f * LOG2E, C_SWA = 0.125f * LOG2E;
constexpr int NWAVES = 8, NTHREADS = 512;

constexpr size_t al256(size_t x) { return (x + 255) & ~(size_t)255; }
constexpr size_t WS_CTL = 0, CTL_BYTES = 1u << 20;
constexpr size_t WS_ROPE = WS_CTL + CTL_BYTES;
constexpr size_t WS_RSQ = al256(WS_ROPE + (size_t)LTOK * 32 * 2 * 4);
constexpr size_t WS_RSKV = al256(WS_RSQ + (size_t)NR * 4);
constexpr size_t WS_AFF = al256(WS_RSKV + (size_t)NR * 4);
constexpr size_t WS_TOKSLOT = al256(WS_AFF + (size_t)32 * LTOK * 4);
constexpr size_t WS_SLOTTOK = al256(WS_TOKSLOT + (size_t)32 * LTOK * 4);
constexpr size_t WS_XGATE = al256(WS_SLOTTOK + (size_t)32 * CAP * 4);
constexpr size_t WS_XMAP = al256(WS_XGATE + (size_t)XROWS * 4);
constexpr size_t WS_PART = al256(WS_XMAP + (size_t)XROWS * 4);
constexpr size_t WS_WIN0 = al256(WS_PART + (size_t)2 * 8 * 8 * 16 * 132 * 4);
constexpr size_t WS_WUQ = al256(WS_WIN0 + (size_t)ZW * D * 2);
constexpr size_t WS_WUKV = al256(WS_WUQ + (size_t)1536 * 512 * 2);
constexpr size_t WS_WOUT0 = al256(WS_WUKV + (size_t)2048 * 512 * 2);
constexpr size_t WS_WIN1 = al256(WS_WOUT0 + (size_t)D * D * 2);
constexpr size_t WS_WOUT1 = al256(WS_WIN1 + (size_t)Z1W * D * 2);
constexpr size_t WS_WGU = al256(WS_WOUT1 + (size_t)D * D * 2);
constexpr size_t WS_WD = al256(WS_WGU + (size_t)NE * 4096 * D * 2);
constexpr size_t WS_H = al256(WS_WD + (size_t)NE * D * D * 2);
constexpr size_t WS_RSF = al256(WS_H + (size_t)NR * D * 2);
constexpr size_t WS_XRS = al256(WS_RSF + (size_t)NR * 4);
constexpr size_t WS_RSM = al256(WS_XRS + (size_t)XROWS * 4);
static_assert(WS_RSM + (size_t)NR * 4 <= WS_H + (size_t)NR * D * 4, "h region");
constexpr size_t WS_U = al256(WS_H + (size_t)NR * D * 4);
constexpr size_t WS_R = al256(WS_U + (size_t)NR * D * 2);
constexpr size_t WS_Z = WS_R;
constexpr size_t WS_Q = al256(WS_Z + (size_t)NR * ZW * 2);
constexpr size_t WS_KC = al256(WS_Q + (size_t)NR * QW * 2);
constexpr size_t WS_VM = al256(WS_KC + (size_t)NR * KCW * 2);
constexpr size_t WS_AO = al256(WS_VM + (size_t)NR * VMW * 2);
constexpr size_t WS_END_ATT = al256(WS_AO + (size_t)NR * AOW * 2);
constexpr size_t WS_XS = WS_R;
constexpr size_t WS_HMID = al256(WS_XS + (size_t)XROWS * D * 2);
constexpr size_t WS_END_MOE = al256(WS_HMID + (size_t)XROWS * D * 2);
constexpr size_t WS_END = WS_END_ATT > WS_END_MOE ? WS_END_ATT : WS_END_MOE;
static_assert(WS_END < (size_t)2000 * 1024 * 1024, "workspace map must fit 2 GiB with margin");

constexpr int CW_BAR = 4096, CW_TICKET = 65536;

constexpr int LDS_BYTES = 147456;
constexpr int MISC_OFF = 147456 - 256;

__device__ __forceinline__ unsigned f2bf(float f) { unsigned u = __builtin_bit_cast(unsigned, f); return (u + 0x7fffu + ((u >> 16) & 1u)) >> 16; }
__device__ __forceinline__ unsigned pk2(float lo, float hi) { return f2bf(lo) | (f2bf(hi) << 16); }
__device__ __forceinline__ float bf2f(unsigned short x) { return __builtin_bit_cast(float, (unsigned)x << 16); }
__device__ __forceinline__ float bflo(unsigned w) { return __builtin_bit_cast(float, w << 16); }
__device__ __forceinline__ float bfhi(unsigned w) { return __builtin_bit_cast(float, w & 0xffff0000u); }
__device__ __forceinline__ float wave_sum(float v) {
#pragma unroll
    for (int o = 1; o < 64; o <<= 1) v += __shfl_xor(v, o);
    return v;
}
#define LDS_WAIT() asm volatile("s_waitcnt lgkmcnt(0)" ::: "memory")

#define XB_TMO      128
#define XB_XCNT(j)  (256  + 64 * (j))
#define XB_XSUB(j)  (1280 + 64 * (j))
#define XB_XGEN(j)  (2304 + 64 * (j))
#define XB_TOP      3328
#define XB_TOPGEN   3392
#define XCD_BAR_WORDS 3456
#define XB_SPIN_CAP (1u << 22)

__device__ __forceinline__ unsigned xb_ld(unsigned* p)              { return __hip_atomic_load(p, __ATOMIC_RELAXED, __HIP_MEMORY_SCOPE_AGENT); }
__device__ __forceinline__ unsigned xb_add(unsigned* p, unsigned v) { return __hip_atomic_fetch_add(p, v, __ATOMIC_RELAXED, __HIP_MEMORY_SCOPE_AGENT); }
__device__ __forceinline__ unsigned xb_xcc_id() { return (unsigned)__builtin_amdgcn_readfirstlane((int)((unsigned)__builtin_amdgcn_s_getreg((3 << 11) | 20) & 0xFu)); }
#define XB_SPIN(cond, bar) do { unsigned _sp = 0; while (cond) { __builtin_amdgcn_s_sleep(1); \
    if ((++_sp & 255u) == 0u) { if (xb_ld(&(bar)[XB_TMO])) break; if (_sp > XB_SPIN_CAP) { atomicAdd(&(bar)[XB_TMO], 1u); break; } } } } while (0)

struct XcdBarrier { unsigned* bar; unsigned x; volatile LAS unsigned* st; };

__device__ __forceinline__ XcdBarrier xcd_barrier_post(unsigned* bar, volatile LAS unsigned* st) {
    XcdBarrier b; b.bar = bar; b.x = xb_xcc_id(); b.st = st;
    if (threadIdx.x == 0) (void)xb_add(&bar[XB_XCNT(b.x)], 1u);
    return b;
}
__device__ __forceinline__ void xcd_barrier_complete(unsigned* bar, unsigned x, unsigned& nloc, unsigned& nx) {
    const unsigned G = gridDim.x * gridDim.y * gridDim.z;
    unsigned sum, cnt, mine, sp = 0u;
    for (;;) {
        sum = 0u; cnt = 0u; mine = 0u;
#pragma unroll
        for (unsigned j = 0; j < 16; ++j) { const unsigned c = xb_ld(&bar[XB_XCNT(j)]); sum += c; cnt += (c > 0u) ? 1u : 0u; mine = (j == x) ? c : mine; }
        if (sum == G) break;
        __builtin_amdgcn_s_sleep(1);
        if ((++sp & 255u) == 0u) { if (xb_ld(&bar[XB_TMO])) break; if (sp > XB_SPIN_CAP) { atomicAdd(&bar[XB_TMO], 1u); break; } }
    }
    nloc = mine > 0u ? mine : 1u; nx = cnt > 0u ? cnt : 1u;
}
__device__ __forceinline__ void xcd_barrier(const XcdBarrier& b) {
    asm volatile("s_waitcnt vmcnt(0)" ::: "memory");
    __syncthreads();
    if (threadIdx.x == 0) {
        unsigned* bar = b.bar; asm volatile("" : "+s"(bar));
        __builtin_amdgcn_s_waitcnt(0);
        const unsigned bx_ = xb_xcc_id();
        unsigned nloc = b.st[0], nx = b.st[1];
        if (nloc == 0u) { xcd_barrier_complete(bar, bx_, nloc, nx); b.st[0] = nloc; b.st[1] = nx; }
        const unsigned old = xb_add(&bar[XB_XSUB(bx_)], 1u);
        const unsigned gen = old / nloc;
        if (old + 1u == (gen + 1u) * nloc) {
            __builtin_amdgcn_fence(__ATOMIC_RELEASE, "agent");
            asm volatile("s_waitcnt vmcnt(0)" ::: "memory");
            const unsigned og = xb_add(&bar[XB_TOP], 1u);
            const unsigned tg = og / nx;
            if (og + 1u == (tg + 1u) * nx) xb_add(&bar[XB_TOPGEN], 1u);
            else XB_SPIN(xb_ld(&bar[XB_TOPGEN]) == tg, bar);
            __builtin_amdgcn_fence(__ATOMIC_ACQUIRE, "agent");
            xb_add(&bar[XB_XGEN(bx_)], 1u);
            asm volatile("s_waitcnt vmcnt(0)" ::: "memory");
        } else {
            XB_SPIN(xb_ld(&bar[XB_XGEN(bx_)]) == gen, bar);
            __builtin_amdgcn_fence(__ATOMIC_ACQUIRE, "agent");
            asm volatile("s_waitcnt vmcnt(0)" ::: "memory");
        }
    }
    __syncthreads();
}

namespace pg8 {
constexpr int BM = 256, BK = 64, HALF = 128, HTB = HALF * BK * 2, STAGE_BYTES = 8 * HTB, NXCD = 8, WGM = 8;
__host__ __device__ __forceinline__ int lds_byte(int r, int c) { const int st = (r >> 4) * 2 + (c >> 5), rr = r & 15, cc = c & 31, ob = rr * 64 + cc * 2; return st * 1024 + (ob ^ (((ob >> 9) & 1) << 5)); }
__host__ __device__ __forceinline__ void stage_rc(int b, int& R, int& C) { const int st = b / 1024, sb = b % 1024, swz = sb ^ (((sb >> 9) & 1) << 5); R = (st >> 1) * 16 + swz / 64; C = (st & 1) * 32 + (swz % 64) / 2; }
__host__ __device__ __forceinline__ int perm32(int rho) { const int n = rho >> 4, i = rho & 15; return 8 * (i >> 2) + 4 * n + (i & 3); }

struct Unit { int pm, pn, pb; };
struct Gemm { const bf16* A; const bf16* Bt; int lda, ldb, K; const int* amap; };

struct TileOrder {
    int nM, nN, nwg, G, c, grp;
    __device__ void init(int nM_, int nN_, int G_, int c_, int grp_) { nM = nM_; nN = nN_; nwg = nM * nN; G = G_; c = c_; grp = grp_; }
    __device__ bool next(int i, Unit& u) const {
        const long L = (long)i * G + c; if (L >= nwg) return false;
        int wgid = (int)L; { const int q = nwg / NXCD, r = nwg % NXCD, xcd = wgid % NXCD, off = wgid / NXCD; wgid = (xcd < r ? xcd * (q + 1) : r * (q + 1) + (xcd - r) * q) + off; }
        const int nig = WGM * nN, gid = wgid / nig, fm = gid * WGM, gsz = (nM - fm) < WGM ? (nM - fm) : WGM;
        u.pm = fm + ((wgid % nig) % gsz); u.pn = (wgid % nig) / gsz; u.pb = grp ? (u.pm / grp) * nN + u.pn : u.pn; return true;
    }
};

__device__ __forceinline__ unsigned cvt_pk_bf16(float lo, float hi) { unsigned r; asm volatile("v_cvt_pk_bf16_f32 %0, %1, %2" : "=v"(r) : "v"(lo), "v"(hi)); return r; }

struct EpiBf16S {
    static constexpr bool PERM = true;
    bf16* O; int ldc; const float* rowscale; int cs_lo, cs_hi; float cscale;
    __device__ __forceinline__ void operator()(const f32x4 (&acc)[2][2][4][2], const Unit& u, int wr, int wc, int fr, int fq) const {
        const int row0 = u.pm * BM + wr * 64 + fr, col0 = u.pn * BM + wc * 32 + 8 * fq;
        const float cs = (u.pn >= cs_lo && u.pn < cs_hi) ? cscale : 1.f;
#pragma unroll
        for (int ai = 0; ai < 2; ++ai)
#pragma unroll
            for (int m = 0; m < 4; ++m) { const int row = row0 + ai * HALF + m * 16; const float s = (rowscale ? rowscale[row] : 1.f) * cs; bf16* rowp = O + (size_t)row * ldc + col0;
#pragma unroll
                for (int bj = 0; bj < 2; ++bj) { const f32x4 v0 = acc[ai][bj][m][0] * s, v1 = acc[ai][bj][m][1] * s;
                    u32x4 w; w.x = cvt_pk_bf16(v0[0], v0[1]); w.y = cvt_pk_bf16(v0[2], v0[3]); w.z = cvt_pk_bf16(v1[0], v1[1]); w.w = cvt_pk_bf16(v1[2], v1[3]);
                    *(u32x4*)(rowp + bj * HALF) = w; } }
    }
};
struct EpiKV {
    static constexpr bool PERM = true;
    bf16* Kc; bf16* Vm; const float* rowscale;
    __device__ __forceinline__ void operator()(const f32x4 (&acc)[2][2][4][2], const Unit& u, int wr, int wc, int fr, int fq) const {
        const int row0 = u.pm * BM + wr * 64 + fr, cc = wc * 32 + 8 * fq;
#pragma unroll
        for (int ai = 0; ai < 2; ++ai)
#pragma unroll
            for (int m = 0; m < 4; ++m) { const int row = row0 + ai * HALF + m * 16; const float s = rowscale[row];
#pragma unroll
                for (int bj = 0; bj < 2; ++bj) { const f32x4 v0 = acc[ai][bj][m][0] * s, v1 = acc[ai][bj][m][1] * s;
                    u32x4 w; w.x = cvt_pk_bf16(v0[0], v0[1]); w.y = cvt_pk_bf16(v0[2], v0[3]); w.z = cvt_pk_bf16(v1[0], v1[1]); w.w = cvt_pk_bf16(v1[2], v1[3]);
                    bf16* p = bj == 0 ? Kc + (size_t)row * KCW + u.pn * 192 + cc : Vm + (size_t)row * VMW + u.pn * 128 + cc;
                    *(u32x4*)p = w; } }
    }
};
struct EpiResid {
    static constexpr bool PERM = true;
    bf16* Hm; int ldc; const float* X; const float* Mt;
    __device__ __forceinline__ void operator()(const f32x4 (&acc)[2][2][4][2], const Unit& u, int wr, int wc, int fr, int fq) const {
        const int row0 = u.pm * BM + wr * 64 + fr, col0 = u.pn * BM + wc * 32 + 8 * fq;
#pragma unroll
        for (int ai = 0; ai < 2; ++ai)
#pragma unroll
            for (int m = 0; m < 4; ++m) { const int row = row0 + ai * HALF + m * 16; bf16* rowp = Hm + (size_t)row * ldc + col0;
                if (X) {
                    const float* sp = (row < RMETA ? X + (size_t)row * ldc : Mt + (size_t)((row - RMETA) & 15) * ldc) + col0; const float z = row < NTOK ? 1.f : 0.f;
#pragma unroll
                    for (int bj = 0; bj < 2; ++bj) { const f32x4 v0 = *(const f32x4*)(sp + bj * HALF) * z + acc[ai][bj][m][0], v1 = *(const f32x4*)(sp + bj * HALF + 4) * z + acc[ai][bj][m][1];
                        u32x4 w; w.x = cvt_pk_bf16(v0[0], v0[1]); w.y = cvt_pk_bf16(v0[2], v0[3]); w.z = cvt_pk_bf16(v1[0], v1[1]); w.w = cvt_pk_bf16(v1[2], v1[3]);
                        *(u32x4*)(rowp + bj * HALF) = w; }
                } else {
#pragma unroll
                    for (int bj = 0; bj < 2; ++bj) { const u32x4 s = *(const u32x4*)(rowp + bj * HALF);
                        const f32x4 v0 = (f32x4){bflo(s.x), bfhi(s.x), bflo(s.y), bfhi(s.y)} + acc[ai][bj][m][0], v1 = (f32x4){bflo(s.z), bfhi(s.z), bflo(s.w), bfhi(s.w)} + acc[ai][bj][m][1];
                        u32x4 w; w.x = cvt_pk_bf16(v0[0], v0[1]); w.y = cvt_pk_bf16(v0[2], v0[3]); w.z = cvt_pk_bf16(v1[0], v1[1]); w.w = cvt_pk_bf16(v1[2], v1[3]);
                        *(u32x4*)(rowp + bj * HALF) = w; }
                }
            }
    }
};
struct EpiSwiGLU {
    static constexpr bool PERM = true;
    bf16* O; int ldc; const float* rowscale;
    __device__ __forceinline__ void operator()(const f32x4 (&acc)[2][2][4][2], const Unit& u, int wr, int wc, int fr, int fq) const {
        const int row0 = u.pm * BM + wr * 64 + fr, col0 = u.pn * HALF + wc * 32 + 8 * fq;
#pragma unroll
        for (int ai = 0; ai < 2; ++ai)
#pragma unroll
            for (int m = 0; m < 4; ++m) { const int row = row0 + ai * HALF + m * 16; bf16* rowp = O + (size_t)row * ldc + col0; float r[8]; const float rs = rowscale[row];
#pragma unroll
                for (int n = 0; n < 2; ++n)
#pragma unroll
                    for (int j = 0; j < 4; ++j) { const float g = acc[ai][0][m][n][j] * rs, up = acc[ai][1][m][n][j] * rs;
                        const float sg = g * __builtin_amdgcn_rcpf(1.f + __builtin_amdgcn_exp2f(-g * LOG2E)); r[n * 4 + j] = sg * up; }
                u32x4 w; w.x = cvt_pk_bf16(r[0], r[1]); w.y = cvt_pk_bf16(r[2], r[3]); w.z = cvt_pk_bf16(r[4], r[5]); w.w = cvt_pk_bf16(r[6], r[7]);
                *(u32x4*)rowp = w; }
    }
};

template <bool GATHER = false, class Epi, class Sched>
__device__ __forceinline__ void gemm_phase(LAS unsigned char* lds, const Gemm g, const Sched& S, const Epi& E) {
    int tid_ = threadIdx.x; asm volatile("" : "+v"(tid_));
    const int tid = tid_, wid = __builtin_amdgcn_readfirstlane(tid >> 6), lane = tid & 63, wr = wid >> 2, wc = wid & 3, fr = lane & 15, fq = lane >> 4;
    const int K = g.K, nt = K / BK;
    unsigned voffA[2], voffB[2];
#pragma unroll
    for (int i = 0; i < 2; ++i) { int R, C; stage_rc(tid * 16 + i * 8192, R, C); const int Rb = Epi::PERM ? ((R & ~31) + perm32(R & 31)) : R;
        voffA[i] = (unsigned)(R * g.lda + C) * 2u; voffB[i] = (unsigned)(Rb * g.ldb + C) * 2u; }
    int RA[2], CA[2];
#pragma unroll
    for (int i = 0; i < 2; ++i) stage_rc(tid * 16 + i * 8192, RA[i], CA[i]);
    unsigned offC[2][2], offN[2][2]; int rawN[2][2];
#define PG8_GRAW(pm_) do { _Pragma("unroll") for (int h_ = 0; h_ < 2; ++h_) _Pragma("unroll") for (int i_ = 0; i_ < 2; ++i_) rawN[h_][i_] = g.amap[(pm_) * BM + h_ * HALF + RA[i_]]; } while (0)
#define PG8_GCONV(dst) do { _Pragma("unroll") for (int h_ = 0; h_ < 2; ++h_) _Pragma("unroll") for (int i_ = 0; i_ < 2; ++i_) dst[h_][i_] = (unsigned)(rawN[h_][i_] * g.lda + CA[i_]) * 2u; } while (0)
    const size_t kstep = (size_t)(BK * 2);
    const size_t hstepA = (size_t)HALF * g.lda * 2, hstepB = (size_t)HALF * g.ldb * 2;
    const size_t tstepA = 2 * hstepA, tstepB = 2 * hstepB;
    const unsigned ldsw = (unsigned)wid * 1024u;
    const int aoff = lds_byte(wr * 64 + fr, fq * 8), boff = lds_byte(wc * 32 + fr, fq * 8);
#define PG8_SA(b, h) (((b) * 2 + (h)) * HTB)
#define PG8_SB(b, h) ((4 + (b) * 2 + (h)) * HTB)
#define PG8_STAGE(bufoff, gbase, voff) do { _Pragma("unroll") for (int _i = 0; _i < 2; ++_i) \
        __builtin_amdgcn_global_load_lds((const unsigned*)((const char*)(gbase) + (voff)[_i]), (LAS unsigned*)(lds + (bufoff) + ldsw + _i * 8192), 16, 0, 0); } while (0)
#define PG8_LDA(dst, b, h) do { _Pragma("unroll") for (int m = 0; m < 4; ++m) _Pragma("unroll") for (int k = 0; k < 2; ++k) dst[m][k] = *(const LAS bf16x8*)(lds + PG8_SA(b, h) + aoff + m * 2048 + k * 1024); } while (0)
#define PG8_LDB(dst, b, h) do { _Pragma("unroll") for (int n = 0; n < 2; ++n) _Pragma("unroll") for (int k = 0; k < 2; ++k) dst[n][k] = *(const LAS bf16x8*)(lds + PG8_SB(b, h) + boff + n * 2048 + k * 1024); } while (0)
#define PG8_MMA(ai, bj, At, Bt) do { __builtin_amdgcn_s_setprio(1); _Pragma("unroll") for (int m = 0; m < 4; ++m) _Pragma("unroll") for (int n = 0; n < 2; ++n) _Pragma("unroll") for (int k = 0; k < 2; ++k) \
        acc[ai][bj][m][n] = __builtin_amdgcn_mfma_f32_16x16x32_bf16(Bt[n][k], At[m][k], acc[ai][bj][m][n], 0, 0, 0); __builtin_amdgcn_s_setprio(0); } while (0)
#define PG8_WAIT_V(n) asm volatile("s_waitcnt vmcnt(" #n ")" ::: "memory")
#define PG8_WAIT_L(n) asm volatile("s_waitcnt lgkmcnt(" #n ")" ::: "memory")
#define PG8_BAR __builtin_amdgcn_s_barrier()
#define PG8_SCHED __builtin_amdgcn_sched_barrier(0)
    Unit cur, nxt; int ui = 0;
    if (!S.next(0, cur)) return;
    f32x4 acc[2][2][4][2];
#pragma unroll
    for (int a = 0; a < 2; ++a)
#pragma unroll
        for (int b = 0; b < 2; ++b)
#pragma unroll
            for (int m = 0; m < 4; ++m)
#pragma unroll
                for (int n = 0; n < 2; ++n) acc[a][b][m][n] = (f32x4){0.f, 0.f, 0.f, 0.f};
    bf16x8 At[4][2], B0[2][2], B1[2][2];
    const char* cA = GATHER ? (const char*)g.A : (const char*)g.A + (size_t)cur.pm * tstepA; const char* cB = (const char*)g.Bt + (size_t)cur.pb * tstepB;
    if constexpr (GATHER) { PG8_GRAW(cur.pm); PG8_GCONV(offC); }
#define PG8_STAGE_A(bufoff, kbase, h_, offs) do { if constexpr (GATHER) { PG8_STAGE(bufoff, kbase, offs[h_]); } else { PG8_STAGE(bufoff, (kbase) + (h_) * hstepA, voffA); } } while (0)
    PG8_STAGE(PG8_SB(0, 0), cB, voffB); PG8_STAGE(PG8_SB(0, 1), cB + hstepB, voffB); PG8_STAGE_A(PG8_SA(0, 0), cA, 0, offC); PG8_STAGE_A(PG8_SA(0, 1), cA, 1, offC);
    if (wr == 1) PG8_BAR;
    PG8_WAIT_V(2); PG8_BAR;
    PG8_STAGE(PG8_SB(1, 0), cB + kstep, voffB); PG8_STAGE_A(PG8_SA(1, 0), cA + kstep, 0, offC); PG8_STAGE(PG8_SB(1, 1), cB + hstepB + kstep, voffB);
    PG8_WAIT_V(6); PG8_BAR;
    for (;;) {
        const bool has_next = S.next(ui + 1, nxt);
        const char* nA = GATHER ? cA : (has_next ? (const char*)g.A + (size_t)nxt.pm * tstepA : cA); const char* nB = has_next ? (const char*)g.Bt + (size_t)nxt.pb * tstepB : cB;
        if constexpr (GATHER) { if (has_next) PG8_GRAW(nxt.pm); }
        for (int t = 0; t < nt; t += 2) {
            const bool last = (t == nt - 2);
            const char* a1 = cA + (size_t)(t + 1) * kstep;
            const char* a2 = last ? nA : cA + (size_t)(t + 2) * kstep; const char* b2 = last ? nB : cB + (size_t)(t + 2) * kstep;
            unsigned off2[2][2];
            if constexpr (GATHER) { if (last && has_next) { PG8_GCONV(offN); } else if (last) { _Pragma("unroll") for (int h_ = 0; h_ < 2; ++h_) _Pragma("unroll") for (int i_ = 0; i_ < 2; ++i_) offN[h_][i_] = offC[h_][i_]; }
                _Pragma("unroll") for (int h_ = 0; h_ < 2; ++h_) _Pragma("unroll") for (int i_ = 0; i_ < 2; ++i_) off2[h_][i_] = last ? offN[h_][i_] : offC[h_][i_]; }
            const char* a3 = a2 + kstep; const char* b3 = b2 + kstep;
            PG8_LDB(B0, 0, 0); PG8_LDB(B1, 0, 1); PG8_SCHED; PG8_LDA(At, 0, 0); PG8_STAGE_A(PG8_SA(1, 1), a1, 1, offC);
            PG8_WAIT_V(8); PG8_WAIT_L(0); PG8_BAR; PG8_MMA(0, 0, At, B0); PG8_MMA(0, 1, At, B1); PG8_BAR; PG8_SCHED;
            PG8_LDA(At, 0, 1); PG8_STAGE(PG8_SB(0, 0), b2, voffB); PG8_STAGE(PG8_SB(0, 1), b2 + hstepB, voffB); PG8_STAGE_A(PG8_SA(0, 0), a2, 0, off2);
            PG8_WAIT_V(8); PG8_WAIT_L(0); PG8_BAR; PG8_MMA(1, 0, At, B0); PG8_MMA(1, 1, At, B1); PG8_BAR; PG8_SCHED;
            PG8_LDB(B0, 1, 0); PG8_LDB(B1, 1, 1); PG8_SCHED; PG8_LDA(At, 1, 0); PG8_STAGE_A(PG8_SA(0, 1), a2, 1, off2);
            PG8_WAIT_V(8); PG8_WAIT_L(0); PG8_BAR; PG8_MMA(0, 0, At, B0); PG8_MMA(0, 1, At, B1); PG8_BAR; PG8_SCHED;
            PG8_LDA(At, 1, 1); PG8_STAGE(PG8_SB(1, 0), b3, voffB); PG8_STAGE(PG8_SB(1, 1), b3 + hstepB, voffB); PG8_STAGE_A(PG8_SA(1, 0), a3, 0, off2);
            PG8_WAIT_V(8); PG8_WAIT_L(0); PG8_BAR; PG8_MMA(1, 0, At, B0); PG8_MMA(1, 1, At, B1); PG8_BAR; PG8_SCHED;
        }
        if (wr == 0) PG8_BAR;
        E(acc, cur, wr, wc, fr, fq);
        if (!has_next) break;
#pragma unroll
        for (int a = 0; a < 2; ++a)
#pragma unroll
            for (int b = 0; b < 2; ++b)
#pragma unroll
                for (int m = 0; m < 4; ++m)
#pragma unroll
                    for (int n = 0; n < 2; ++n) acc[a][b][m][n] = (f32x4){0.f, 0.f, 0.f, 0.f};
        cur = nxt; cA = nA; cB = nB; ++ui;
        if constexpr (GATHER) { _Pragma("unroll") for (int h_ = 0; h_ < 2; ++h_) _Pragma("unroll") for (int i_ = 0; i_ < 2; ++i_) offC[h_][i_] = offN[h_][i_]; }
        if (wr == 1) PG8_BAR;
    }
    PG8_WAIT_V(0);
    PG8_BAR;
#undef PG8_SA
#undef PG8_SB
#undef PG8_STAGE
#undef PG8_STAGE_A
#undef PG8_GRAW
#undef PG8_GCONV
#undef PG8_LDA
#undef PG8_LDB
#undef PG8_MMA
#undef PG8_WAIT_V
#undef PG8_WAIT_L
#undef PG8_BAR
#undef PG8_SCHED
}
}

namespace att {
#define SBAR() __builtin_amdgcn_sched_barrier(0)
constexpr float NEGBIG = -1e30f, THR = 8.f;
__device__ __forceinline__ int crow(int r, int hi) { return (r & 3) + 8 * (r >> 2) + 4 * hi; }
typedef __bf16 bf16x2_t __attribute__((ext_vector_type(2)));
__device__ __forceinline__ unsigned cvtpk(float lo, float hi) { f32x2 v = {lo, hi}; bf16x2_t b = __builtin_convertvector(v, bf16x2_t); return __builtin_bit_cast(unsigned, b); }

__device__ __forceinline__ void partialSM(f32x16& p0, f32x16& p1, float& m_reg, float& alpha) {
    float pmax = p0[0];
#pragma unroll
    for (int r = 1; r < 16; ++r) pmax = fmaxf(pmax, p0[r]);
#pragma unroll
    for (int r = 0; r < 16; ++r) pmax = fmaxf(pmax, p1[r]);
    { auto rr = __builtin_amdgcn_permlane32_swap(__float_as_uint(pmax), __float_as_uint(pmax), false, false);
      pmax = fmaxf(__uint_as_float(rr[0]), __uint_as_float(rr[1])); }
    float mn;
    if (__builtin_expect(__all(pmax - m_reg <= THR), 1)) { mn = m_reg; alpha = 1.f; }
    else { mn = fmaxf(m_reg, pmax); alpha = __builtin_amdgcn_exp2f(m_reg - mn); m_reg = mn; }
#pragma unroll
    for (int r = 0; r < 16; ++r) { p0[r] = p0[r] - mn; p1[r] = p1[r] - mn; }
#pragma unroll
    for (int r = 0; r < 16; ++r) p0[r] = __builtin_amdgcn_exp2f(p0[r]);
}
__device__ __forceinline__ void finishSM(f32x16& p0, f32x16& p1, float alpha, float& l_reg, bf16x8& pa0, bf16x8& pa1, bf16x8& pa2, bf16x8& pa3) {
#pragma unroll
    for (int r = 0; r < 16; ++r) p1[r] = __builtin_amdgcn_exp2f(p1[r]);
    float ps = 0;
#pragma unroll
    for (int r = 0; r < 16; ++r) ps += p0[r];
#pragma unroll
    for (int r = 0; r < 16; ++r) ps += p1[r];
    { auto rr = __builtin_amdgcn_permlane32_swap(__float_as_uint(ps), __float_as_uint(ps), false, false);
      ps = __uint_as_float(rr[0]) + __uint_as_float(rr[1]); }
    l_reg = l_reg * alpha + ps;
#define PK4(P, BASE, OUT) do { unsigned a0 = cvtpk(P[BASE + 0], P[BASE + 1]), a1 = cvtpk(P[BASE + 2], P[BASE + 3]);   \
    unsigned b0 = cvtpk(P[BASE + 4], P[BASE + 5]), b1 = cvtpk(P[BASE + 6], P[BASE + 7]);                              \
    auto r0 = __builtin_amdgcn_permlane32_swap(a0, b0, false, false); auto r1 = __builtin_amdgcn_permlane32_swap(a1, b1, false, false); \
    u32x4 w = {r0[0], r1[0], r0[1], r1[1]}; OUT = __builtin_bit_cast(bf16x8, w); } while (0)
    PK4(p0, 0, pa0); PK4(p0, 8, pa1); PK4(p1, 0, pa2); PK4(p1, 8, pa3);
#undef PK4
}
template <int NQC>
__device__ __forceinline__ void qkt(f32x16& p0, f32x16& p1, const char* Ks, const bf16x8* qr, int r32, int hi) {
    p0 = f32x16{}; p1 = f32x16{};
#pragma unroll
    for (int d0 = 0; d0 < NQC; ++d0) { const int c = 2 * d0 + hi; const int a = c * 1024 + ((r32 ^ (c & 7)) << 4);
        const bf16x8 b0 = *reinterpret_cast<const bf16x8*>(Ks + a);
        const bf16x8 b1 = *reinterpret_cast<const bf16x8*>(Ks + a + 512);
        p0 = __builtin_amdgcn_mfma_f32_32x32x16_bf16(b0, qr[d0], p0, 0, 0, 0);
        p1 = __builtin_amdgcn_mfma_f32_32x32x16_bf16(b1, qr[d0], p1, 0, 0, 0); }
}
template <int NDB> __device__ __forceinline__ int v_st(int k, int c) { const int kk = (k & ~0xC) | ((k & 4) << 1) | ((k & 8) >> 1); return ((kk >> 3) * NDB + (c >> 5)) * 512 + ((kk & 7) * 32 + (c & 31)) * 2; }
__device__ __forceinline__ int v_rd_base(int lane) { return ((lane & 3) << 3) | (((lane >> 2) & 3) << 6) | (((lane >> 4) & 1) << 5) | (((lane >> 5) & 1) << 8); }
template <int NDB> constexpr int v_rd_off(int d0, int ks, int half) { return d0 * 512 + ks * (NDB * 1024) + half * (NDB * 512); }
template <int OFF> __device__ __forceinline__ s16x4 tr_read(int vb) { s16x4 r; asm volatile("ds_read_b64_tr_b16 %0, %1 offset:%2" : "=&v"(r) : "v"(vb), "i"(OFF) : "memory"); return r; }
template <int D0, int NDB> __device__ __forceinline__ void pv_one(f32x16& od, int vb, bf16x8 pa0, bf16x8 pa1, bf16x8 pa2, bf16x8 pa3) {
    const s16x4 l0 = tr_read<v_rd_off<NDB>(D0, 0, 0)>(vb), h0 = tr_read<v_rd_off<NDB>(D0, 0, 1)>(vb), l1 = tr_read<v_rd_off<NDB>(D0, 1, 0)>(vb), h1 = tr_read<v_rd_off<NDB>(D0, 1, 1)>(vb);
    const s16x4 l2 = tr_read<v_rd_off<NDB>(D0, 2, 0)>(vb), h2 = tr_read<v_rd_off<NDB>(D0, 2, 1)>(vb), l3 = tr_read<v_rd_off<NDB>(D0, 3, 0)>(vb), h3 = tr_read<v_rd_off<NDB>(D0, 3, 1)>(vb);
    asm volatile("s_waitcnt lgkmcnt(0)" ::: "memory"); SBAR();
#define PK(L, H) (bf16x8){L[0], L[1], L[2], L[3], H[0], H[1], H[2], H[3]}
    od = __builtin_amdgcn_mfma_f32_32x32x16_bf16(pa0, PK(l0, h0), od, 0, 0, 0);
    od = __builtin_amdgcn_mfma_f32_32x32x16_bf16(pa1, PK(l1, h1), od, 0, 0, 0);
    od = __builtin_amdgcn_mfma_f32_32x32x16_bf16(pa2, PK(l2, h2), od, 0, 0, 0);
    od = __builtin_amdgcn_mfma_f32_32x32x16_bf16(pa3, PK(l3, h3), od, 0, 0, 0);
#undef PK
}
template <int NDB> __device__ __forceinline__ void pv_all(f32x16* o, int vb, bf16x8 pa0, bf16x8 pa1, bf16x8 pa2, bf16x8 pa3) {
    pv_one<0, NDB>(o[0], vb, pa0, pa1, pa2, pa3); pv_one<1, NDB>(o[1], vb, pa0, pa1, pa2, pa3);
    if constexpr (NDB == 4) { pv_one<2, NDB>(o[2], vb, pa0, pa1, pa2, pa3); pv_one<3, NDB>(o[3], vb, pa0, pa1, pa2, pa3); }
}
__device__ __forceinline__ void mask_meta(f32x16& p0, f32x16& p1) {
#pragma unroll
    for (int r = 8; r < 16; ++r) p0[r] = NEGBIG;
#pragma unroll
    for (int r = 0; r < 16; ++r) p1[r] = NEGBIG;
}
__device__ __forceinline__ void mask_all(f32x16& p0, f32x16& p1) {
#pragma unroll
    for (int r = 0; r < 16; ++r) { p0[r] = NEGBIG; p1[r] = NEGBIG; }
}

template <int DQK, int DV, class P>
__device__ __forceinline__ void attn_unit(const P& pol, char* lds) {
    constexpr int NQC = DQK / 16, NDB = DV / 32, KB = 64 * DQK * 2, VB = 64 * DV * 2;
    constexpr int KCH = DQK / 8, VCH = DV / 8, NKS = (64 * KCH) / 512, NVS = (64 * VCH) / 512;
    int tid_ = threadIdx.x; asm volatile("" : "+v"(tid_));
    const int tid = tid_, wid = tid >> 6, lane = tid & 63, r32 = lane & 31, hi = lane >> 5;
    char* V_lds = lds; char* K_lds = lds + 3 * VB;
    float* ws = (float*)(lds + 3 * VB + 3 * KB) + wid * 64; float* li_l = ws; float* al_l = ws + 32;
    float m_reg = NEGBIG, l_reg = 0.f; f32x16 o[NDB];
#pragma unroll
    for (int d = 0; d < NDB; ++d) o[d] = f32x16{};
    bf16x8 qr[NQC];
    { const bf16* Qw = pol.qptr(wid * 32 + r32) + hi * 8;
#pragma unroll
      for (int d0 = 0; d0 < NQC; ++d0) qr[d0] = *reinterpret_cast<const bf16x8*>(Qw + d0 * 16); }
    pol.qfix(qr, wid * 32 + r32, hi);
    const int vb0 = (int)(uintptr_t)V_lds + v_rd_base(lane);
    bf16x8 ks[NKS], vs[NVS];
    const int srow = tid >> 3, c0 = tid & 7;
    const unsigned koff = (unsigned)(srow * pol.kstride + c0 * 8) * 2u, voff = (unsigned)(srow * pol.vstride + c0 * 8) * 2u;
    const int kst = c0 * 1024 + ((srow ^ c0) << 4), vst = v_st<NDB>(srow, c0 * 8);
    static_assert(NKS == KCH / 8 && NVS == VCH / 8, "staging map");
#define SLOAD(t) do { const char* kb_ = (const char*)pol.kbase(t) + koff; const char* vb_ = (const char*)pol.vbase(t) + voff; \
    _Pragma("unroll") for (int i = 0; i < NKS; ++i) ks[i] = *reinterpret_cast<const bf16x8*>(kb_ + i * 128); \
    _Pragma("unroll") for (int i = 0; i < NVS; ++i) vs[i] = *reinterpret_cast<const bf16x8*>(vb_ + i * 128); } while (0)
#define SWRITE(b) do { \
    _Pragma("unroll") for (int i = 0; i < NKS; ++i) *reinterpret_cast<bf16x8*>(K_lds + (b) * KB + kst + i * 8192) = ks[i]; \
    _Pragma("unroll") for (int i = 0; i < NVS; ++i) *reinterpret_cast<bf16x8*>(V_lds + (b) * VB + vst + i * 1024) = vs[i]; } while (0)
#define RESC(a) do { if (__any((a) < 1.f)) { if (hi == 0) al_l[r32] = (a); asm volatile("s_waitcnt lgkmcnt(0)" ::: "memory"); \
    _Pragma("unroll") for (int d = 0; d < NDB; ++d) _Pragma("unroll") for (int r = 0; r < 16; ++r) o[d][r] *= al_l[crow(r, hi)]; } } while (0)
#define XFORM(pa_, pb_, t) do { if (pol.needs_xform(t)) pol.xform(pa_, pb_, (t), wid, r32, hi); } while (0)
    f32x16 pA0, pA1, pB0, pB1; float alA, alB; bf16x8 pa0, pa1, pa2, pa3; const int NT = pol.nt;
    if constexpr (DQK <= 128) {
        bf16x8 ks2[NKS], vs2[NVS];
        SLOAD(0);
        { const char* kb_ = (const char*)pol.kbase(1) + koff; const char* vb_ = (const char*)pol.vbase(1) + voff;
#pragma unroll
          for (int i = 0; i < NKS; ++i) ks2[i] = *reinterpret_cast<const bf16x8*>(kb_ + i * 128);
#pragma unroll
          for (int i = 0; i < NVS; ++i) vs2[i] = *reinterpret_cast<const bf16x8*>(vb_ + i * 128); }
        asm volatile("s_waitcnt vmcnt(0)" ::: "memory"); SWRITE(0);
#pragma unroll
        for (int i = 0; i < NKS; ++i) *reinterpret_cast<bf16x8*>(K_lds + KB + kst + i * 8192) = ks2[i];
#pragma unroll
        for (int i = 0; i < NVS; ++i) *reinterpret_cast<bf16x8*>(V_lds + VB + vst + i * 1024) = vs2[i];
        __syncthreads();
        qkt<NQC>(pA0, pA1, K_lds, qr, r32, hi); XFORM(pA0, pA1, 0); partialSM(pA0, pA1, m_reg, alA);
    } else {
    SLOAD(0); asm volatile("s_waitcnt vmcnt(0)" ::: "memory"); SWRITE(0); __syncthreads();
    qkt<NQC>(pA0, pA1, K_lds, qr, r32, hi); XFORM(pA0, pA1, 0); partialSM(pA0, pA1, m_reg, alA);
    SLOAD(1); asm volatile("s_waitcnt vmcnt(0)" ::: "memory"); SWRITE(1); __syncthreads();
    }
    int bprev = 0, bcur = 1, bnext = 2;
#define ROT3() do { bprev = bcur; bcur = bnext; bnext = (bnext == 2) ? 0 : bnext + 1; } while (0)
    for (int j = 1; j + 1 < NT; j += 2) {
        SBAR(); qkt<NQC>(pB0, pB1, K_lds + bcur * KB, qr, r32, hi);
        finishSM(pA0, pA1, alA, l_reg, pa0, pa1, pa2, pa3); SBAR();
        SLOAD(j + 1); SBAR();
        pv_all<NDB>(o, vb0 + bprev * VB, pa0, pa1, pa2, pa3); XFORM(pB0, pB1, j); partialSM(pB0, pB1, m_reg, alB);
        asm volatile("s_waitcnt vmcnt(0)" ::: "memory"); SWRITE(bnext);
        RESC(alB); __syncthreads(); ROT3();
        SBAR(); qkt<NQC>(pA0, pA1, K_lds + bcur * KB, qr, r32, hi);
        finishSM(pB0, pB1, alB, l_reg, pa0, pa1, pa2, pa3); SBAR();
        SLOAD(j + 2); SBAR();
        pv_all<NDB>(o, vb0 + bprev * VB, pa0, pa1, pa2, pa3); XFORM(pA0, pA1, j + 1); partialSM(pA0, pA1, m_reg, alA);
        asm volatile("s_waitcnt vmcnt(0)" ::: "memory"); SWRITE(bnext);
        RESC(alA); __syncthreads(); ROT3();
    }
    SBAR(); qkt<NQC>(pB0, pB1, K_lds + bcur * KB, qr, r32, hi);
    finishSM(pA0, pA1, alA, l_reg, pa0, pa1, pa2, pa3); SBAR();
    pv_all<NDB>(o, vb0 + bprev * VB, pa0, pa1, pa2, pa3); XFORM(pB0, pB1, NT - 1); partialSM(pB0, pB1, m_reg, alB);
    RESC(alB);
    finishSM(pB0, pB1, alB, l_reg, pa0, pa1, pa2, pa3); SBAR();
    pv_all<NDB>(o, vb0 + bcur * VB, pa0, pa1, pa2, pa3);
#undef ROT3
    l_reg += pol.sink_term(m_reg);
    if (pol.partial()) {
        if (wid == 0) {
            if (lane < 16) { float* pp = pol.pptr(lane); pp[128] = m_reg; pp[129] = l_reg; }
#pragma unroll
            for (int r = 0; r < 8; ++r) { float* pp = pol.pptr(crow(r, hi));
#pragma unroll
                for (int d0 = 0; d0 < NDB; ++d0) pp[d0 * 32 + r32] = o[d0][r]; }
        }
    } else {
    if (hi == 0) li_l[r32] = l_reg; asm volatile("s_waitcnt lgkmcnt(0)" ::: "memory");
    float rli[16];
#pragma unroll
    for (int r = 0; r < 16; ++r) rli[r] = __builtin_amdgcn_rcpf(li_l[crow(r, hi)]);
#pragma unroll
    for (int r = 0; r < 16; ++r) { const int orow = wid * 32 + crow(r, hi);
        if (pol.ovalid(orow)) { bf16* op = pol.optr(orow);
#pragma unroll
            for (int d0 = 0; d0 < NDB; ++d0) op[d0 * 32 + r32] = (bf16)f2bf(o[d0][r] * rli[r]); } }
    }
    __syncthreads();
#undef SLOAD
#undef SWRITE
#undef RESC
#undef XFORM
}

__device__ __forceinline__ int unit_row(int b, int qb, int r) { int row = qb < 64 ? b * SEQ + qb * 256 + r : RMETA + 16 * b + r; return row < NR ? row : NR - 1; }

struct PolMLA {
    const bf16 *Kc, *Vm, *Q; bf16* O; float* part; const float* rope_; int b, h, qb, nt, kstride, vstride, split;
    __device__ __forceinline__ void init(const bf16* Kc_, const bf16* Vm_, const bf16* Q_, bf16* O_, float* part_, const float* rope__, int b_, int h_, int qb_, int split_) {
        Kc = Kc_; Vm = Vm_; Q = Q_; O = O_; part = part_; rope_ = rope__; b = b_; h = h_; qb = qb_; split = split_; kstride = KCW; vstride = VMW;
        nt = split < 0 ? 258 : (split == 0 ? 34 : 32); }
    __device__ __forceinline__ int krow0(int t) const {
        if (split < 0) return (t == 0 || t == 257) ? RMETA + 16 * b : b * SEQ + (t - 1) * 64;
        if (split == 0) return (t == 0 || t == 33) ? RMETA + 16 * b : b * SEQ + (t - 1) * 64;
        return b * SEQ + (32 * split + t) * 64; }
    __device__ __forceinline__ const bf16* kbase(int t) const { return Kc + (size_t)krow0(t) * KCW + h * 192; }
    __device__ __forceinline__ const bf16* vbase(int t) const { return Vm + (size_t)krow0(t) * VMW + h * 128; }
    __device__ __forceinline__ const bf16* qptr(int r) const { return Q + (size_t)unit_row(b, qb, r) * QW + h * 192; }
    __device__ __forceinline__ bf16* optr(int r) const { return O + (size_t)unit_row(b, qb, r) * AOW + h * 128; }
    __device__ __forceinline__ bool ovalid(int r) const { return qb < 64 || r < 16; }
    __device__ __forceinline__ bool needs_xform(int t) const { return split < 0 ? (t == 0 || t == 257) : (split == 0 && (t == 0 || t == 33)); }
    __device__ __forceinline__ void xform(f32x16& p0, f32x16& p1, int t, int, int, int) const { if (t == 0) mask_meta(p0, p1); else mask_all(p0, p1); }
    __device__ __forceinline__ float sink_term(float) const { return 0.f; }
    __device__ __forceinline__ bool partial() const { return split >= 0; }
    __device__ __forceinline__ void qfix(bf16x8* qr, int r, int hi) const {
        const int row = unit_row(b, qb, r); const int pos = row < RMETA ? NMETA + (row & (SEQ - 1)) : ((row - RMETA) & 15);
        const float* rp = rope_ + 2 * (size_t)(pos * 32);
#pragma unroll
        for (int blk = 0; blk < 2; ++blk) { const f32x4* cs = (const f32x4*)(rp + 2 * (16 * blk + 8 * hi)); f32x4 t[4];
#pragma unroll
            for (int q = 0; q < 4; ++q) t[q] = cs[q];
            bf16x8 x1 = qr[8 + blk], x2 = qr[10 + blk];
#pragma unroll
            for (int e = 0; e < 8; ++e) { const float c = t[e >> 1][(e & 1) * 2], sn = t[e >> 1][(e & 1) * 2 + 1];
                const float a = bf2f((unsigned short)x1[e]), bb = bf2f((unsigned short)x2[e]);
                x1[e] = (short)f2bf(a * c - bb * sn); x2[e] = (short)f2bf(bb * c + a * sn); }
            qr[8 + blk] = x1; qr[10 + blk] = x2; } }
    __device__ __forceinline__ float* pptr(int r) const { return part + ((size_t)((b * 8 + h) * 8 + split) * 16 + r) * 132; }
};

struct PolNA {
    const bf16* Z; bf16* O; const float* tab; int b, h, qb, nt, kstride, vstride, glo, n;
    __device__ __forceinline__ void init(const bf16* Z_, bf16* O_, const float* tab_, int b_, int h_, int qb_) {
        Z = Z_; O = O_; tab = tab_; b = b_; h = h_; qb = qb_; kstride = ZW; vstride = ZW;
        if (qb < 64) { int lo = 4 * qb - 4; lo = lo < 0 ? 0 : (lo > 248 ? 248 : lo); int hi_ = 4 * qb + 3 - 4; hi_ = hi_ < 0 ? 0 : (hi_ > 248 ? 248 : hi_); hi_ += 7; glo = lo; n = hi_ - lo + 1; }
        else { glo = 0; n = 0; }
        nt = (n + 1 + 1) & ~1; }
    __device__ __forceinline__ int krow0(int t) const { return (t == 0 || t > n) ? RMETA + 16 * b : b * SEQ + (glo + t - 1) * 64; }
    __device__ __forceinline__ const bf16* kbase(int t) const { return Z + (size_t)krow0(t) * ZW + ZNAK + h * 128; }
    __device__ __forceinline__ const bf16* vbase(int t) const { return Z + (size_t)krow0(t) * ZW + ZNAV + h * 128; }
    __device__ __forceinline__ const bf16* qptr(int r) const { return Z + (size_t)unit_row(b, qb, r) * ZW + ZNAQ + h * 128; }
    __device__ __forceinline__ bf16* optr(int r) const { return O + (size_t)unit_row(b, qb, r) * AOW + 1024 + h * 128; }
    __device__ __forceinline__ bool ovalid(int r) const { return qb < 64 || r < 16; }
    __device__ __forceinline__ bool needs_xform(int) const { return true; }
    __device__ __forceinline__ void xform(f32x16& p0, f32x16& p1, int t, int wid, int r32, int hi) const {
        if (t == 0) { mask_meta(p0, p1); return; }
        if (t > n) { mask_all(p0, p1); return; }
        const int g = glo + t - 1, r = 4 * qb + (wid >> 1), c = 32 * (wid & 1) + r32;
        int rs = r - 4; rs = rs < 0 ? 0 : (rs > 248 ? 248 : rs);
        if (g < rs || g >= rs + 8) { mask_all(p0, p1); return; }
        int cs = c - 8; cs = cs < 0 ? 0 : (cs > 48 ? 48 : cs);
        const float* trow = tab + (g - r + 7) * 31 + 15 - c;
#pragma unroll
        for (int i = 0; i < 16; ++i) { const int kc = crow(i, hi); const bool ok = kc >= cs && kc < cs + 16; const int kcc = ok ? kc : c;
            const float bv = trow[kcc]; p0[i] = ok ? p0[i] + bv : NEGBIG; }
#pragma unroll
        for (int i = 0; i < 16; ++i) { const int kc = 32 + crow(i, hi); const bool ok = kc >= cs && kc < cs + 16; const int kcc = ok ? kc : c;
            const float bv = trow[kcc]; p1[i] = ok ? p1[i] + bv : NEGBIG; }
    }
    __device__ __forceinline__ float sink_term(float) const { return 0.f; }
    __device__ __forceinline__ bool partial() const { return false; }
    __device__ __forceinline__ float* pptr(int) const { return nullptr; }
    __device__ __forceinline__ void qfix(bf16x8*, int, int) const {}
};

struct PolSWA {
    const bf16* Z; bf16* O; int b, hq, qb, nt, kstride, vstride, klo, n; float slope_l2, sink_l2;
    __device__ __forceinline__ void init(const bf16* Z_, bf16* O_, const float* sinks, int b_, int hq_, int qb_) {
        Z = Z_; O = O_; b = b_; hq = hq_; qb = qb_; kstride = Z1W; vstride = Z1W;
        if (qb < 64) { klo = 4 * qb - 2; if (klo < 0) klo = 0; int khi = 4 * qb + 5; if (khi > 255) khi = 255; n = khi - klo + 1; }
        else { klo = 0; n = 2; }
        nt = (n + 1 + 1) & ~1;
        slope_l2 = __builtin_amdgcn_exp2f(-0.25f * (float)(hq + 1)) * LOG2E; sink_l2 = sinks[hq] * LOG2E; }
    __device__ __forceinline__ int krow0(int t) const { return (t == 0 || t > n) ? RMETA + 16 * b : b * SEQ + (klo + t - 1) * 64; }
    __device__ __forceinline__ const bf16* kbase(int t) const { return Z + (size_t)krow0(t) * Z1W + 2048 + (hq >> 3) * 64; }
    __device__ __forceinline__ const bf16* vbase(int t) const { return Z + (size_t)krow0(t) * Z1W + 2304 + (hq >> 3) * 64; }
    __device__ __forceinline__ const bf16* qptr(int r) const { return Z + (size_t)unit_row(b, qb, r) * Z1W + hq * 64; }
    __device__ __forceinline__ bf16* optr(int r) const { return O + (size_t)unit_row(b, qb, r) * AOW + hq * 64; }
    __device__ __forceinline__ bool ovalid(int r) const { return qb < 64 || r < 16; }
    __device__ __forceinline__ bool needs_xform(int) const { return true; }
    __device__ __forceinline__ void xform(f32x16& p0, f32x16& p1, int t, int wid, int r32, int hi) const {
        if (t == 0) { mask_meta(p0, p1); return; }
        if (t > n) { mask_all(p0, p1); return; }
        const int kt = klo + t - 1;
        if (qb < 64) {
            const int d0 = 64 * kt - (256 * qb + 32 * wid + r32);
#pragma unroll
            for (int i = 0; i < 16; ++i) { int d = d0 + crow(i, hi); d = max(d, -d); const int m = min(max(d - 128, 0), 1); p0[i] = (p0[i] - slope_l2 * (float)d) + NEGBIG * (float)m; }
#pragma unroll
            for (int i = 0; i < 16; ++i) { int d = d0 + 32 + crow(i, hi); d = max(d, -d); const int m = min(max(d - 128, 0), 1); p1[i] = (p1[i] - slope_l2 * (float)d) + NEGBIG * (float)m; }
        } else {
            const int qi = 32 * wid + r32, j0 = 64 * kt;
#pragma unroll
            for (int i = 0; i < 16; ++i) { const int j = j0 + crow(i, hi); const int m = min(max(16 + j - qi - 128, 0), 1); p0[i] = p0[i] + NEGBIG * (float)m; }
#pragma unroll
            for (int i = 0; i < 16; ++i) { const int j = j0 + 32 + crow(i, hi); const int m = min(max(16 + j - qi - 128, 0), 1); p1[i] = p1[i] + NEGBIG * (float)m; }
        }
    }
    __device__ __forceinline__ float sink_term(float m) const { return __builtin_amdgcn_exp2f(sink_l2 - m); }
    __device__ __forceinline__ bool partial() const { return false; }
    __device__ __forceinline__ float* pptr(int) const { return nullptr; }
    __device__ __forceinline__ void qfix(bf16x8*, int, int) const {}
};
struct PolSWAG {
    const bf16* Z; bf16* O; int b, kvh, pb, nt, kstride, vstride, klo, n; float slope_l2, sink_l2;
    __device__ __forceinline__ void init(const bf16* Z_, bf16* O_, const float* sinks, int b_, int kvh_, int pb_, int wv) {
        Z = Z_; O = O_; b = b_; kvh = kvh_; pb = pb_; kstride = Z1W; vstride = Z1W;
        klo = (pb - 4) >> 1; if (klo < 0) klo = 0; int khi = (pb + 4) >> 1; if (khi > 255) khi = 255; n = khi - klo + 1;
        nt = (n + 1 + 1) & ~1;
        const int hq = kvh * 8 + wv;
        slope_l2 = __builtin_amdgcn_exp2f(-0.25f * (float)(hq + 1)) * LOG2E; sink_l2 = sinks[hq] * LOG2E; }
    __device__ __forceinline__ int krow0(int t) const { return (t == 0 || t > n) ? RMETA + 16 * b : b * SEQ + (klo + t - 1) * 64; }
    __device__ __forceinline__ const bf16* kbase(int t) const { return Z + (size_t)krow0(t) * Z1W + 2048 + kvh * 64; }
    __device__ __forceinline__ const bf16* vbase(int t) const { return Z + (size_t)krow0(t) * Z1W + 2304 + kvh * 64; }
    __device__ __forceinline__ const bf16* qptr(int r) const { return Z + (size_t)(b * SEQ + 32 * pb + (r & 31)) * Z1W + (kvh * 8 + (r >> 5)) * 64; }
    __device__ __forceinline__ bf16* optr(int r) const { return O + (size_t)(b * SEQ + 32 * pb + (r & 31)) * AOW + (kvh * 8 + (r >> 5)) * 64; }
    __device__ __forceinline__ bool ovalid(int) const { return true; }
    __device__ __forceinline__ bool needs_xform(int) const { return true; }
    __device__ __forceinline__ void xform(f32x16& p0, f32x16& p1, int t, int, int r32, int hi) const {
        if (t == 0) { mask_meta(p0, p1); return; }
        if (t > n) { mask_all(p0, p1); return; }
        const int rel = 64 * (klo + t - 1) - 32 * pb;
        const int d0 = rel - r32;
        if (rel == -96 || rel == -64 || rel == 32 || rel == 64) {
            const float sg = rel < 0 ? slope_l2 : -slope_l2;
            const float sb0 = sg * (float)(d0 + 4 * hi), sb1 = sb0 + sg * 32.f;
#pragma unroll
            for (int i = 0; i < 16; ++i) p0[i] = __builtin_fmaf(sg, (float)((i & 3) + 8 * (i >> 2)), p0[i] + sb0);
#pragma unroll
            for (int i = 0; i < 16; ++i) p1[i] = __builtin_fmaf(sg, (float)((i & 3) + 8 * (i >> 2)), p1[i] + sb1);
            return;
        }
        if (rel == -32 || rel == 0) {
#pragma unroll
            for (int i = 0; i < 16; ++i) { int d = d0 + crow(i, hi); d = max(d, -d); p0[i] = p0[i] - slope_l2 * (float)d; }
#pragma unroll
            for (int i = 0; i < 16; ++i) { int d = d0 + 32 + crow(i, hi); d = max(d, -d); p1[i] = p1[i] - slope_l2 * (float)d; }
            return;
        }
#pragma unroll
        for (int i = 0; i < 16; ++i) { int d = d0 + crow(i, hi); d = max(d, -d); const int m = min(max(d - 128, 0), 1); p0[i] = (p0[i] - slope_l2 * (float)d) + NEGBIG * (float)m; }
#pragma unroll
        for (int i = 0; i < 16; ++i) { int d = d0 + 32 + crow(i, hi); d = max(d, -d); const int m = min(max(d - 128, 0), 1); p1[i] = (p1[i] - slope_l2 * (float)d) + NEGBIG * (float)m; }
    }
    __device__ __forceinline__ float sink_term(float m) const { return __builtin_amdgcn_exp2f(sink_l2 - m); }
    __device__ __forceinline__ bool partial() const { return false; }
    __device__ __forceinline__ float* pptr(int) const { return nullptr; }
    __device__ __forceinline__ void qfix(bf16x8*, int, int) const {}
};
#undef SBAR
}

struct Params {
    const float* x; const float* meta; const float* norm_mix; const float* norm_ffn; const float* norm_final;
    const float* ab_w_in; const float* ab_q_norm; const float* ab_kv_norm; const float* ab_w_uq; const float* ab_w_ukv; const float* ab_rpb; const float* ab_w_out;
    const float* c_w_in; const float* c_sinks; const float* c_w_out;
    const float* ec_w_router; const float* ec_w_gate; const float* ec_w_up; const float* ec_w_down;
    float* out; unsigned char* ws;
};

__device__ __forceinline__ void load_row(const float* row, int lane, f32x4 (&v)[8]) {
    const f32x4* r = (const f32x4*)row + lane;
#pragma unroll
    for (int j = 0; j < 8; ++j) v[j] = r[64 * j];
}
__device__ __forceinline__ void load_row_bf16(const bf16* row, int lane, f32x4 (&v)[8]) {
    const u32x2* r = (const u32x2*)row + lane;
#pragma unroll
    for (int j = 0; j < 8; ++j) { const u32x2 w = r[64 * j]; v[j] = (f32x4){bflo(w.x), bfhi(w.x), bflo(w.y), bfhi(w.y)}; }
}
__device__ __forceinline__ void store_row_bf16(bf16* row, int lane, const f32x4 (&v)[8]) {
    u32x2* o8 = (u32x2*)row + lane;
#pragma unroll
    for (int j = 0; j < 8; ++j) { u32x2 w; w.x = pk2(v[j].x, v[j].y); w.y = pk2(v[j].z, v[j].w); o8[64 * j] = w; }
}
__device__ __forceinline__ float row_rs(const f32x4 (&v)[8]) {
    float s = 0.f;
#pragma unroll
    for (int j = 0; j < 8; ++j) s += (v[j].x * v[j].x + v[j].y * v[j].y) + (v[j].z * v[j].z + v[j].w * v[j].w);
    return 1.0f / sqrtf(wave_sum(s) * (1.f / D) + EPS);
}
__device__ __forceinline__ void store_norm_bf16(bf16* urow, int lane, const f32x4 (&v)[8], float rs, const float* g) {
    const f32x4* gp = (const f32x4*)g + lane; u32x2* o8 = (u32x2*)urow + lane;
#pragma unroll
    for (int j = 0; j < 8; ++j) { const f32x4 gg = gp[64 * j]; u32x2 w; w.x = pk2(v[j].x * rs * gg.x, v[j].y * rs * gg.y); w.y = pk2(v[j].z * rs * gg.z, v[j].w * rs * gg.w); o8[64 * j] = w; }
}
__device__ __forceinline__ void store_zero_bf16(bf16* urow, int lane) {
    u32x2* o8 = (u32x2*)urow + lane;
#pragma unroll
    for (int j = 0; j < 8; ++j) o8[64 * j] = (u32x2){0u, 0u};
}

__device__ __forceinline__ void transpose_item(const float* src, int srcN, int k0, int n0, bf16* dst, int dstK, int dst_row0, const float* kscale, LAS float*, int lane) {
    const int kg = lane >> 4, ng = lane & 15;
#pragma unroll
    for (int half = 0; half < 2; ++half) {
        const int kk0 = k0 + 32 * half + 8 * kg;
        f32x4 v[8];
#pragma unroll
        for (int j = 0; j < 8; ++j) v[j] = *(const f32x4*)(src + (size_t)(kk0 + j) * srcN + n0 + 4 * ng);
        if (kscale) {
#pragma unroll
            for (int j = 0; j < 8; ++j) v[j] = v[j] * kscale[kk0 + j]; }
#pragma unroll
        for (int q = 0; q < 4; ++q) { u32x4 o; o.x = pk2(v[0][q], v[1][q]); o.y = pk2(v[2][q], v[3][q]); o.z = pk2(v[4][q], v[5][q]); o.w = pk2(v[6][q], v[7][q]);
            *(u32x4*)(dst + (size_t)(dst_row0 + 4 * ng + q) * dstK + kk0) = o; }
    }
}
template <class Map>
__device__ __forceinline__ void transpose_matrix(const float* W, int K, int N, bf16* WT, const float* kscale, LAS float* scr, int gw, int ngw, int lane, const Map& map) {
    const int nkb = K / 64, nnb = N / 64, items = nkb * nnb;
    for (int it = gw; it < items; it += ngw) { const int kb = it / nnb, nb = it % nnb; transpose_item(W, N, kb * 64, nb * 64, WT, K, map(nb * 64), kscale, scr, lane); }
}
__device__ __forceinline__ void convert_experts(const float* wg, const float* wu, const float* wd, const float* gk, bf16* Wgu, bf16* Wd, LAS float* scr, int gw, int ngw, int lane, int lo, int hi) {
    constexpr int PER = 32 * 32;
    for (int it = lo + gw; it < hi; it += ngw) {
        const int e = it / (3 * PER), r = it % (3 * PER), which = r / PER, q = r % PER, kb = q / 32, nb = q % 32, n0 = nb * 64;
        const size_t eoff = (size_t)e * D * D;
        if (which == 0) transpose_item(wg + eoff, D, kb * 64, n0, Wgu + (size_t)e * 4096 * D, D, (n0 >> 7) * 256 + (n0 & 127), gk, scr, lane);
        else if (which == 1) transpose_item(wu + eoff, D, kb * 64, n0, Wgu + (size_t)e * 4096 * D, D, (n0 >> 7) * 256 + 128 + (n0 & 127), gk, scr, lane);
        else transpose_item(wd + eoff, D, kb * 64, n0, Wd + eoff, D, n0, nullptr, scr, lane);
    }
}

constexpr int CV_ITEMS = NE * 3 * 32 * 32, CV_TAIL_PER_CU = 80;
constexpr int CV_TOPK = 224 * 30;
constexpr int CV_CHUNK = 64;
constexpr int CV_IN0 = (256 - (129 * 17) % 256) * CV_TAIL_PER_CU, CV_OUT = (256 - (129 * 8) % 256) * CV_TAIL_PER_CU, CV_IN1 = (256 - (129 * 10) % 256) * CV_TAIL_PER_CU;
constexpr int CV_MAIN0 = CV_ITEMS - CV_IN0 - CV_OUT - CV_TOPK;
#ifndef PHASES
#define PHASES 0xffffffffu
#endif
#define EN(k) (((PHASES) >> (k)) & 1u)
#define PH_IDS() int tid = threadIdx.x; asm volatile("" : "+v"(tid)); const int lane = tid & 63, wave = __builtin_amdgcn_readfirstlane(tid >> 6), gw = vcu * NWAVES + wave; (void)lane; (void)wave; (void)gw; WSL()
__global__ void __launch_bounds__(NTHREADS, 2) fwd_kernel(Params P) {
    extern __shared__ __attribute__((aligned(16))) unsigned char lds[];
    LAS unsigned char* ldsl = (LAS unsigned char*)lds;
    volatile LAS unsigned* MISC = (volatile LAS unsigned*)(ldsl + MISC_OFF);
    const int G = gridDim.x, bx = blockIdx.x;
    const int vcu = (G % 8 == 0) ? (bx % 8) * (G / 8) + bx / 8 : bx;
    const int NGW = G * NWAVES;
    unsigned* ctl = (unsigned*)(P.ws + WS_CTL);
    for (int u = threadIdx.x; u < 64; u += NTHREADS) MISC[u] = 0u;
    __syncthreads();
    XcdBarrier bar = xcd_barrier_post(ctl + CW_BAR, MISC + 8);
#define GRID_BAR() xcd_barrier(bar)

#define WSL() GAS unsigned char* wsg_ = (GAS unsigned char*)P.ws; asm volatile("" : "+s"(wsg_)); unsigned char* wsl = (unsigned char*)wsg_
#define rope ((float*)(wsl + WS_ROPE))
#define rsq ((float*)(wsl + WS_RSQ))
#define rskv ((float*)(wsl + WS_RSKV))
#define aff ((float*)(wsl + WS_AFF))
#define tokslot ((int*)(wsl + WS_TOKSLOT))
#define slottok ((int*)(wsl + WS_SLOTTOK))
#define xgate ((float*)(wsl + WS_XGATE))
#define xmap ((int*)(wsl + WS_XMAP))
#define rsf ((float*)(wsl + WS_RSF))
#define xrs ((float*)(wsl + WS_XRS))
#define rsm ((float*)(wsl + WS_RSM))
#define Win0 ((bf16*)(wsl + WS_WIN0))
#define Wuq ((bf16*)(wsl + WS_WUQ))
#define Wukv ((bf16*)(wsl + WS_WUKV))
#define Wout0 ((bf16*)(wsl + WS_WOUT0))
#define Win1 ((bf16*)(wsl + WS_WIN1))
#define Wout1 ((bf16*)(wsl + WS_WOUT1))
#define Wgu ((bf16*)(wsl + WS_WGU))
#define Wd ((bf16*)(wsl + WS_WD))
#define Hm ((bf16*)(wsl + WS_H))
#define U ((bf16*)(wsl + WS_U))
#define Z ((bf16*)(wsl + WS_Z))
#define Qb ((bf16*)(wsl + WS_Q))
#define Kc ((bf16*)(wsl + WS_KC))
#define Vm ((bf16*)(wsl + WS_VM))
#define AO ((bf16*)(wsl + WS_AO))
#define XS ((bf16*)(wsl + WS_XS))
#define HMID ((bf16*)(wsl + WS_HMID))

    if (EN(0)) {
        PH_IDS();
        LAS float* scr = (LAS float*)(ldsl + wave * 16640);
        transpose_matrix(P.ab_w_in, D, 4160, Win0, nullptr, scr, gw, NGW, lane, [](int n0) { return n0 < 1024 ? n0 : (n0 < 1088 ? 4096 + (n0 - 1024) : n0 - 64); });
        transpose_matrix(P.ab_w_uq, 512, 1536, Wuq, P.ab_q_norm, scr, gw, NGW, lane, [](int n0) { return n0; });
        transpose_matrix(P.ab_w_ukv, 512, 2048, Wukv, P.ab_kv_norm, scr, gw, NGW, lane, [](int n0) { return n0; });
        transpose_matrix(P.ab_w_out, D, D, Wout0, nullptr, scr, gw, NGW, lane, [](int n0) { return n0; });
        transpose_matrix(P.c_w_in, D, Z1W, Win1, P.norm_mix + D, scr, gw, NGW, lane, [](int n0) { return n0; });
        transpose_matrix(P.c_w_out, D, D, Wout1, nullptr, scr, gw, NGW, lane, [](int n0) { return n0; });
        if (G != 256) convert_experts(P.ec_w_gate, P.ec_w_up, P.ec_w_down, P.norm_ffn, Wgu, Wd, scr, gw, NGW, lane, 0, CV_ITEMS);
        for (int row = NTOK + gw * 64 + lane; row < NR; row += NGW * 64) rsm[row] = 0.f;
        for (int i = gw * 64 + lane; i < 192 * D / 8; i += NGW * 64) ((u32x4*)(Win0 + (size_t)4160 * D))[i] = (u32x4){0u, 0u, 0u, 0u};
        for (int row = gw; row < NR; row += NGW) {
            bf16* urow = U + (size_t)row * D;
            if (row < NTOK) {
                const float* src = row < RMETA ? P.x + (size_t)row * D : P.meta + (size_t)((row - RMETA) & 15) * D;
                f32x4 v[8]; load_row(src, lane, v);
                const float rs = row_rs(v); store_norm_bf16(urow, lane, v, rs, P.norm_mix);
            } else store_zero_bf16(urow, lane);
        }
        for (int i = gw * 64 + lane; i < LTOK * 32; i += NGW * 64) {
            const int pos = i >> 5, j = i & 31;
            double f = 1.0; { double r = 0.74989420933245582730;   for (int q = 0; q < j; ++q) f *= r; }
            const double rev = (double)pos * f * 0.15915494309189533577;
            const float fr = (float)(rev - __builtin_floor(rev));
            rope[2 * i] = __builtin_amdgcn_cosf(fr); rope[2 * i + 1] = __builtin_amdgcn_sinf(fr);
        }
    }
    GRID_BAR();

    for (int layer = 0; layer < 2; ++layer) {
        if (EN(1)) {
            WSL();
            const int nN = layer == 0 ? 17 : 10, ldz = layer == 0 ? ZW : Z1W;
            pg8::Gemm g{layer == 0 ? U : Hm, layer == 0 ? Win0 : Win1, D, D, D};
            pg8::TileOrder S; S.init(NR / 256, nN, G, bx, 0);
            pg8::EpiBf16S E{Z, ldz, layer == 0 ? nullptr : rsm, layer == 0 ? 4 : 0, 8, layer == 0 ? C_NA : C_SWA};
            pg8::gemm_phase(ldsl, g, S, E);
            if (G == 256) {
                const int rem = (129 * nN) % 256;
                if (bx >= rem) { PH_IDS(); const int cnt = layer == 0 ? CV_IN0 : CV_IN1, base = CV_ITEMS - CV_OUT - cnt; const size_t lo = (size_t)layer * NE * D * D;
                    convert_experts(P.ec_w_gate + lo, P.ec_w_up + lo, P.ec_w_down + lo, P.norm_ffn + (size_t)layer * D, Wgu, Wd, (LAS float*)ldsl, (bx - rem) * NWAVES + wave, (256 - rem) * NWAVES, lane, base, base + cnt); }
            }
        }
        GRID_BAR();
        if (layer == 0) {
            if (EN(2)) { PH_IDS();
                const int sub = lane >> 4, l16 = lane & 15;
                for (int row4 = gw * 4; row4 < NR; row4 += NGW * 4) {
                    const int row = row4 + sub;
                    const bf16* zr = Z + (size_t)row * ZW;
                    u32x4 a[4], bq[4];
#pragma unroll
                    for (int i = 0; i < 4; ++i) { a[i] = *(const u32x4*)(zr + ZQL + 128 * i + 8 * l16); bq[i] = *(const u32x4*)(zr + ZKVL + 128 * i + 8 * l16); }
                    const int pos = row < RMETA ? NMETA + (row & (SEQ - 1)) : ((row - RMETA) & 15);
                    const unsigned x1w = *(const unsigned*)(zr + ZKR + 2 * l16), x2w = *(const unsigned*)(zr + ZKR + 32 + 2 * l16);
                    const f32x4 cs = *(const f32x4*)(rope + 2 * (pos * 32 + 2 * l16));
                    float s1 = 0.f, s2 = 0.f;
#pragma unroll
                    for (int i = 0; i < 4; ++i)
#pragma unroll
                        for (int q = 0; q < 4; ++q) { const float a0 = bflo(a[i][q]), a1 = bfhi(a[i][q]), b0 = bflo(bq[i][q]), b1 = bfhi(bq[i][q]); s1 += a0 * a0 + a1 * a1; s2 += b0 * b0 + b1 * b1; }
#pragma unroll
                    for (int o = 1; o < 16; o <<= 1) { s1 += __shfl_xor(s1, o); s2 += __shfl_xor(s2, o); }
                    if (l16 == 0) { rsq[row] = C_MLA / sqrtf(s1 * (1.f / 512) + EPS); rskv[row] = 1.0f / sqrtf(s2 * (1.f / 512) + EPS); }
                    const float z = row < NTOK ? 1.f : 0.f;
                    const float x1a = bflo(x1w) * z, x1b = bfhi(x1w) * z, x2a = bflo(x2w) * z, x2b = bfhi(x2w) * z;
                    const unsigned w1 = pk2(x1a * cs[0] - x2a * cs[1], x1b * cs[2] - x2b * cs[3]), w2 = pk2(x2a * cs[0] + x1a * cs[1], x2b * cs[2] + x1b * cs[3]);
                    bf16* kr = Kc + (size_t)row * KCW + 128 + 2 * l16;
#pragma unroll
                    for (int h = 0; h < 8; ++h) { *(unsigned*)(kr + h * 192) = w1; *(unsigned*)(kr + h * 192 + 32) = w2; }
                } }
            GRID_BAR();
            if (EN(3)) {
                WSL();
                pg8::Gemm g{Z + ZQL, Wuq, ZW, 512, 512};
                pg8::TileOrder S; S.init(NR / 256, 6, G, bx, 0);
                pg8::EpiBf16S E{Qb, QW, rsq, 0, 0, 1.f};
                pg8::gemm_phase(ldsl, g, S, E);
            }
            if (EN(4)) {
                WSL();
                pg8::Gemm g{Z + ZKVL, Wukv, ZW, 512, 512};
                pg8::TileOrder S; S.init(NR / 256, 8, G, G == 256 ? (bx + 248) & 255 : bx, 0);
                pg8::EpiKV E{Kc, Vm, rskv};
                pg8::gemm_phase(ldsl, g, S, E);
            }
            GRID_BAR();
            {
                WSL();
                constexpr int N_MLA = 1024 + 128, N_NA = 1040;
                float* tab = (float*)(lds + 3 * 16384 + 3 * 16384 + 2048);
                float* PART = (float*)(wsl + WS_PART);
                unsigned* ticket = (unsigned*)(wsl + WS_CTL) + CW_TICKET;
                for (int u0 = vcu; ; ) {
                    int u;
                    if (u0 < 1024) { u = u0; u0 += G; }
                    else {
                        if (threadIdx.x == 0) MISC[16] = 1024u + __hip_atomic_fetch_add(ticket, 1u, __ATOMIC_RELAXED, __HIP_MEMORY_SCOPE_AGENT);
                        __syncthreads();
                        u = (int)MISC[16];
                        if (u >= N_MLA + N_NA) {
                            const int c = u - (N_MLA + N_NA);
                            if (G != 256 || c >= (CV_MAIN0 + CV_CHUNK - 1) / CV_CHUNK) break;
                            const int ln = threadIdx.x & 63, wv = __builtin_amdgcn_readfirstlane((int)threadIdx.x >> 6), hi_ = (c + 1) * CV_CHUNK < CV_MAIN0 ? (c + 1) * CV_CHUNK : CV_MAIN0;
                            convert_experts(P.ec_w_gate, P.ec_w_up, P.ec_w_down, P.norm_ffn, Wgu, Wd, (LAS float*)ldsl, wv, NWAVES, ln, c * CV_CHUNK, hi_);
                            __syncthreads();
                            continue;
                        }
                    }
                    if (u < N_MLA) { if (EN(6)) {
                        int b, h, qb, sp; if (u < 1024) { const int bh = u >> 6; b = bh >> 3; h = bh & 7; qb = u & 63; sp = -1; } else { const int v = u - 1024; const int bh = v >> 3; b = bh >> 3; h = bh & 7; qb = 64; sp = v & 7; }
                        att::PolMLA pol; pol.init(Kc, Vm, Qb, AO, PART, rope, b, h, qb, sp);
                        att::attn_unit<192, 128>(pol, (char*)lds); }
                    } else if (EN(7)) {
                        const int v = u - N_MLA; int b, h, qb; if (v < 1024) { const int bh = v >> 6; b = bh >> 3; h = bh & 7; qb = v & 63; } else { const int bh = v - 1024; b = bh >> 3; h = bh & 7; qb = 64; }
                        for (int i = threadIdx.x; i < 15 * 31; i += NTHREADS) tab[i] = P.ab_rpb[h * 465 + i] * LOG2E;
                        __syncthreads();
                        att::PolNA pol; pol.init(Z, AO, tab, b, h, qb);
                        att::attn_unit<128, 128>(pol, (char*)lds);
                    }
                }
            }
            GRID_BAR();
            {
                PH_IDS();
                const float* PART = (const float*)(wsl + WS_PART);
                for (int it = gw; it < 2 * 8 * 16; it += NGW) {
                    const int row = it & 15, bh = it >> 4, b = bh >> 3, h = bh & 7;
                    const float* pp = PART + ((size_t)(bh * 8) * 16 + row) * 132;
                    float M = -3e38f;
#pragma unroll
                    for (int sp = 0; sp < 8; ++sp) M = fmaxf(M, pp[(size_t)sp * 16 * 132 + 128]);
                    float L = 0.f, o0 = 0.f, o1 = 0.f;
#pragma unroll
                    for (int sp = 0; sp < 8; ++sp) { const float* q = pp + (size_t)sp * 16 * 132; const float w = __builtin_amdgcn_exp2f(q[128] - M); L += w * q[129]; o0 += w * q[lane]; o1 += w * q[64 + lane]; }
                    const float rl = 1.0f / L; bf16* op = AO + (size_t)(RMETA + 16 * b + row) * AOW + h * 128;
                    op[lane] = (bf16)f2bf(o0 * rl); op[64 + lane] = (bf16)f2bf(o1 * rl);
                }
            }
        } else {
            WSL();
            if (EN(8)) {
                const int wv = __builtin_amdgcn_readfirstlane((int)threadIdx.x >> 6);
                for (int u = vcu; u < 4096; u += G) {
                    att::PolSWAG pol; pol.init(Z, AO, P.c_sinks, u >> 11, (u >> 9) & 3, u & 511, wv);
                    att::attn_unit<64, 64>(pol, (char*)lds);
                }
                for (int u = vcu; u < 64; u += G) {
                    att::PolSWA pol; pol.init(Z, AO, P.c_sinks, u >> 5, u & 31, 64);
                    att::attn_unit<64, 64>(pol, (char*)lds);
                }
            }
        }
        GRID_BAR();
        if (EN(9)) {
            WSL();
            pg8::Gemm g{AO, layer == 0 ? Wout0 : Wout1, AOW, D, D};
            pg8::TileOrder S; S.init(NR / 256, 8, G, bx, 0);
            pg8::EpiResid E{Hm, D, layer == 0 ? P.x : nullptr, P.meta};
            pg8::gemm_phase(ldsl, g, S, E);
            if (G == 256) {
                const int rem = (129 * 8) % 256;
                if (bx >= rem) { PH_IDS(); const size_t lo = (size_t)layer * NE * D * D;
                    convert_experts(P.ec_w_gate + lo, P.ec_w_up + lo, P.ec_w_down + lo, P.norm_ffn + (size_t)layer * D, Wgu, Wd, (LAS float*)ldsl, (bx - rem) * NWAVES + wave, (256 - rem) * NWAVES, lane, CV_ITEMS - CV_OUT, CV_ITEMS); }
            }
        }
        GRID_BAR();
        if (EN(10)) {
            PH_IDS();
            LAS float* wb = (LAS float*)ldsl;
            LAS float* red = (LAS float*)(ldsl + 131072);
            const float* wsrc = P.ec_w_router + (size_t)layer * D * NE; const float* gf = P.norm_ffn + (size_t)layer * D;
            for (int i = tid; i < D * 4; i += NTHREADS) { const int k = i >> 2, eg = i & 3; const f32x4 w4 = *(const f32x4*)(wsrc + (size_t)k * NE + 4 * eg) * gf[k];
                const int base = ((k >> 2) * 16 + 4 * eg) * 4 + (k & 3);
                wb[base] = w4.x; wb[base + 4] = w4.y; wb[base + 8] = w4.z; wb[base + 12] = w4.w; }
            __syncthreads();
            const int r = lane & 15, kq = lane >> 4;
            u32x4 hv[8];
            { const bf16* hp = Hm + (size_t)(vcu * 16 + r) * D + 256 * wave + 8 * kq;
#pragma unroll
              for (int i = 0; i < 8; ++i) hv[i] = *(const u32x4*)(hp + 32 * i); }
            for (int blk = vcu; blk < NTOK / 16; blk += G) {
                const int row0 = blk * 16;
                f32x4 acc = {0.f, 0.f, 0.f, 0.f}; float ss = 0.f;
#pragma unroll
                for (int i = 0; i < 8; ++i) {
                    const LAS f32x4* bp = (const LAS f32x4*)wb + (((wave * 8 + i) * 4 + kq) * 2) * 16 + r;
                    const f32x4 b0 = bp[0], b1 = bp[16];
                    const float a0 = bflo(hv[i].x), a1 = bfhi(hv[i].x), a2 = bflo(hv[i].y), a3 = bfhi(hv[i].y), a4 = bflo(hv[i].z), a5 = bfhi(hv[i].z), a6 = bflo(hv[i].w), a7 = bfhi(hv[i].w);
                    acc = __builtin_amdgcn_mfma_f32_16x16x4f32(a0, b0.x, acc, 0, 0, 0); acc = __builtin_amdgcn_mfma_f32_16x16x4f32(a1, b0.y, acc, 0, 0, 0);
                    acc = __builtin_amdgcn_mfma_f32_16x16x4f32(a2, b0.z, acc, 0, 0, 0); acc = __builtin_amdgcn_mfma_f32_16x16x4f32(a3, b0.w, acc, 0, 0, 0);
                    acc = __builtin_amdgcn_mfma_f32_16x16x4f32(a4, b1.x, acc, 0, 0, 0); acc = __builtin_amdgcn_mfma_f32_16x16x4f32(a5, b1.y, acc, 0, 0, 0);
                    acc = __builtin_amdgcn_mfma_f32_16x16x4f32(a6, b1.z, acc, 0, 0, 0); acc = __builtin_amdgcn_mfma_f32_16x16x4f32(a7, b1.w, acc, 0, 0, 0);
                    ss += (a0 * a0 + a1 * a1) + (a2 * a2 + a3 * a3) + (a4 * a4 + a5 * a5) + (a6 * a6 + a7 * a7);
                }
                if (blk + G < NTOK / 16) {
                    const bf16* hp = Hm + (size_t)((blk + G) * 16 + r) * D + 256 * wave + 8 * kq;
#pragma unroll
                    for (int i = 0; i < 8; ++i) hv[i] = *(const u32x4*)(hp + 32 * i); }
                ss += __shfl_xor(ss, 16); ss += __shfl_xor(ss, 32);
                LAS float* rw = red + wave * 272;
                *(LAS f32x4*)(rw + 4 * lane) = acc;
                if (lane < 16) rw[256 + lane] = ss;
                __syncthreads();
                if (wave == 0) {
                    f32x4 lg = {0.f, 0.f, 0.f, 0.f}; float sq[4] = {0.f, 0.f, 0.f, 0.f};
#pragma unroll
                    for (int w = 0; w < 8; ++w) { lg = lg + *(const LAS f32x4*)(red + w * 272 + 4 * lane);
#pragma unroll
                        for (int j = 0; j < 4; ++j) sq[j] += red[w * 272 + 256 + 4 * kq + j]; }
#pragma unroll
                    for (int j = 0; j < 4; ++j) {
                        const int row = row0 + 4 * kq + j; const float rs = 1.0f / sqrtf(sq[j] * (1.f / D) + EPS);
                        const float x = lg[j] * rs;
                        float mx = x; mx = fmaxf(mx, __shfl_xor(mx, 1)); mx = fmaxf(mx, __shfl_xor(mx, 2)); mx = fmaxf(mx, __shfl_xor(mx, 4)); mx = fmaxf(mx, __shfl_xor(mx, 8));
                        const float p = __expf(x - mx); float sum = p;
                        sum += __shfl_xor(sum, 1); sum += __shfl_xor(sum, 2); sum += __shfl_xor(sum, 4); sum += __shfl_xor(sum, 8);
                        const int b = row < RMETA ? (row >> 14) : ((row - RMETA) >> 4); const int tok = row < RMETA ? NMETA + (row & (SEQ - 1)) : ((row - RMETA) & 15);
                        aff[(size_t)(b * NE + r) * LTOK + tok] = p / sum;
                        if (r == 0) rsf[row] = rs;
                    }
                }
                __syncthreads();
            }
        }
        GRID_BAR();
        if (EN(11) && vcu < 32) {
            PH_IDS();
            const int be = vcu, b = be >> 4, e = be & 15;
            LAS unsigned* keys = (LAS unsigned*)ldsl;
            LAS unsigned* hist = (LAS unsigned*)(ldsl + 66560);
            LAS unsigned* sh = (LAS unsigned*)(ldsl + 66560 + 1024);
            const float* av = aff + (size_t)be * LTOK;
            for (int i = tid; i < LTOK; i += NTHREADS) keys[i] = __float_as_uint(av[i]);
            __syncthreads();
            const int i0 = tid * 33, i1 = (i0 + 33 < LTOK) ? i0 + 33 : LTOK;
            unsigned kv[33];
#pragma unroll
            for (int q = 0; q < 33; ++q) kv[q] = (i0 + q < LTOK) ? keys[i0 + q] : 0u;
            unsigned T = 0u;
            for (int bit = 30; bit >= 0; --bit) {
                const unsigned cand = T | (1u << bit); unsigned c = 0u;
#pragma unroll
                for (int q = 0; q < 33; ++q) c += 1u - ((kv[q] - cand) >> 31);
#pragma unroll
                for (int o = 1; o < 64; o <<= 1) c += __shfl_xor(c, o);
                LAS unsigned* slot = sh + 32 + (bit & 1) * 8;
                if (lane == 0) slot[wave] = c;
                __syncthreads();
                unsigned tot = 0u;
#pragma unroll
                for (int w = 0; w < 8; ++w) tot += slot[w];
                T |= (1u - ((tot - (unsigned)CAP) >> 31)) << bit;
            }
            unsigned cgt = 0u, ceq = 0u;
#pragma unroll
            for (int q = 0; q < 33; ++q) { const unsigned k = kv[q]; cgt += k > T ? 1u : 0u; ceq += (k == T && i0 + q < LTOK) ? 1u : 0u; }
            unsigned pk = cgt | (ceq << 16), incl = pk;
#pragma unroll
            for (int o = 1; o < 64; o <<= 1) { const unsigned t = __shfl_up(incl, o); if (lane >= o) incl += t; }
            if (lane == 63) sh[16 + wave] = incl;
            __syncthreads();
            unsigned wbase = 0u, totgt = 0u;
            for (int w = 0; w < 8; ++w) { const unsigned x = sh[16 + w]; totgt += x & 0xffffu; if (w < wave) wbase += x; }
            const unsigned krem = (unsigned)CAP - totgt;
            const unsigned excl = wbase + incl - pk;
            unsigned ngt = excl & 0xffffu, neq = excl >> 16;
            int* tsl = tokslot + (size_t)be * LTOK; int* stk = slottok + (size_t)be * CAP; float* xg = xgate + (size_t)e * XPE + b * CAP; int* xm = xmap + (size_t)e * XPE + b * CAP; float* xr = xrs + (size_t)e * XPE + b * CAP;
            for (int i = i0; i < i1; ++i) { const unsigned k = keys[i]; bool sel = k > T; if (k == T) { sel = neq < krem; }
                int slot = -1;
                if (sel) { slot = (int)(ngt + (neq < krem ? neq : krem)); if (slot < CAP) { const int trow = i < NMETA ? RMETA + 16 * b + i : b * SEQ + (i - NMETA); stk[slot] = trow; xm[slot] = trow; xg[slot] = __uint_as_float(k); xr[slot] = rsf[trow]; } else slot = -1; }
                if (k > T) ++ngt; if (k == T) ++neq;
                tsl[i] = slot; }
            if (b == 1) for (int i = tid; i < XPE - 2 * CAP; i += NTHREADS) { xgate[(size_t)e * XPE + 2 * CAP + i] = 0.f; xmap[(size_t)e * XPE + 2 * CAP + i] = NR - 1; xrs[(size_t)e * XPE + 2 * CAP + i] = 0.f; }
        }
        else if (EN(11) && G == 256) {
            PH_IDS(); const int cin = layer == 0 ? CV_IN0 : CV_IN1, hi_ = CV_ITEMS - CV_OUT - cin; const size_t lo = (size_t)layer * NE * D * D;
            convert_experts(P.ec_w_gate + lo, P.ec_w_up + lo, P.ec_w_down + lo, P.norm_ffn + (size_t)layer * D, Wgu, Wd, (LAS float*)ldsl, (vcu - 32) * NWAVES + wave, 224 * NWAVES, lane, hi_ - CV_TOPK, hi_);
        }
        GRID_BAR();
        if (EN(13)) {
            WSL();
            pg8::Gemm g{Hm, Wgu, D, D, D, xmap};
            pg8::TileOrder S; S.init(XROWS / 256, 16, G, bx, 17);
            pg8::EpiSwiGLU E{HMID, D, xrs};
            pg8::gemm_phase<true>(ldsl, g, S, E);
        }
        GRID_BAR();
        if (EN(14)) {
            WSL();
            pg8::Gemm g{HMID, Wd, D, D, D};
            pg8::TileOrder S; S.init(XROWS / 256, 8, G, bx, 17);
            pg8::EpiBf16S E{XS, D, xgate, 0, 0, 1.f};
            pg8::gemm_phase(ldsl, g, S, E);
        }
        GRID_BAR();
        if (EN(15)) {
            PH_IDS();
            const float* gn = layer == 0 ? P.norm_mix + D : P.norm_final;
            for (int row = gw; row < (layer == 0 ? NTOK : RMETA); row += NGW) {
                const int b = row < RMETA ? (row >> 14) : ((row - RMETA) >> 4); const int tok = row < RMETA ? NMETA + (row & (SEQ - 1)) : ((row - RMETA) & 15);
                f32x4 v[8]; bf16* hrow = Hm + (size_t)row * D; load_row_bf16(hrow, lane, v);
                int sl[NE];
#pragma unroll
                for (int e = 0; e < NE; ++e) sl[e] = tokslot[(size_t)(b * NE + e) * LTOK + tok];
                int cnt = 0, o0 = 0, o1 = 0, o2 = 0, o3 = 0;
#pragma unroll
                for (int e = 0; e < NE; ++e) {
                    const int s = __builtin_amdgcn_readfirstlane(sl[e]); const int ok = s >= 0 ? 1 : 0, xr_ = e * XPE + b * CAP + s;
                    o0 = (ok && cnt == 0) ? xr_ : o0; o1 = (ok && cnt == 1) ? xr_ : o1; o2 = (ok && cnt == 2) ? xr_ : o2; o3 = (ok && cnt == 3) ? xr_ : o3; cnt += ok;
                }
                { const float w0 = cnt > 0 ? 1.f : 0.f, w1 = cnt > 1 ? 1.f : 0.f, w2 = cnt > 2 ? 1.f : 0.f, w3 = cnt > 3 ? 1.f : 0.f;
                  o1 = cnt > 1 ? o1 : o0; o2 = cnt > 2 ? o2 : o0; o3 = cnt > 3 ? o3 : o0;
                  const u32x2* p0 = (const u32x2*)(XS + (size_t)o0 * D) + lane; const u32x2* p1 = (const u32x2*)(XS + (size_t)o1 * D) + lane;
                  const u32x2* p2 = (const u32x2*)(XS + (size_t)o2 * D) + lane; const u32x2* p3 = (const u32x2*)(XS + (size_t)o3 * D) + lane;
                  u32x2 y0[8], y1[8], y2[8], y3[8];
#pragma unroll
                  for (int j = 0; j < 8; ++j) { y0[j] = p0[64 * j]; y1[j] = p1[64 * j]; y2[j] = p2[64 * j]; y3[j] = p3[64 * j]; }
#pragma unroll
                  for (int j = 0; j < 8; ++j) {
                      v[j].x += (w0 * bflo(y0[j].x) + w1 * bflo(y1[j].x)) + (w2 * bflo(y2[j].x) + w3 * bflo(y3[j].x)); v[j].y += (w0 * bfhi(y0[j].x) + w1 * bfhi(y1[j].x)) + (w2 * bfhi(y2[j].x) + w3 * bfhi(y3[j].x));
                      v[j].z += (w0 * bflo(y0[j].y) + w1 * bflo(y1[j].y)) + (w2 * bflo(y2[j].y) + w3 * bflo(y3[j].y)); v[j].w += (w0 * bfhi(y0[j].y) + w1 * bfhi(y1[j].y)) + (w2 * bfhi(y2[j].y) + w3 * bfhi(y3[j].y)); } }
                if (cnt > 4) {
                    int seen = 0;
#pragma unroll
                    for (int e = 0; e < NE; ++e) {
                        const int s = __builtin_amdgcn_readfirstlane(sl[e]);
                        if (s >= 0) { if (seen >= 4) { const u32x2* yp = (const u32x2*)(XS + (size_t)(e * XPE + b * CAP + s) * D) + lane;
#pragma unroll
                            for (int j = 0; j < 8; ++j) { const u32x2 w = yp[64 * j]; v[j].x += bflo(w.x); v[j].y += bfhi(w.x); v[j].z += bflo(w.y); v[j].w += bfhi(w.y); } }
                          ++seen; }
                    }
                }
                const float rs = row_rs(v);
                if (layer == 0) {
                    store_row_bf16(hrow, lane, v);
                    if (lane == 0) rsm[row] = rs;
                } else {
                    const f32x4* gp = (const f32x4*)gn + lane; f32x4* op = (f32x4*)(P.out + (size_t)row * D) + lane;
#pragma unroll
                    for (int j = 0; j < 8; ++j) op[64 * j] = v[j] * rs * gp[64 * j];
                }
            }
            if (layer == 0) {
                LAS float* scr = (LAS float*)(ldsl + wave * 16640);
                const size_t lo = (size_t)NE * D * D;
                convert_experts(P.ec_w_gate + lo, P.ec_w_up + lo, P.ec_w_down + lo, P.norm_ffn + D, Wgu, Wd, scr, gw, NGW, lane, 0, G == 256 ? CV_ITEMS - CV_IN1 - CV_OUT - CV_TOPK : CV_ITEMS);
            }
        }
        if (layer == 0) GRID_BAR();
    }
#undef GRID_BAR
}

extern "C" void kernel_launch(void* const* d_in, const int* in_sizes, int n_in, void* d_out, int out_size, void* d_ws, size_t ws_size, hipStream_t stream) {
    static int grid = 0;
    if (grid == 0) {
        if (n_in != 19 || ws_size < WS_END) { fprintf(stderr, "kernel_launch: unexpected n_in %d / ws %zu (need %zu)\n", n_in, ws_size, (size_t)WS_END); grid = -1; return; }
        int dev = 0, cus = 0, per_cu = 0;
        if (hipGetDevice(&dev) != hipSuccess || hipDeviceGetAttribute(&cus, hipDeviceAttributeMultiprocessorCount, dev) != hipSuccess) { grid = -1; return; }
        if (hipFuncSetAttribute((const void*)fwd_kernel, hipFuncAttributeMaxDynamicSharedMemorySize, LDS_BYTES) != hipSuccess) { fprintf(stderr, "kernel_launch: hipFuncSetAttribute failed\n"); grid = -1; return; }
        if (hipOccupancyMaxActiveBlocksPerMultiprocessor(&per_cu, (const void*)fwd_kernel, NTHREADS, LDS_BYTES) != hipSuccess || per_cu < 1) { fprintf(stderr, "kernel_launch: occupancy query reports %d\n", per_cu); }
        (void)hipGetLastError();
        grid = cus;
    }
    if (grid < 0) return;
    if (hipMemsetAsync((char*)d_ws + WS_CTL, 0, CTL_BYTES, stream) != hipSuccess) return;
    Params p{};
    p.x = (const float*)d_in[0]; p.meta = (const float*)d_in[1]; p.norm_mix = (const float*)d_in[2]; p.norm_ffn = (const float*)d_in[3]; p.norm_final = (const float*)d_in[4];
    p.ab_w_in = (const float*)d_in[5]; p.ab_q_norm = (const float*)d_in[6]; p.ab_kv_norm = (const float*)d_in[7]; p.ab_w_uq = (const float*)d_in[8]; p.ab_w_ukv = (const float*)d_in[9];
    p.ab_rpb = (const float*)d_in[10]; p.ab_w_out = (const float*)d_in[11]; p.c_w_in = (const float*)d_in[12]; p.c_sinks = (const float*)d_in[13]; p.c_w_out = (const float*)d_in[14];
    p.ec_w_router = (const float*)d_in[15]; p.ec_w_gate = (const float*)d_in[16]; p.ec_w_up = (const float*)d_in[17]; p.ec_w_down = (const float*)d_in[18];
    p.out = (float*)d_out; p.ws = (unsigned char*)d_ws;
    hipLaunchKernelGGL(fwd_kernel, dim3(grid), dim3(NTHREADS), LDS_BYTES, stream, p);
    const hipError_t le = hipPeekAtLastError();
    if (le != hipSuccess) fprintf(stderr, "kernel_launch: launch failed: %s\n", hipGetErrorName(le));
}
```

```cpp
#include <hip/hip_runtime.h>
#include <cstdio>
#include <cstdint>

#define GAS __attribute__((address_space(1)))
#define LAS __attribute__((address_space(3)))
typedef unsigned short bf16;
typedef short bf16x8 __attribute__((ext_vector_type(8)));
typedef short s16x4 __attribute__((ext_vector_type(4)));
typedef float f32x2 __attribute__((ext_vector_type(2)));
typedef float f32x4 __attribute__((ext_vector_type(4)));
typedef float f32x16 __attribute__((ext_vector_type(16)));
typedef unsigned u32x2 __attribute__((ext_vector_type(2)));
typedef unsigned u32x4 __attribute__((ext_vector_type(4)));

constexpr int D = 2048, NBATCH = 2, SEQ = 16384, NMETA = 16, LTOK = 16400, NTOK = 32800, NR = 33024, RMETA = 32768;
constexpr int ZW = 4352, ZQL = 0, ZKVL = 512, ZNAQ = 1024, ZNAK = 2048, ZNAV = 3072, ZKR = 4096;
constexpr int QW = 1536, KCW = 1536, VMW = 1024, Z1W = 2560, AOW = 2048;
constexpr int NE = 16, CAP = 2050, XPE = 4352, XROWS = NE * XPE;
constexpr float EPS = 1e-6f, LOG2E = 1.4426950408889634f;
constexpr float C_MLA = 0.07216878364870322f * LOG2E, C_NA = 0.08838834764831845f * LOG2E, C_SWA = 0.125f * LOG2E;
constexpr int NWAVES = 8, NTHREADS = 512;

constexpr size_t al256(size_t x) { return (x + 255) & ~(size_t)255; }
constexpr size_t WS_CTL = 0, CTL_BYTES = 1u << 20;
constexpr size_t WS_ROPE = WS_CTL + CTL_BYTES;
constexpr size_t WS_RSQ = al256(WS_ROPE + (size_t)LTOK * 32 * 2 * 4);
constexpr size_t WS_RSKV = al256(WS_RSQ + (size_t)NR * 4);
constexpr size_t WS_AFF = al256(WS_RSKV + (size_t)NR * 4);
constexpr size_t WS_TOKSLOT = al256(WS_AFF + (size_t)32 * LTOK * 4);
constexpr size_t WS_SLOTTOK = al256(WS_TOKSLOT + (size_t)32 * LTOK * 4);
constexpr size_t WS_XGATE = al256(WS_SLOTTOK + (size_t)32 * CAP * 4);
constexpr size_t WS_XMAP = al256(WS_XGATE + (size_t)XROWS * 4);
constexpr size_t WS_PART = al256(WS_XMAP + (size_t)XROWS * 4);
constexpr size_t WS_WIN0 = al256(WS_PART + (size_t)2 * 8 * 8 * 16 * 132 * 4);
constexpr size_t WS_WUQ = al256(WS_WIN0 + (size_t)ZW * D * 2);
constexpr size_t WS_WUKV = al256(WS_WUQ + (size_t)1536 * 512 * 2);
constexpr size_t WS_WOUT0 = al256(WS_WUKV + (size_t)2048 * 512 * 2);
constexpr size_t WS_WIN1 = al256(WS_WOUT0 + (size_t)D * D * 2);
constexpr size_t WS_WOUT1 = al256(WS_WIN1 + (size_t)Z1W * D * 2);
constexpr size_t WS_WGU = al256(WS_WOUT1 + (size_t)D * D * 2);
constexpr size_t WS_WD = al256(WS_WGU + (size_t)NE * 4096 * D * 2);
constexpr size_t WS_H = al256(WS_WD + (size_t)NE * D * D * 2);
constexpr size_t WS_RSF = al256(WS_H + (size_t)NR * D * 2);
constexpr size_t WS_XRS = al256(WS_RSF + (size_t)NR * 4);
constexpr size_t WS_RSM = al256(WS_XRS + (size_t)XROWS * 4);
static_assert(WS_RSM + (size_t)NR * 4 <= WS_H + (size_t)NR * D * 4, "h region");
constexpr size_t WS_U = al256(WS_H + (size_t)NR * D * 4);
constexpr size_t WS_R = al256(WS_U + (size_t)NR * D * 2);
constexpr size_t WS_Z = WS_R;
constexpr size_t WS_Q = al256(WS_Z + (size_t)NR * ZW * 2);
constexpr size_t WS_KC = al256(WS_Q + (size_t)NR * QW * 2);
constexpr size_t WS_VM = al256(WS_KC + (size_t)NR * KCW * 2);
constexpr size_t WS_AO = al256(WS_VM + (size_t)NR * VMW * 2);
constexpr size_t WS_END_ATT = al256(WS_AO + (size_t)NR * AOW * 2);
constexpr size_t WS_XS = WS_R;
constexpr size_t WS_HMID = al256(WS_XS + (size_t)XROWS * D * 2);
constexpr size_t WS_END_MOE = al256(WS_HMID + (size_t)XROWS * D * 2);
constexpr size_t WS_END = WS_END_ATT > WS_END_MOE ? WS_END_ATT : WS_END_MOE;
static_assert(WS_END < (size_t)2000 * 1024 * 1024, "workspace map must fit 2 GiB with margin");

constexpr int CW_BAR = 4096, CW_TICKET = 65536;

constexpr int LDS_BYTES = 147456;
constexpr int MISC_OFF = 147456 - 256;

__device__ __forceinline__ unsigned f2bf(float f) { unsigned u = __builtin_bit_cast(unsigned, f); return (u + 0x7fffu + ((u >> 16) & 1u)) >> 16; }
__device__ __forceinline__ unsigned pk2(float lo, float hi) { return f2bf(lo) | (f2bf(hi) << 16); }
__device__ __forceinline__ float bf2f(unsigned short x) { return __builtin_bit_cast(float, (unsigned)x << 16); }
__device__ __forceinline__ float bflo(unsigned w) { return __builtin_bit_cast(float, w << 16); }
__device__ __forceinline__ float bfhi(unsigned w) { return __builtin_bit_cast(float, w & 0xffff0000u); }
__device__ __forceinline__ float wave_sum(float v) {
#pragma unroll
    for (int o = 1; o < 64; o <<= 1) v += __shfl_xor(v, o);
    return v;
}
#define LDS_WAIT() asm volatile("s_waitcnt lgkmcnt(0)" ::: "memory")

#define XB_TMO      128
#define XB_XCNT(j)  (256  + 64 * (j))
#define XB_XSUB(j)  (1280 + 64 * (j))
#define XB_XGEN(j)  (2304 + 64 * (j))
#define XB_TOP      3328
#define XB_TOPGEN   3392
#define XCD_BAR_WORDS 3456
#define XB_SPIN_CAP (1u << 22)

__device__ __forceinline__ unsigned xb_ld(unsigned* p)              { return __hip_atomic_load(p, __ATOMIC_RELAXED, __HIP_MEMORY_SCOPE_AGENT); }
__device__ __forceinline__ unsigned xb_add(unsigned* p, unsigned v) { return __hip_atomic_fetch_add(p, v, __ATOMIC_RELAXED, __HIP_MEMORY_SCOPE_AGENT); }
__device__ __forceinline__ unsigned xb_xcc_id() { return (unsigned)__builtin_amdgcn_readfirstlane((int)((unsigned)__builtin_amdgcn_s_getreg((3 << 11) | 20) & 0xFu)); }
#define XB_SPIN(cond, bar) do { unsigned _sp = 0; while (cond) { __builtin_amdgcn_s_sleep(1); \
    if ((++_sp & 255u) == 0u) { if (xb_ld(&(bar)[XB_TMO])) break; if (_sp > XB_SPIN_CAP) { atomicAdd(&(bar)[XB_TMO], 1u); break; } } } } while (0)

struct XcdBarrier { unsigned* bar; unsigned x; volatile LAS unsigned* st; };

__device__ __forceinline__ XcdBarrier xcd_barrier_post(unsigned* bar, volatile LAS unsigned* st) {
    XcdBarrier b; b.bar = bar; b.x = xb_xcc_id(); b.st = st;
    if (threadIdx.x == 0) (void)xb_add(&bar[XB_XCNT(b.x)], 1u);
    return b;
}
__device__ __forceinline__ void xcd_barrier_complete(unsigned* bar, unsigned x, unsigned& nloc, unsigned& nx) {
    const unsigned G = gridDim.x * gridDim.y * gridDim.z;
    unsigned sum, cnt, mine, sp = 0u;
    for (;;) {
        sum = 0u; cnt = 0u; mine = 0u;
#pragma unroll
        for (unsigned j = 0; j < 16; ++j) { const unsigned c = xb_ld(&bar[XB_XCNT(j)]); sum += c; cnt += (c > 0u) ? 1u : 0u; mine = (j == x) ? c : mine; }
        if (sum == G) break;
        __builtin_amdgcn_s_sleep(1);
        if ((++sp & 255u) == 0u) { if (xb_ld(&bar[XB_TMO])) break; if (sp > XB_SPIN_CAP) { atomicAdd(&bar[XB_TMO], 1u); break; } }
    }
    nloc = mine > 0u ? mine : 1u; nx = cnt > 0u ? cnt : 1u;
}
__device__ __forceinline__ void xcd_barrier(const XcdBarrier& b) {
    asm volatile("s_waitcnt vmcnt(0)" ::: "memory");
    __syncthreads();
    if (threadIdx.x == 0) {
        unsigned* bar = b.bar; asm volatile("" : "+s"(bar));
        __builtin_amdgcn_s_waitcnt(0);
        const unsigned bx_ = xb_xcc_id();
        unsigned nloc = b.st[0], nx = b.st[1];
        if (nloc == 0u) { xcd_barrier_complete(bar, bx_, nloc, nx); b.st[0] = nloc; b.st[1] = nx; }
        const unsigned old = xb_add(&bar[XB_XSUB(bx_)], 1u);
        const unsigned gen = old / nloc;
        if (old + 1u == (gen + 1u) * nloc) {
            __builtin_amdgcn_fence(__ATOMIC_RELEASE, "agent");
            asm volatile("s_waitcnt vmcnt(0)" ::: "memory");
            const unsigned og = xb_add(&bar[XB_TOP], 1u);
            const unsigned tg = og / nx;
            if (og + 1u == (tg + 1u) * nx) xb_add(&bar[XB_TOPGEN], 1u);
            else XB_SPIN(xb_ld(&bar[XB_TOPGEN]) == tg, bar);
            __builtin_amdgcn_fence(__ATOMIC_ACQUIRE, "agent");
            xb_add(&bar[XB_XGEN(bx_)], 1u);
            asm volatile("s_waitcnt vmcnt(0)" ::: "memory");
        } else {
            XB_SPIN(xb_ld(&bar[XB_XGEN(bx_)]) == gen, bar);
            __builtin_amdgcn_fence(__ATOMIC_ACQUIRE, "agent");
            asm volatile("s_waitcnt vmcnt(0)" ::: "memory");
        }
    }
    __syncthreads();
}

namespace pg8 {
constexpr int BM = 256, BK = 64, HALF = 128, HTB = HALF * BK * 2, STAGE_BYTES = 8 * HTB, NXCD = 8, WGM = 8;
__host__ __device__ __forceinline__ int lds_byte(int r, int c) { const int st = (r >> 4) * 2 + (c >> 5), rr = r & 15, cc = c & 31, ob = rr * 64 + cc * 2; return st * 1024 + (ob ^ (((ob >> 9) & 1) << 5)); }
__host__ __device__ __forceinline__ void stage_rc(int b, int& R, int& C) { const int st = b / 1024, sb = b % 1024, swz = sb ^ (((sb >> 9) & 1) << 5); R = (st >> 1) * 16 + swz / 64; C = (st & 1) * 32 + (swz % 64) / 2; }
__host__ __device__ __forceinline__ int perm32(int rho) { const int n = rho >> 4, i = rho & 15; return 8 * (i >> 2) + 4 * n + (i & 3); }

struct Unit { int pm, pn, pb; };
struct Gemm { const bf16* A; const bf16* Bt; int lda, ldb, K; const int* amap; };

struct TileOrder {
    int nM, nN, nwg, G, c, grp;
    __device__ void init(int nM_, int nN_, int G_, int c_, int grp_) { nM = nM_; nN = nN_; nwg = nM * nN; G = G_; c = c_; grp = grp_; }
    __device__ bool next(int i, Unit& u) const {
        const long L = (long)i * G + c; if (L >= nwg) return false;
        int wgid = (int)L; { const int q = nwg / NXCD, r = nwg % NXCD, xcd = wgid % NXCD, off = wgid / NXCD; wgid = (xcd < r ? xcd * (q + 1) : r * (q + 1) + (xcd - r) * q) + off; }
        const int nig = WGM * nN, gid = wgid / nig, fm = gid * WGM, gsz = (nM - fm) < WGM ? (nM - fm) : WGM;
        u.pm = fm + ((wgid % nig) % gsz); u.pn = (wgid % nig) / gsz; u.pb = grp ? (u.pm / grp) * nN + u.pn : u.pn; return true;
    }
};

__device__ __forceinline__ unsigned cvt_pk_bf16(float lo, float hi) { unsigned r; asm volatile("v_cvt_pk_bf16_f32 %0, %1, %2" : "=v"(r) : "v"(lo), "v"(hi)); return r; }

struct EpiBf16S {
    static constexpr bool PERM = true;
    bf16* O; int ldc; const float* rowscale; int cs_lo, cs_hi; float cscale;
    __device__ __forceinline__ void operator()(const f32x4 (&acc)[2][2][4][2], const Unit& u, int wr, int wc, int fr, int fq) const {
        const int row0 = u.pm * BM + wr * 64 + fr, col0 = u.pn * BM + wc * 32 + 8 * fq;
        const float cs = (u.pn >= cs_lo && u.pn < cs_hi) ? cscale : 1.f;
#pragma unroll
        for (int ai = 0; ai < 2; ++ai)
#pragma unroll
            for (int m = 0; m < 4; ++m) { const int row = row0 + ai * HALF + m * 16; const float s = (rowscale ? rowscale[row] : 1.f) * cs; bf16* rowp = O + (size_t)row * ldc + col0;
#pragma unroll
                for (int bj = 0; bj < 2; ++bj) { const f32x4 v0 = acc[ai][bj][m][0] * s, v1 = acc[ai][bj][m][1] * s;
                    u32x4 w; w.x = cvt_pk_bf16(v0[0], v0[1]); w.y = cvt_pk_bf16(v0[2], v0[3]); w.z = cvt_pk_bf16(v1[0], v1[1]); w.w = cvt_pk_bf16(v1[2], v1[3]);
                    *(u32x4*)(rowp + bj * HALF) = w; } }
    }
};
struct EpiKV {
    static constexpr bool PERM = true;
    bf16* Kc; bf16* Vm; const float* rowscale;
    __device__ __forceinline__ void operator()(const f32x4 (&acc)[2][2][4][2], const Unit& u, int wr, int wc, int fr, int fq) const {
        const int row0 = u.pm * BM + wr * 64 + fr, cc = wc * 32 + 8 * fq;
#pragma unroll
        for (int ai = 0; ai < 2; ++ai)
#pragma unroll
            for (int m = 0; m < 4; ++m) { const int row = row0 + ai * HALF + m * 16; const float s = rowscale[row];
#pragma unroll
                for (int bj = 0; bj < 2; ++bj) { const f32x4 v0 = acc[ai][bj][m][0] * s, v1 = acc[ai][bj][m][1] * s;
                    u32x4 w; w.x = cvt_pk_bf16(v0[0], v0[1]); w.y = cvt_pk_bf16(v0[2], v0[3]); w.z = cvt_pk_bf16(v1[0], v1[1]); w.w = cvt_pk_bf16(v1[2], v1[3]);
                    bf16* p = bj == 0 ? Kc + (size_t)row * KCW + u.pn * 192 + cc : Vm + (size_t)row * VMW + u.pn * 128 + cc;
                    *(u32x4*)p = w; } }
    }
};
struct EpiResid {
    static constexpr bool PERM = true;
    bf16* Hm; int ldc; const float* X; const float* Mt;
    __device__ __forceinline__ void operator()(const f32x4 (&acc)[2][2][4][2], const Unit& u, int wr, int wc, int fr, int fq) const {
        const int row0 = u.pm * BM + wr * 64 + fr, col0 = u.pn * BM + wc * 32 + 8 * fq;
#pragma unroll
        for (int ai = 0; ai < 2; ++ai)
#pragma unroll
            for (int m = 0; m < 4; ++m) { const int row = row0 + ai * HALF + m * 16; bf16* rowp = Hm + (size_t)row * ldc + col0;
                if (X) {
                    const float* sp = (row < RMETA ? X + (size_t)row * ldc : Mt + (size_t)((row - RMETA) & 15) * ldc) + col0; const float z = row < NTOK ? 1.f : 0.f;
#pragma unroll
                    for (int bj = 0; bj < 2; ++bj) { const f32x4 v0 = *(const f32x4*)(sp + bj * HALF) * z + acc[ai][bj][m][0], v1 = *(const f32x4*)(sp + bj * HALF + 4) * z + acc[ai][bj][m][1];
                        u32x4 w; w.x = cvt_pk_bf16(v0[0], v0[1]); w.y = cvt_pk_bf16(v0[2], v0[3]); w.z = cvt_pk_bf16(v1[0], v1[1]); w.w = cvt_pk_bf16(v1[2], v1[3]);
                        *(u32x4*)(rowp + bj * HALF) = w; }
                } else {
#pragma unroll
                    for (int bj = 0; bj < 2; ++bj) { const u32x4 s = *(const u32x4*)(rowp + bj * HALF);
                        const f32x4 v0 = (f32x4){bflo(s.x), bfhi(s.x), bflo(s.y), bfhi(s.y)} + acc[ai][bj][m][0], v1 = (f32x4){bflo(s.z), bfhi(s.z), bflo(s.w), bfhi(s.w)} + acc[ai][bj][m][1];
                        u32x4 w; w.x = cvt_pk_bf16(v0[0], v0[1]); w.y = cvt_pk_bf16(v0[2], v0[3]); w.z = cvt_pk_bf16(v1[0], v1[1]); w.w = cvt_pk_bf16(v1[2], v1[3]);
                        *(u32x4*)(rowp + bj * HALF) = w; }
                }
            }
    }
};
struct EpiSwiGLU {
    static constexpr bool PERM = true;
    bf16* O; int ldc; const float* rowscale;
    __device__ __forceinline__ void operator()(const f32x4 (&acc)[2][2][4][2], const Unit& u, int wr, int wc, int fr, int fq) const {
        const int row0 = u.pm * BM + wr * 64 + fr, col0 = u.pn * HALF + wc * 32 + 8 * fq;
#pragma unroll
        for (int ai = 0; ai < 2; ++ai)
#pragma unroll
            for (int m = 0; m < 4; ++m) { const int row = row0 + ai * HALF + m * 16; bf16* rowp = O + (size_t)row * ldc + col0; float r[8]; const float rs = rowscale[row];
#pragma unroll
                for (int n = 0; n < 2; ++n)
#pragma unroll
                    for (int j = 0; j < 4; ++j) { const float g = acc[ai][0][m][n][j] * rs, up = acc[ai][1][m][n][j] * rs;
                        const float sg = g * __builtin_amdgcn_rcpf(1.f + __builtin_amdgcn_exp2f(-g * LOG2E)); r[n * 4 + j] = sg * up; }
                u32x4 w; w.x = cvt_pk_bf16(r[0], r[1]); w.y = cvt_pk_bf16(r[2], r[3]); w.z = cvt_pk_bf16(r[4], r[5]); w.w = cvt_pk_bf16(r[6], r[7]);
                *(u32x4*)rowp = w; }
    }
};

template <bool GATHER = false, class Epi, class Sched>
__device__ __forceinline__ void gemm_phase(LAS unsigned char* lds, const Gemm g, const Sched& S, const Epi& E) {
    int tid_ = threadIdx.x; asm volatile("" : "+v"(tid_));
    const int tid = tid_, wid = __builtin_amdgcn_readfirstlane(tid >> 6), lane = tid & 63, wr = wid >> 2, wc = wid & 3, fr = lane & 15, fq = lane >> 4;
    const int K = g.K, nt = K / BK;
    unsigned voffA[2], voffB[2];
#pragma unroll
    for (int i = 0; i < 2; ++i) { int R, C; stage_rc(tid * 16 + i * 8192, R, C); const int Rb = Epi::PERM ? ((R & ~31) + perm32(R & 31)) : R;
        voffA[i] = (unsigned)(R * g.lda + C) * 2u; voffB[i] = (unsigned)(Rb * g.ldb + C) * 2u; }
    int RA[2], CA[2];
#pragma unroll
    for (int i = 0; i < 2; ++i) stage_rc(tid * 16 + i * 8192, RA[i], CA[i]);
    unsigned offC[2][2], offN[2][2]; int rawN[2][2];
#define PG8_GRAW(pm_) do { _Pragma("unroll") for (int h_ = 0; h_ < 2; ++h_) _Pragma("unroll") for (int i_ = 0; i_ < 2; ++i_) rawN[h_][i_] = g.amap[(pm_) * BM + h_ * HALF + RA[i_]]; } while (0)
#define PG8_GCONV(dst) do { _Pragma("unroll") for (int h_ = 0; h_ < 2; ++h_) _Pragma("unroll") for (int i_ = 0; i_ < 2; ++i_) dst[h_][i_] = (unsigned)(rawN[h_][i_] * g.lda + CA[i_]) * 2u; } while (0)
    const size_t kstep = (size_t)(BK * 2);
    const size_t hstepA = (size_t)HALF * g.lda * 2, hstepB = (size_t)HALF * g.ldb * 2;
    const size_t tstepA = 2 * hstepA, tstepB = 2 * hstepB;
    const unsigned ldsw = (unsigned)wid * 1024u;
    const int aoff = lds_byte(wr * 64 + fr, fq * 8), boff = lds_byte(wc * 32 + fr, fq * 8);
#define PG8_SA(b, h) (((b) * 2 + (h)) * HTB)
#define PG8_SB(b, h) ((4 + (b) * 2 + (h)) * HTB)
#define PG8_STAGE(bufoff, gbase, voff) do { _Pragma("unroll") for (int _i = 0; _i < 2; ++_i) \
        __builtin_amdgcn_global_load_lds((const unsigned*)((const char*)(gbase) + (voff)[_i]), (LAS unsigned*)(lds + (bufoff) + ldsw + _i * 8192), 16, 0, 0); } while (0)
#define PG8_LDA(dst, b, h) do { _Pragma("unroll") for (int m = 0; m < 4; ++m) _Pragma("unroll") for (int k = 0; k < 2; ++k) dst[m][k] = *(const LAS bf16x8*)(lds + PG8_SA(b, h) + aoff + m * 2048 + k * 1024); } while (0)
#define PG8_LDB(dst, b, h) do { _Pragma("unroll") for (int n = 0; n < 2; ++n) _Pragma("unroll") for (int k = 0; k < 2; ++k) dst[n][k] = *(const LAS bf16x8*)(lds + PG8_SB(b, h) + boff + n * 2048 + k * 1024); } while (0)
#define PG8_MMA(ai, bj, At, Bt) do { __builtin_amdgcn_s_setprio(1); _Pragma("unroll") for (int m = 0; m < 4; ++m) _Pragma("unroll") for (int n = 0; n < 2; ++n) _Pragma("unroll") for (int k = 0; k < 2; ++k) \
        acc[ai][bj][m][n] = __builtin_amdgcn_mfma_f32_16x16x32_bf16(Bt[n][k], At[m][k], acc[ai][bj][m][n], 0, 0, 0); __builtin_amdgcn_s_setprio(0); } while (0)
#define PG8_WAIT_V(n) asm volatile("s_waitcnt vmcnt(" #n ")" ::: "memory")
#define PG8_WAIT_L(n) asm volatile("s_waitcnt lgkmcnt(" #n ")" ::: "memory")
#define PG8_BAR __builtin_amdgcn_s_barrier()
#define PG8_SCHED __builtin_amdgcn_sched_barrier(0)
    Unit cur, nxt; int ui = 0;
    if (!S.next(0, cur)) return;
    f32x4 acc[2][2][4][2];
#pragma unroll
    for (int a = 0; a < 2; ++a)
#pragma unroll
        for (int b = 0; b < 2; ++b)
#pragma unroll
            for (int m = 0; m < 4; ++m)
#pragma unroll
                for (int n = 0; n < 2; ++n) acc[a][b][m][n] = (f32x4){0.f, 0.f, 0.f, 0.f};
    bf16x8 At[4][2], B0[2][2], B1[2][2];
    const char* cA = GATHER ? (const char*)g.A : (const char*)g.A + (size_t)cur.pm * tstepA; const char* cB = (const char*)g.Bt + (size_t)cur.pb * tstepB;
    if constexpr (GATHER) { PG8_GRAW(cur.pm); PG8_GCONV(offC); }
#define PG8_STAGE_A(bufoff, kbase, h_, offs) do { if constexpr (GATHER) { PG8_STAGE(bufoff, kbase, offs[h_]); } else { PG8_STAGE(bufoff, (kbase) + (h_) * hstepA, voffA); } } while (0)
    PG8_STAGE(PG8_SB(0, 0), cB, voffB); PG8_STAGE(PG8_SB(0, 1), cB + hstepB, voffB); PG8_STAGE_A(PG8_SA(0, 0), cA, 0, offC); PG8_STAGE_A(PG8_SA(0, 1), cA, 1, offC);
    if (wr == 1) PG8_BAR;
    PG8_WAIT_V(2); PG8_BAR;
    PG8_STAGE(PG8_SB(1, 0), cB + kstep, voffB); PG8_STAGE_A(PG8_SA(1, 0), cA + kstep, 0, offC); PG8_STAGE(PG8_SB(1, 1), cB + hstepB + kstep, voffB);
    PG8_WAIT_V(6); PG8_BAR;
    for (;;) {
        const bool has_next = S.next(ui + 1, nxt);
        const char* nA = GATHER ? cA : (has_next ? (const char*)g.A + (size_t)nxt.pm * tstepA : cA); const char* nB = has_next ? (const char*)g.Bt + (size_t)nxt.pb * tstepB : cB;
        if constexpr (GATHER) { if (has_next) PG8_GRAW(nxt.pm); }
        for (int t = 0; t < nt; t += 2) {
            const bool last = (t == nt - 2);
            const char* a1 = cA + (size_t)(t + 1) * kstep;
            const char* a2 = last ? nA : cA + (size_t)(t + 2) * kstep; const char* b2 = last ? nB : cB + (size_t)(t + 2) * kstep;
            unsigned off2[2][2];
            if constexpr (GATHER) { if (last && has_next) { PG8_GCONV(offN); } else if (last) { _Pragma("unroll") for (int h_ = 0; h_ < 2; ++h_) _Pragma("unroll") for (int i_ = 0; i_ < 2; ++i_) offN[h_][i_] = offC[h_][i_]; }
                _Pragma("unroll") for (int h_ = 0; h_ < 2; ++h_) _Pragma("unroll") for (int i_ = 0; i_ < 2; ++i_) off2[h_][i_] = last ? offN[h_][i_] : offC[h_][i_]; }
            const char* a3 = a2 + kstep; const char* b3 = b2 + kstep;
            PG8_LDB(B0, 0, 0); PG8_LDB(B1, 0, 1); PG8_SCHED; PG8_LDA(At, 0, 0); PG8_STAGE_A(PG8_SA(1, 1), a1, 1, offC);
            PG8_WAIT_V(8); PG8_WAIT_L(0); PG8_BAR; PG8_MMA(0, 0, At, B0); PG8_MMA(0, 1, At, B1); PG8_BAR; PG8_SCHED;
            PG8_LDA(At, 0, 1); PG8_STAGE(PG8_SB(0, 0), b2, voffB); PG8_STAGE(PG8_SB(0, 1), b2 + hstepB, voffB); PG8_STAGE_A(PG8_SA(0, 0), a2, 0, off2);
            PG8_WAIT_V(8); PG8_WAIT_L(0); PG8_BAR; PG8_MMA(1, 0, At, B0); PG8_MMA(1, 1, At, B1); PG8_BAR; PG8_SCHED;
            PG8_LDB(B0, 1, 0); PG8_LDB(B1, 1, 1); PG8_SCHED; PG8_LDA(At, 1, 0); PG8_STAGE_A(PG8_SA(0, 1), a2, 1, off2);
            PG8_WAIT_V(8); PG8_WAIT_L(0); PG8_BAR; PG8_MMA(0, 0, At, B0); PG8_MMA(0, 1, At, B1); PG8_BAR; PG8_SCHED;
            PG8_LDA(At, 1, 1); PG8_STAGE(PG8_SB(1, 0), b3, voffB); PG8_STAGE(PG8_SB(1, 1), b3 + hstepB, voffB); PG8_STAGE_A(PG8_SA(1, 0), a3, 0, off2);
            PG8_WAIT_V(8); PG8_WAIT_L(0); PG8_BAR; PG8_MMA(1, 0, At, B0); PG8_MMA(1, 1, At, B1); PG8_BAR; PG8_SCHED;
        }
        if (wr == 0) PG8_BAR;
        E(acc, cur, wr, wc, fr, fq);
        if (!has_next) break;
#pragma unroll
        for (int a = 0; a < 2; ++a)
#pragma unroll
            for (int b = 0; b < 2; ++b)
#pragma unroll
                for (int m = 0; m < 4; ++m)
#pragma unroll
                    for (int n = 0; n < 2; ++n) acc[a][b][m][n] = (f32x4){0.f, 0.f, 0.f, 0.f};
        cur = nxt; cA = nA; cB = nB; ++ui;
        if constexpr (GATHER) { _Pragma("unroll") for (int h_ = 0; h_ < 2; ++h_) _Pragma("unroll") for (int i_ = 0; i_ < 2; ++i_) offC[h_][i_] = offN[h_][i_]; }
        if (wr == 1) PG8_BAR;
    }
    PG8_WAIT_V(0);
    PG8_BAR;
#undef PG8_SA
#undef PG8_SB
#undef PG8_STAGE
#undef PG8_STAGE_A
#undef PG8_GRAW
#undef PG8_GCONV
#undef PG8_LDA
#undef PG8_LDB
#undef PG8_MMA
#undef PG8_WAIT_V
#undef PG8_WAIT_L
#undef PG8_BAR
#undef PG8_SCHED
}
}

namespace att {
#define SBAR() __builtin_amdgcn_sched_barrier(0)
constexpr float NEGBIG = -1e30f, THR = 8.f;
__device__ __forceinline__ int crow(int r, int hi) { return (r & 3) + 8 * (r >> 2) + 4 * hi; }
typedef __bf16 bf16x2_t __attribute__((ext_vector_type(2)));
__device__ __forceinline__ unsigned cvtpk(float lo, float hi) { f32x2 v = {lo, hi}; bf16x2_t b = __builtin_convertvector(v, bf16x2_t); return __builtin_bit_cast(unsigned, b); }

__device__ __forceinline__ void partialSM(f32x16& p0, f32x16& p1, float& m_reg, float& alpha) {
    float pmax = p0[0];
#pragma unroll
    for (int r = 1; r < 16; ++r) pmax = fmaxf(pmax, p0[r]);
#pragma unroll
    for (int r = 0; r < 16; ++r) pmax = fmaxf(pmax, p1[r]);
    { auto rr = __builtin_amdgcn_permlane32_swap(__float_as_uint(pmax), __float_as_uint(pmax), false, false);
      pmax = fmaxf(__uint_as_float(rr[0]), __uint_as_float(rr[1])); }
    float mn;
    if (__builtin_expect(__all(pmax - m_reg <= THR), 1)) { mn = m_reg; alpha = 1.f; }
    else { mn = fmaxf(m_reg, pmax); alpha = __builtin_amdgcn_exp2f(m_reg - mn); m_reg = mn; }
#pragma unroll
    for (int r = 0; r < 16; ++r) { p0[r] = p0[r] - mn; p1[r] = p1[r] - mn; }
#pragma unroll
    for (int r = 0; r < 16; ++r) p0[r] = __builtin_amdgcn_exp2f(p0[r]);
}
__device__ __forceinline__ void finishSM(f32x16& p0, f32x16& p1, float alpha, float& l_reg, bf16x8& pa0, bf16x8& pa1, bf16x8& pa2, bf16x8& pa3) {
#pragma unroll
    for (int r = 0; r < 16; ++r) p1[r] = __builtin_amdgcn_exp2f(p1[r]);
    float ps = 0;
#pragma unroll
    for (int r = 0; r < 16; ++r) ps += p0[r];
#pragma unroll
    for (int r = 0; r < 16; ++r) ps += p1[r];
    { auto rr = __builtin_amdgcn_permlane32_swap(__float_as_uint(ps), __float_as_uint(ps), false, false);
      ps = __uint_as_float(rr[0]) + __uint_as_float(rr[1]); }
    l_reg = l_reg * alpha + ps;
#define PK4(P, BASE, OUT) do { unsigned a0 = cvtpk(P[BASE + 0], P[BASE + 1]), a1 = cvtpk(P[BASE + 2], P[BASE + 3]);   \
    unsigned b0 = cvtpk(P[BASE + 4], P[BASE + 5]), b1 = cvtpk(P[BASE + 6], P[BASE + 7]);                              \
    auto r0 = __builtin_amdgcn_permlane32_swap(a0, b0, false, false); auto r1 = __builtin_amdgcn_permlane32_swap(a1, b1, false, false); \
    u32x4 w = {r0[0], r1[0], r0[1], r1[1]}; OUT = __builtin_bit_cast(bf16x8, w); } while (0)
    PK4(p0, 0, pa0); PK4(p0, 8, pa1); PK4(p1, 0, pa2); PK4(p1, 8, pa3);
#undef PK4
}
template <int NQC>
__device__ __forceinline__ void qkt(f32x16& p0, f32x16& p1, const char* Ks, const bf16x8* qr, int r32, int hi) {
    p0 = f32x16{}; p1 = f32x16{};
#pragma unroll
    for (int d0 = 0; d0 < NQC; ++d0) { const int c = 2 * d0 + hi; const int a = c * 1024 + ((r32 ^ (c & 7)) << 4);
        const bf16x8 b0 = *reinterpret_cast<const bf16x8*>(Ks + a);
        const bf16x8 b1 = *reinterpret_cast<const bf16x8*>(Ks + a + 512);
        p0 = __builtin_amdgcn_mfma_f32_32x32x16_bf16(b0, qr[d0], p0, 0, 0, 0);
        p1 = __builtin_amdgcn_mfma_f32_32x32x16_bf16(b1, qr[d0], p1, 0, 0, 0); }
}
template <int NDB> __device__ __forceinline__ int v_st(int k, int c) { const int kk = (k & ~0xC) | ((k & 4) << 1) | ((k & 8) >> 1); return ((kk >> 3) * NDB + (c >> 5)) * 512 + ((kk & 7) * 32 + (c & 31)) * 2; }
__device__ __forceinline__ int v_rd_base(int lane) { return ((lane & 3) << 3) | (((lane >> 2) & 3) << 6) | (((lane >> 4) & 1) << 5) | (((lane >> 5) & 1) << 8); }
template <int NDB> constexpr int v_rd_off(int d0, int ks, int half) { return d0 * 512 + ks * (NDB * 1024) + half * (NDB * 512); }
template <int OFF> __device__ __forceinline__ s16x4 tr_read(int vb) { s16x4 r; asm volatile("ds_read_b64_tr_b16 %0, %1 offset:%2" : "=&v"(r) : "v"(vb), "i"(OFF) : "memory"); return r; }
template <int D0, int NDB> __device__ __forceinline__ void pv_one(f32x16& od, int vb, bf16x8 pa0, bf16x8 pa1, bf16x8 pa2, bf16x8 pa3) {
    const s16x4 l0 = tr_read<v_rd_off<NDB>(D0, 0, 0)>(vb), h0 = tr_read<v_rd_off<NDB>(D0, 0, 1)>(vb), l1 = tr_read<v_rd_off<NDB>(D0, 1, 0)>(vb), h1 = tr_read<v_rd_off<NDB>(D0, 1, 1)>(vb);
    const s16x4 l2 = tr_read<v_rd_off<NDB>(D0, 2, 0)>(vb), h2 = tr_read<v_rd_off<NDB>(D0, 2, 1)>(vb), l3 = tr_read<v_rd_off<NDB>(D0, 3, 0)>(vb), h3 = tr_read<v_rd_off<NDB>(D0, 3, 1)>(vb);
    asm volatile("s_waitcnt lgkmcnt(0)" ::: "memory"); SBAR();
#define PK(L, H) (bf16x8){L[0], L[1], L[2], L[3], H[0], H[1], H[2], H[3]}
    od = __builtin_amdgcn_mfma_f32_32x32x16_bf16(pa0, PK(l0, h0), od, 0, 0, 0);
    od = __builtin_amdgcn_mfma_f32_32x32x16_bf16(pa1, PK(l1, h1), od, 0, 0, 0);
    od = __builtin_amdgcn_mfma_f32_32x32x16_bf16(pa2, PK(l2, h2), od, 0, 0, 0);
    od = __builtin_amdgcn_mfma_f32_32x32x16_bf16(pa3, PK(l3, h3), od, 0, 0, 0);
#undef PK
}
template <int NDB> __device__ __forceinline__ void pv_all(f32x16* o, int vb, bf16x8 pa0, bf16x8 pa1, bf16x8 pa2, bf16x8 pa3) {
    pv_one<0, NDB>(o[0], vb, pa0, pa1, pa2, pa3); pv_one<1, NDB>(o[1], vb, pa0, pa1, pa2, pa3);
    if constexpr (NDB == 4) { pv_one<2, NDB>(o[2], vb, pa0, pa1, pa2, pa3); pv_one<3, NDB>(o[3], vb, pa0, pa1, pa2, pa3); }
}
__device__ __forceinline__ void mask_meta(f32x16& p0, f32x16& p1) {
#pragma unroll
    for (int r = 8; r < 16; ++r) p0[r] = NEGBIG;
#pragma unroll
    for (int r = 0; r < 16; ++r) p1[r] = NEGBIG;
}
__device__ __forceinline__ void mask_all(f32x16& p0, f32x16& p1) {
#pragma unroll
    for (int r = 0; r < 16; ++r) { p0[r] = NEGBIG; p1[r] = NEGBIG; }
}

template <int DQK, int DV, class P>
__device__ __forceinline__ void attn_unit(const P& pol, char* lds) {
    constexpr int NQC = DQK / 16, NDB = DV / 32, KB = 64 * DQK * 2, VB = 64 * DV * 2;
    constexpr int KCH = DQK / 8, VCH = DV / 8, NKS = (64 * KCH) / 512, NVS = (64 * VCH) / 512;
    int tid_ = threadIdx.x; asm volatile("" : "+v"(tid_));
    const int tid = tid_, wid = tid >> 6, lane = tid & 63, r32 = lane & 31, hi = lane >> 5;
    char* V_lds = lds; char* K_lds = lds + 3 * VB;
    float* ws = (float*)(lds + 3 * VB + 3 * KB) + wid * 64; float* li_l = ws; float* al_l = ws + 32;
    float m_reg = NEGBIG, l_reg = 0.f; f32x16 o[NDB];
#pragma unroll
    for (int d = 0; d < NDB; ++d) o[d] = f32x16{};
    bf16x8 qr[NQC];
    { const bf16* Qw = pol.qptr(wid * 32 + r32) + hi * 8;
#pragma unroll
      for (int d0 = 0; d0 < NQC; ++d0) qr[d0] = *reinterpret_cast<const bf16x8*>(Qw + d0 * 16); }
    pol.qfix(qr, wid * 32 + r32, hi);
    const int vb0 = (int)(uintptr_t)V_lds + v_rd_base(lane);
    bf16x8 ks[NKS], vs[NVS];
    const int srow = tid >> 3, c0 = tid & 7;
    const unsigned koff = (unsigned)(srow * pol.kstride + c0 * 8) * 2u, voff = (unsigned)(srow * pol.vstride + c0 * 8) * 2u;
    const int kst = c0 * 1024 + ((srow ^ c0) << 4), vst = v_st<NDB>(srow, c0 * 8);
    static_assert(NKS == KCH / 8 && NVS == VCH / 8, "staging map");
#define SLOAD(t) do { const char* kb_ = (const char*)pol.kbase(t) + koff; const char* vb_ = (const char*)pol.vbase(t) + voff; \
    _Pragma("unroll") for (int i = 0; i < NKS; ++i) ks[i] = *reinterpret_cast<const bf16x8*>(kb_ + i * 128); \
    _Pragma("unroll") for (int i = 0; i < NVS; ++i) vs[i] = *reinterpret_cast<const bf16x8*>(vb_ + i * 128); } while (0)
#define SWRITE(b) do { \
    _Pragma("unroll") for (int i = 0; i < NKS; ++i) *reinterpret_cast<bf16x8*>(K_lds + (b) * KB + kst + i * 8192) = ks[i]; \
    _Pragma("unroll") for (int i = 0; i < NVS; ++i) *reinterpret_cast<bf16x8*>(V_lds + (b) * VB + vst + i * 1024) = vs[i]; } while (0)
#define RESC(a) do { if (__any((a) < 1.f)) { if (hi == 0) al_l[r32] = (a); asm volatile("s_waitcnt lgkmcnt(0)" ::: "memory"); \
    _Pragma("unroll") for (int d = 0; d < NDB; ++d) _Pragma("unroll") for (int r = 0; r < 16; ++r) o[d][r] *= al_l[crow(r, hi)]; } } while (0)
#define XFORM(pa_, pb_, t) do { if (pol.needs_xform(t)) pol.xform(pa_, pb_, (t), wid, r32, hi); } while (0)
    f32x16 pA0, pA1, pB0, pB1; float alA, alB; bf16x8 pa0, pa1, pa2, pa3; const int NT = pol.nt;
    if constexpr (DQK <= 128) {
        bf16x8 ks2[NKS], vs2[NVS];
        SLOAD(0);
        { const char* kb_ = (const char*)pol.kbase(1) + koff; const char* vb_ = (const char*)pol.vbase(1) + voff;
#pragma unroll
          for (int i = 0; i < NKS; ++i) ks2[i] = *reinterpret_cast<const bf16x8*>(kb_ + i * 128);
#pragma unroll
          for (int i = 0; i < NVS; ++i) vs2[i] = *reinterpret_cast<const bf16x8*>(vb_ + i * 128); }
        asm volatile("s_waitcnt vmcnt(0)" ::: "memory"); SWRITE(0);
#pragma unroll
        for (int i = 0; i < NKS; ++i) *reinterpret_cast<bf16x8*>(K_lds + KB + kst + i * 8192) = ks2[i];
#pragma unroll
        for (int i = 0; i < NVS; ++i) *reinterpret_cast<bf16x8*>(V_lds + VB + vst + i * 1024) = vs2[i];
        __syncthreads();
        qkt<NQC>(pA0, pA1, K_lds, qr, r32, hi); XFORM(pA0, pA1, 0); partialSM(pA0, pA1, m_reg, alA);
    } else {
    SLOAD(0); asm volatile("s_waitcnt vmcnt(0)" ::: "memory"); SWRITE(0); __syncthreads();
    qkt<NQC>(pA0, pA1, K_lds, qr, r32, hi); XFORM(pA0, pA1, 0); partialSM(pA0, pA1, m_reg, alA);
    SLOAD(1); asm volatile("s_waitcnt vmcnt(0)" ::: "memory"); SWRITE(1); __syncthreads();
    }
    int bprev = 0, bcur = 1, bnext = 2;
#define ROT3() do { bprev = bcur; bcur = bnext; bnext = (bnext == 2) ? 0 : bnext + 1; } while (0)
    for (int j = 1; j + 1 < NT; j += 2) {
        SBAR(); qkt<NQC>(pB0, pB1, K_lds + bcur * KB, qr, r32, hi);
        finishSM(pA0, pA1, alA, l_reg, pa0, pa1, pa2, pa3); SBAR();
        SLOAD(j + 1); SBAR();
        pv_all<NDB>(o, vb0 + bprev * VB, pa0, pa1, pa2, pa3); XFORM(pB0, pB1, j); partialSM(pB0, pB1, m_reg, alB);
        asm volatile("s_waitcnt vmcnt(0)" ::: "memory"); SWRITE(bnext);
        RESC(alB); __syncthreads(); ROT3();
        SBAR(); qkt<NQC>(pA0, pA1, K_lds + bcur * KB, qr, r32, hi);
        finishSM(pB0, pB1, alB, l_reg, pa0, pa1, pa2, pa3); SBAR();
        SLOAD(j + 2); SBAR();
        pv_all<NDB>(o, vb0 + bprev * VB, pa0, pa1, pa2, pa3); XFORM(pA0, pA1, j + 1); partialSM(pA0, pA1, m_reg, alA);
        asm volatile("s_waitcnt vmcnt(0)" ::: "memory"); SWRITE(bnext);
        RESC(alA); __syncthreads(); ROT3();
    }
    SBAR(); qkt<NQC>(pB0, pB1, K_lds + bcur * KB, qr, r32, hi);
    finishSM(pA0, pA1, alA, l_reg, pa0, pa1, pa2, pa3); SBAR();
    pv_all<NDB>(o, vb0 + bprev * VB, pa0, pa1, pa2, pa3); XFORM(pB0, pB1, NT - 1); partialSM(pB0, pB1, m_reg, alB);
    RESC(alB);
    finishSM(pB0, pB1, alB, l_reg, pa0, pa1, pa2, pa3); SBAR();
    pv_all<NDB>(o, vb0 + bcur * VB, pa0, pa1, pa2, pa3);
#undef ROT3
    l_reg += pol.sink_term(m_reg);
    if (pol.partial()) {
        if (wid == 0) {
            if (lane < 16) { float* pp = pol.pptr(lane); pp[128] = m_reg; pp[129] = l_reg; }
#pragma unroll
            for (int r = 0; r < 8; ++r) { float* pp = pol.pptr(crow(r, hi));
#pragma unroll
                for (int d0 = 0; d0 < NDB; ++d0) pp[d0 * 32 + r32] = o[d0][r]; }
        }
    } else {
    if (hi == 0) li_l[r32] = l_reg; asm volatile("s_waitcnt lgkmcnt(0)" ::: "memory");
    float rli[16];
#pragma unroll
    for (int r = 0; r < 16; ++r) rli[r] = __builtin_amdgcn_rcpf(li_l[crow(r, hi)]);
#pragma unroll
    for (int r = 0; r < 16; ++r) { const int orow = wid * 32 + crow(r, hi);
        if (pol.ovalid(orow)) { bf16* op = pol.optr(orow);
#pragma unroll
            for (int d0 = 0; d0 < NDB; ++d0) op[d0 * 32 + r32] = (bf16)f2bf(o[d0][r] * rli[r]); } }
    }
    __syncthreads();
#undef SLOAD
#undef SWRITE
#undef RESC
#undef XFORM
}

__device__ __forceinline__ int unit_row(int b, int qb, int r) { int row = qb < 64 ? b * SEQ + qb * 256 + r : RMETA + 16 * b + r; return row < NR ? row : NR - 1; }

struct PolMLA {
    const bf16 *Kc, *Vm, *Q; bf16* O; float* part; const float* rope_; int b, h, qb, nt, kstride, vstride, split;
    __device__ __forceinline__ void init(const bf16* Kc_, const bf16* Vm_, const bf16* Q_, bf16* O_, float* part_, const float* rope__, int b_, int h_, int qb_, int split_) {
        Kc = Kc_; Vm = Vm_; Q = Q_; O = O_; part = part_; rope_ = rope__; b = b_; h = h_; qb = qb_; split = split_; kstride = KCW; vstride = VMW;
        nt = split < 0 ? 258 : (split == 0 ? 34 : 32); }
    __device__ __forceinline__ int krow0(int t) const {
        if (split < 0) return (t == 0 || t == 257) ? RMETA + 16 * b : b * SEQ + (t - 1) * 64;
        if (split == 0) return (t == 0 || t == 33) ? RMETA + 16 * b : b * SEQ + (t - 1) * 64;
        return b * SEQ + (32 * split + t) * 64; }
    __device__ __forceinline__ const bf16* kbase(int t) const { return Kc + (size_t)krow0(t) * KCW + h * 192; }
    __device__ __forceinline__ const bf16* vbase(int t) const { return Vm + (size_t)krow0(t) * VMW + h * 128; }
    __device__ __forceinline__ const bf16* qptr(int r) const { return Q + (size_t)unit_row(b, qb, r) * QW + h * 192; }
    __device__ __forceinline__ bf16* optr(int r) const { return O + (size_t)unit_row(b, qb, r) * AOW + h * 128; }
    __device__ __forceinline__ bool ovalid(int r) const { return qb < 64 || r < 16; }
    __device__ __forceinline__ bool needs_xform(int t) const { return split < 0 ? (t == 0 || t == 257) : (split == 0 && (t == 0 || t == 33)); }
    __device__ __forceinline__ void xform(f32x16& p0, f32x16& p1, int t, int, int, int) const { if (t == 0) mask_meta(p0, p1); else mask_all(p0, p1); }
    __device__ __forceinline__ float sink_term(float) const { return 0.f; }
    __device__ __forceinline__ bool partial() const { return split >= 0; }
    __device__ __forceinline__ void qfix(bf16x8* qr, int r, int hi) const {
        const int row = unit_row(b, qb, r); const int pos = row < RMETA ? NMETA + (row & (SEQ - 1)) : ((row - RMETA) & 15);
        const float* rp = rope_ + 2 * (size_t)(pos * 32);
#pragma unroll
        for (int blk = 0; blk < 2; ++blk) { const f32x4* cs = (const f32x4*)(rp + 2 * (16 * blk + 8 * hi)); f32x4 t[4];
#pragma unroll
            for (int q = 0; q < 4; ++q) t[q] = cs[q];
            bf16x8 x1 = qr[8 + blk], x2 = qr[10 + blk];
#pragma unroll
            for (int e = 0; e < 8; ++e) { const float c = t[e >> 1][(e & 1) * 2], sn = t[e >> 1][(e & 1) * 2 + 1];
                const float a = bf2f((unsigned short)x1[e]), bb = bf2f((unsigned short)x2[e]);
                x1[e] = (short)f2bf(a * c - bb * sn); x2[e] = (short)f2bf(bb * c + a * sn); }
            qr[8 + blk] = x1; qr[10 + blk] = x2; } }
    __device__ __forceinline__ float* pptr(int r) const { return part + ((size_t)((b * 8 + h) * 8 + split) * 16 + r) * 132; }
};

struct PolNA {
    const bf16* Z; bf16* O; const float* tab; int b, h, qb, nt, kstride, vstride, glo, n;
    __device__ __forceinline__ void init(const bf16* Z_, bf16* O_, const float* tab_, int b_, int h_, int qb_) {
        Z = Z_; O = O_; tab = tab_; b = b_; h = h_; qb = qb_; kstride = ZW; vstride = ZW;
        if (qb < 64) { int lo = 4 * qb - 4; lo = lo < 0 ? 0 : (lo > 248 ? 248 : lo); int hi_ = 4 * qb + 3 - 4; hi_ = hi_ < 0 ? 0 : (hi_ > 248 ? 248 : hi_); hi_ += 7; glo = lo; n = hi_ - lo + 1; }
        else { glo = 0; n = 0; }
        nt = (n + 1 + 1) & ~1; }
    __device__ __forceinline__ int krow0(int t) const { return (t == 0 || t > n) ? RMETA + 16 * b : b * SEQ + (glo + t - 1) * 64; }
    __device__ __forceinline__ const bf16* kbase(int t) const { return Z + (size_t)krow0(t) * ZW + ZNAK + h * 128; }
    __device__ __forceinline__ const bf16* vbase(int t) const { return Z + (size_t)krow0(t) * ZW + ZNAV + h * 128; }
    __device__ __forceinline__ const bf16* qptr(int r) const { return Z + (size_t)unit_row(b, qb, r) * ZW + ZNAQ + h * 128; }
    __device__ __forceinline__ bf16* optr(int r) const { return O + (size_t)unit_row(b, qb, r) * AOW + 1024 + h * 128; }
    __device__ __forceinline__ bool ovalid(int r) const { return qb < 64 || r < 16; }
    __device__ __forceinline__ bool needs_xform(int) const { return true; }
    __device__ __forceinline__ void xform(f32x16& p0, f32x16& p1, int t, int wid, int r32, int hi) const {
        if (t == 0) { mask_meta(p0, p1); return; }
        if (t > n) { mask_all(p0, p1); return; }
        const int g = glo + t - 1, r = 4 * qb + (wid >> 1), c = 32 * (wid & 1) + r32;
        int rs = r - 4; rs = rs < 0 ? 0 : (rs > 248 ? 248 : rs);
        if (g < rs || g >= rs + 8) { mask_all(p0, p1); return; }
        int cs = c - 8; cs = cs < 0 ? 0 : (cs > 48 ? 48 : cs);
        const float* trow = tab + (g - r + 7) * 31 + 15 - c;
#pragma unroll
        for (int i = 0; i < 16; ++i) { const int kc = crow(i, hi); const bool ok = kc >= cs && kc < cs + 16; const int kcc = ok ? kc : c;
            const float bv = trow[kcc]; p0[i] = ok ? p0[i] + bv : NEGBIG; }
#pragma unroll
        for (int i = 0; i < 16; ++i) { const int kc = 32 + crow(i, hi); const bool ok = kc >= cs && kc < cs + 16; const int kcc = ok ? kc : c;
            const float bv = trow[kcc]; p1[i] = ok ? p1[i] + bv : NEGBIG; }
    }
    __device__ __forceinline__ float sink_term(float) const { return 0.f; }
    __device__ __forceinline__ bool partial() const { return false; }
    __device__ __forceinline__ float* pptr(int) const { return nullptr; }
    __device__ __forceinline__ void qfix(bf16x8*, int, int) const {}
};

struct PolSWA {
    const bf16* Z; bf16* O; int b, hq, qb, nt, kstride, vstride, klo, n; float slope_l2, sink_l2;
    __device__ __forceinline__ void init(const bf16* Z_, bf16* O_, const float* sinks, int b_, int hq_, int qb_) {
        Z = Z_; O = O_; b = b_; hq = hq_; qb = qb_; kstride = Z1W; vstride = Z1W;
        if (qb < 64) { klo = 4 * qb - 2; if (klo < 0) klo = 0; int khi = 4 * qb + 5; if (khi > 255) khi = 255; n = khi - klo + 1; }
        else { klo = 0; n = 2; }
        nt = (n + 1 + 1) & ~1;
        slope_l2 = __builtin_amdgcn_exp2f(-0.25f * (float)(hq + 1)) * LOG2E; sink_l2 = sinks[hq] * LOG2E; }
    __device__ __forceinline__ int krow0(int t) const { return (t == 0 || t > n) ? RMETA + 16 * b : b * SEQ + (klo + t - 1) * 64; }
    __device__ __forceinline__ const bf16* kbase(int t) const { return Z + (size_t)krow0(t) * Z1W + 2048 + (hq >> 3) * 64; }
    __device__ __forceinline__ const bf16* vbase(int t) const { return Z + (size_t)krow0(t) * Z1W + 2304 + (hq >> 3) * 64; }
    __device__ __forceinline__ const bf16* qptr(int r) const { return Z + (size_t)unit_row(b, qb, r) * Z1W + hq * 64; }
    __device__ __forceinline__ bf16* optr(int r) const { return O + (size_t)unit_row(b, qb, r) * AOW + hq * 64; }
    __device__ __forceinline__ bool ovalid(int r) const { return qb < 64 || r < 16; }
    __device__ __forceinline__ bool needs_xform(int) const { return true; }
    __device__ __forceinline__ void xform(f32x16& p0, f32x16& p1, int t, int wid, int r32, int hi) const {
        if (t == 0) { mask_meta(p0, p1); return; }
        if (t > n) { mask_all(p0, p1); return; }
        const int kt = klo + t - 1;
        if (qb < 64) {
            const int d0 = 64 * kt - (256 * qb + 32 * wid + r32);
#pragma unroll
            for (int i = 0; i < 16; ++i) { int d = d0 + crow(i, hi); d = max(d, -d); const int m = min(max(d - 128, 0), 1); p0[i] = (p0[i] - slope_l2 * (float)d) + NEGBIG * (float)m; }
#pragma unroll
            for (int i = 0; i < 16; ++i) { int d = d0 + 32 + crow(i, hi); d = max(d, -d); const int m = min(max(d - 128, 0), 1); p1[i] = (p1[i] - slope_l2 * (float)d) + NEGBIG * (float)m; }
        } else {
            const int qi = 32 * wid + r32, j0 = 64 * kt;
#pragma unroll
            for (int i = 0; i < 16; ++i) { const int j = j0 + crow(i, hi); const int m = min(max(16 + j - qi - 128, 0), 1); p0[i] = p0[i] + NEGBIG * (float)m; }
#pragma unroll
            for (int i = 0; i < 16; ++i) { const int j = j0 + 32 + crow(i, hi); const int m = min(max(16 + j - qi - 128, 0), 1); p1[i] = p1[i] + NEGBIG * (float)m; }
        }
    }
    __device__ __forceinline__ float sink_term(float m) const { return __builtin_amdgcn_exp2f(sink_l2 - m); }
    __device__ __forceinline__ bool partial() const { return false; }
    __device__ __forceinline__ float* pptr(int) const { return nullptr; }
    __device__ __forceinline__ void qfix(bf16x8*, int, int) const {}
};
struct PolSWAG {
    const bf16* Z; bf16* O; int b, kvh, pb, nt, kstride, vstride, klo, n; float slope_l2, sink_l2;
    __device__ __forceinline__ void init(const bf16* Z_, bf16* O_, const float* sinks, int b_, int kvh_, int pb_, int wv) {
        Z = Z_; O = O_; b = b_; kvh = kvh_; pb = pb_; kstride = Z1W; vstride = Z1W;
        klo = (pb - 4) >> 1; if (klo < 0) klo = 0; int khi = (pb + 4) >> 1; if (khi > 255) khi = 255; n = khi - klo + 1;
        nt = (n + 1 + 1) & ~1;
        const int hq = kvh * 8 + wv;
        slope_l2 = __builtin_amdgcn_exp2f(-0.25f * (float)(hq + 1)) * LOG2E; sink_l2 = sinks[hq] * LOG2E; }
    __device__ __forceinline__ int krow0(int t) const { return (t == 0 || t > n) ? RMETA + 16 * b : b * SEQ + (klo + t - 1) * 64; }
    __device__ __forceinline__ const bf16* kbase(int t) const { return Z + (size_t)krow0(t) * Z1W + 2048 + kvh * 64; }
    __device__ __forceinline__ const bf16* vbase(int t) const { return Z + (size_t)krow0(t) * Z1W + 2304 + kvh * 64; }
    __device__ __forceinline__ const bf16* qptr(int r) const { return Z + (size_t)(b * SEQ + 32 * pb + (r & 31)) * Z1W + (kvh * 8 + (r >> 5)) * 64; }
    __device__ __forceinline__ bf16* optr(int r) const { return O + (size_t)(b * SEQ + 32 * pb + (r & 31)) * AOW + (kvh * 8 + (r >> 5)) * 64; }
    __device__ __forceinline__ bool ovalid(int) const { return true; }
    __device__ __forceinline__ bool needs_xform(int) const { return true; }
    __device__ __forceinline__ void xform(f32x16& p0, f32x16& p1, int t, int, int r32, int hi) const {
        if (t == 0) { mask_meta(p0, p1); return; }
        if (t > n) { mask_all(p0, p1); return; }
        const int rel = 64 * (klo + t - 1) - 32 * pb;
        const int d0 = rel - r32;
        if (rel == -96 || rel == -64 || rel == 32 || rel == 64) {
            const float sg = rel < 0 ? slope_l2 : -slope_l2;
            const float sb0 = sg * (float)(d0 + 4 * hi), sb1 = sb0 + sg * 32.f;
#pragma unroll
            for (int i = 0; i < 16; ++i) p0[i] = __builtin_fmaf(sg, (float)((i & 3) + 8 * (i >> 2)), p0[i] + sb0);
#pragma unroll
            for (int i = 0; i < 16; ++i) p1[i] = __builtin_fmaf(sg, (float)((i & 3) + 8 * (i >> 2)), p1[i] + sb1);
            return;
        }
        if (rel == -32 || rel == 0) {
#pragma unroll
            for (int i = 0; i < 16; ++i) { int d = d0 + crow(i, hi); d = max(d, -d); p0[i] = p0[i] - slope_l2 * (float)d; }
#pragma unroll
            for (int i = 0; i < 16; ++i) { int d = d0 + 32 + crow(i, hi); d = max(d, -d); p1[i] = p1[i] - slope_l2 * (float)d; }
            return;
        }
#pragma unroll
        for (int i = 0; i < 16; ++i) { int d = d0 + crow(i, hi); d = max(d, -d); const int m = min(max(d - 128, 0), 1); p0[i] = (p0[i] - slope_l2 * (float)d) + NEGBIG * (float)m; }
#pragma unroll
        for (int i = 0; i < 16; ++i) { int d = d0 + 32 + crow(i, hi); d = max(d, -d); const int m = min(max(d - 128, 0), 1); p1[i] = (p1[i] - slope_l2 * (float)d) + NEGBIG * (float)m; }
    }
    __device__ __forceinline__ float sink_term(float m) const { return __builtin_amdgcn_exp2f(sink_l2 - m); }
    __device__ __forceinline__ bool partial() const { return false; }
    __device__ __forceinline__ float* pptr(int) const { return nullptr; }
    __device__ __forceinline__ void qfix(bf16x8*, int, int) const {}
};
#undef SBAR
}

struct Params {
    const float* x; const float* meta; const float* norm_mix; const float* norm_ffn; const float* norm_final;
    const float* ab_w_in; const float* ab_q_norm; const float* ab_kv_norm; const float* ab_w_uq; const float* ab_w_ukv; const float* ab_rpb; const float* ab_w_out;
    const float* c_w_in; const float* c_sinks; const float* c_w_out;
    const float* ec_w_router; const float* ec_w_gate; const float* ec_w_up; const float* ec_w_down;
    float* out; unsigned char* ws;
};

__device__ __forceinline__ void load_row(const float* row, int lane, f32x4 (&v)[8]) {
    const f32x4* r = (const f32x4*)row + lane;
#pragma unroll
    for (int j = 0; j < 8; ++j) v[j] = r[64 * j];
}
__device__ __forceinline__ void load_row_bf16(const bf16* row, int lane, f32x4 (&v)[8]) {
    const u32x2* r = (const u32x2*)row + lane;
#pragma unroll
    for (int j = 0; j < 8; ++j) { const u32x2 w = r[64 * j]; v[j] = (f32x4){bflo(w.x), bfhi(w.x), bflo(w.y), bfhi(w.y)}; }
}
__device__ __forceinline__ void store_row_bf16(bf16* row, int lane, const f32x4 (&v)[8]) {
    u32x2* o8 = (u32x2*)row + lane;
#pragma unroll
    for (int j = 0; j < 8; ++j) { u32x2 w; w.x = pk2(v[j].x, v[j].y); w.y = pk2(v[j].z, v[j].w); o8[64 * j] = w; }
}
__device__ __forceinline__ float row_rs(const f32x4 (&v)[8]) {
    float s = 0.f;
#pragma unroll
    for (int j = 0; j < 8; ++j) s += (v[j].x * v[j].x + v[j].y * v[j].y) + (v[j].z * v[j].z + v[j].w * v[j].w);
    return 1.0f / sqrtf(wave_sum(s) * (1.f / D) + EPS);
}
__device__ __forceinline__ void store_norm_bf16(bf16* urow, int lane, const f32x4 (&v)[8], float rs, const float* g) {
    const f32x4* gp = (const f32x4*)g + lane; u32x2* o8 = (u32x2*)urow + lane;
#pragma unroll
    for (int j = 0; j < 8; ++j) { const f32x4 gg = gp[64 * j]; u32x2 w; w.x = pk2(v[j].x * rs * gg.x, v[j].y * rs * gg.y); w.y = pk2(v[j].z * rs * gg.z, v[j].w * rs * gg.w); o8[64 * j] = w; }
}
__device__ __forceinline__ void store_zero_bf16(bf16* urow, int lane) {
    u32x2* o8 = (u32x2*)urow + lane;
#pragma unroll
    for (int j = 0; j < 8; ++j) o8[64 * j] = (u32x2){0u, 0u};
}

__device__ __forceinline__ void transpose_item(const float* src, int srcN, int k0, int n0, bf16* dst, int dstK, int dst_row0, const float* kscale, LAS float*, int lane) {
    const int kg = lane >> 4, ng = lane & 15;
    f32x4 v[2][8];
#pragma unroll
    for (int half = 0; half < 2; ++half) { const int kk0 = k0 + 32 * half + 8 * kg;
#pragma unroll
        for (int j = 0; j < 8; ++j) v[half][j] = *(const f32x4*)(src + (size_t)(kk0 + j) * srcN + n0 + 4 * ng); }
#pragma unroll
    for (int half = 0; half < 2; ++half) {
        const int kk0 = k0 + 32 * half + 8 * kg;
        if (kscale) {
#pragma unroll
            for (int j = 0; j < 8; ++j) v[half][j] = v[half][j] * kscale[kk0 + j]; }
#pragma unroll
        for (int q = 0; q < 4; ++q) { u32x4 o; o.x = pk2(v[half][0][q], v[half][1][q]); o.y = pk2(v[half][2][q], v[half][3][q]); o.z = pk2(v[half][4][q], v[half][5][q]); o.w = pk2(v[half][6][q], v[half][7][q]);
            *(u32x4*)(dst + (size_t)(dst_row0 + 4 * ng + q) * dstK + kk0) = o; }
    }
}
template <class Map>
__device__ __forceinline__ void transpose_matrix(const float* W, int K, int N, bf16* WT, const float* kscale, LAS float* scr, int gw, int ngw, int lane, const Map& map) {
    const int nkb = K / 64, nnb = N / 64, items = nkb * nnb;
    for (int it = gw; it < items; it += ngw) { const int kb = it / nnb, nb = it % nnb; transpose_item(W, N, kb * 64, nb * 64, WT, K, map(nb * 64), kscale, scr, lane); }
}
__device__ __forceinline__ void convert_experts(const float* wg, const float* wu, const float* wd, const float* gk, bf16* Wgu, bf16* Wd, LAS float* scr, int gw, int ngw, int lane, int lo, int hi) {
    constexpr int PER = 32 * 32;
    for (int it = lo + gw; it < hi; it += ngw) {
        const int e = it / (3 * PER), r = it % (3 * PER), which = r / PER, q = r % PER, kb = q / 32, nb = q % 32, n0 = nb * 64;
        const size_t eoff = (size_t)e * D * D;
        if (which == 0) transpose_item(wg + eoff, D, kb * 64, n0, Wgu + (size_t)e * 4096 * D, D, (n0 >> 7) * 256 + (n0 & 127), gk, scr, lane);
        else if (which == 1) transpose_item(wu + eoff, D, kb * 64, n0, Wgu + (size_t)e * 4096 * D, D, (n0 >> 7) * 256 + 128 + (n0 & 127), gk, scr, lane);
        else transpose_item(wd + eoff, D, kb * 64, n0, Wd + eoff, D, n0, nullptr, scr, lane);
    }
}

constexpr int CV_ITEMS = NE * 3 * 32 * 32, CV_TAIL_PER_CU = 80;
constexpr int CV_TOPK = 224 * 30;
constexpr int CV_CHUNK = 64;
constexpr int NG_IN0 = 31, NG_OUT = 26, NG_IN1 = 27;
constexpr int CV_IN0 = (32 - NG_IN0) * 8 * NWAVES * 88, CV_OUT = (32 - NG_OUT) * 8 * NWAVES * 48, CV_IN1 = (32 - NG_IN1) * 8 * NWAVES * 56;
constexpr int CV_MAIN0 = CV_ITEMS - CV_IN0 - CV_OUT - CV_TOPK;
#ifndef PHASES
#define PHASES 0xffffffffu
#endif
#define EN(k) (((PHASES) >> (k)) & 1u)
#define PH_IDS() int tid = threadIdx.x; asm volatile("" : "+v"(tid)); const int lane = tid & 63, wave = __builtin_amdgcn_readfirstlane(tid >> 6), gw = vcu * NWAVES + wave; (void)lane; (void)wave; (void)gw; WSL()
__global__ void __launch_bounds__(NTHREADS, 2) fwd_kernel(Params P) {
    extern __shared__ __attribute__((aligned(16))) unsigned char lds[];
    LAS unsigned char* ldsl = (LAS unsigned char*)lds;
    volatile LAS unsigned* MISC = (volatile LAS unsigned*)(ldsl + MISC_OFF);
    const int G = gridDim.x, bx = blockIdx.x;
    const int vcu = (G % 8 == 0) ? (bx % 8) * (G / 8) + bx / 8 : bx;
    const int NGW = G * NWAVES;
    unsigned* ctl = (unsigned*)(P.ws + WS_CTL);
    for (int u = threadIdx.x; u < 64; u += NTHREADS) MISC[u] = 0u;
    __syncthreads();
    XcdBarrier bar = xcd_barrier_post(ctl + CW_BAR, MISC + 8);
#define GRID_BAR() xcd_barrier(bar)

#define WSL() GAS unsigned char* wsg_ = (GAS unsigned char*)P.ws; asm volatile("" : "+s"(wsg_)); unsigned char* wsl = (unsigned char*)wsg_
#define rope ((float*)(wsl + WS_ROPE))
#define rsq ((float*)(wsl + WS_RSQ))
#define rskv ((float*)(wsl + WS_RSKV))
#define aff ((float*)(wsl + WS_AFF))
#define tokslot ((int*)(wsl + WS_TOKSLOT))
#define slottok ((int*)(wsl + WS_SLOTTOK))
#define xgate ((float*)(wsl + WS_XGATE))
#define xmap ((int*)(wsl + WS_XMAP))
#define rsf ((float*)(wsl + WS_RSF))
#define xrs ((float*)(wsl + WS_XRS))
#define rsm ((float*)(wsl + WS_RSM))
#define Win0 ((bf16*)(wsl + WS_WIN0))
#define Wuq ((bf16*)(wsl + WS_WUQ))
#define Wukv ((bf16*)(wsl + WS_WUKV))
#define Wout0 ((bf16*)(wsl + WS_WOUT0))
#define Win1 ((bf16*)(wsl + WS_WIN1))
#define Wout1 ((bf16*)(wsl + WS_WOUT1))
#define Wgu ((bf16*)(wsl + WS_WGU))
#define Wd ((bf16*)(wsl + WS_WD))
#define Hm ((bf16*)(wsl + WS_H))
#define U ((bf16*)(wsl + WS_U))
#define Z ((bf16*)(wsl + WS_Z))
#define Qb ((bf16*)(wsl + WS_Q))
#define Kc ((bf16*)(wsl + WS_KC))
#define Vm ((bf16*)(wsl + WS_VM))
#define AO ((bf16*)(wsl + WS_AO))
#define XS ((bf16*)(wsl + WS_XS))
#define HMID ((bf16*)(wsl + WS_HMID))

    if (EN(0)) {
        PH_IDS();
        LAS float* scr = (LAS float*)(ldsl + wave * 16640);
        transpose_matrix(P.ab_w_in, D, 4160, Win0, nullptr, scr, gw, NGW, lane, [](int n0) { return n0 < 1024 ? n0 : (n0 < 1088 ? 4096 + (n0 - 1024) : n0 - 64); });
        transpose_matrix(P.ab_w_uq, 512, 1536, Wuq, P.ab_q_norm, scr, gw, NGW, lane, [](int n0) { return n0; });
        transpose_matrix(P.ab_w_ukv, 512, 2048, Wukv, P.ab_kv_norm, scr, gw, NGW, lane, [](int n0) { return n0; });
        transpose_matrix(P.ab_w_out, D, D, Wout0, nullptr, scr, gw, NGW, lane, [](int n0) { return n0; });
        transpose_matrix(P.c_w_in, D, Z1W, Win1, P.norm_mix + D, scr, gw, NGW, lane, [](int n0) { return n0; });
        transpose_matrix(P.c_w_out, D, D, Wout1, nullptr, scr, gw, NGW, lane, [](int n0) { return n0; });
        if (G != 256) convert_experts(P.ec_w_gate, P.ec_w_up, P.ec_w_down, P.norm_ffn, Wgu, Wd, scr, gw, NGW, lane, 0, CV_ITEMS);
        for (int row = NTOK + gw * 64 + lane; row < NR; row += NGW * 64) rsm[row] = 0.f;
        for (int i = gw * 64 + lane; i < 192 * D / 8; i += NGW * 64) ((u32x4*)(Win0 + (size_t)4160 * D))[i] = (u32x4){0u, 0u, 0u, 0u};
        for (int row = gw; row < NR; row += NGW) {
            bf16* urow = U + (size_t)row * D;
            if (row < NTOK) {
                const float* src = row < RMETA ? P.x + (size_t)row * D : P.meta + (size_t)((row - RMETA) & 15) * D;
                f32x4 v[8]; load_row(src, lane, v);
                const float rs = row_rs(v); store_norm_bf16(urow, lane, v, rs, P.norm_mix);
            } else store_zero_bf16(urow, lane);
        }
        for (int i = gw * 64 + lane; i < LTOK * 32; i += NGW * 64) {
            const int pos = i >> 5, j = i & 31;
            double f = 1.0; { double r = 0.74989420933245582730;   for (int q = 0; q < j; ++q) f *= r; }
            const double rev = (double)pos * f * 0.15915494309189533577;
            const float fr = (float)(rev - __builtin_floor(rev));
            rope[2 * i] = __builtin_amdgcn_cosf(fr); rope[2 * i + 1] = __builtin_amdgcn_sinf(fr);
        }
    }
    GRID_BAR();

    for (int layer = 0; layer < 2; ++layer) {
        if (EN(1)) {
            WSL();
            const int nN = layer == 0 ? 17 : 10, ldz = layer == 0 ? ZW : Z1W;
            pg8::Gemm g{layer == 0 ? U : Hm, layer == 0 ? Win0 : Win1, D, D, D};
            const int ng = G == 256 ? (layer == 0 ? NG_IN0 : NG_IN1) : 0;
            pg8::EpiBf16S E{Z, ldz, layer == 0 ? nullptr : rsm, layer == 0 ? 4 : 0, 8, layer == 0 ? C_NA : C_SWA};
            if (ng == 0 || (bx >> 3) < ng) {
                pg8::TileOrder S; if (ng) S.init(NR / 256, nN, 8 * ng, bx, 0); else S.init(NR / 256, nN, G, bx, 0);
                pg8::gemm_phase(ldsl, g, S, E);
            } else {
                PH_IDS(); const int cnt = layer == 0 ? CV_IN0 : CV_IN1, base = CV_ITEMS - CV_OUT - cnt; const size_t lo = (size_t)layer * NE * D * D;
                convert_experts(P.ec_w_gate + lo, P.ec_w_up + lo, P.ec_w_down + lo, P.norm_ffn + (size_t)layer * D, Wgu, Wd, (LAS float*)ldsl, (bx - 8 * ng) * NWAVES + wave, (256 - 8 * ng) * NWAVES, lane, base, base + cnt);
            }
        }
        GRID_BAR();
        if (layer == 0) {
            if (EN(2)) { PH_IDS();
                const int sub = lane >> 4, l16 = lane & 15;
                for (int row4 = gw * 4; row4 < NR; row4 += NGW * 4) {
                    const int row = row4 + sub;
                    const bf16* zr = Z + (size_t)row * ZW;
                    u32x4 a[4], bq[4];
#pragma unroll
                    for (int i = 0; i < 4; ++i) { a[i] = *(const u32x4*)(zr + ZQL + 128 * i + 8 * l16); bq[i] = *(const u32x4*)(zr + ZKVL + 128 * i + 8 * l16); }
                    const int pos = row < RMETA ? NMETA + (row & (SEQ - 1)) : ((row - RMETA) & 15);
                    const unsigned x1w = *(const unsigned*)(zr + ZKR + 2 * l16), x2w = *(const unsigned*)(zr + ZKR + 32 + 2 * l16);
                    const f32x4 cs = *(const f32x4*)(rope + 2 * (pos * 32 + 2 * l16));
                    float s1 = 0.f, s2 = 0.f;
#pragma unroll
                    for (int i = 0; i < 4; ++i)
#pragma unroll
                        for (int q = 0; q < 4; ++q) { const float a0 = bflo(a[i][q]), a1 = bfhi(a[i][q]), b0 = bflo(bq[i][q]), b1 = bfhi(bq[i][q]); s1 += a0 * a0 + a1 * a1; s2 += b0 * b0 + b1 * b1; }
#pragma unroll
                    for (int o = 1; o < 16; o <<= 1) { s1 += __shfl_xor(s1, o); s2 += __shfl_xor(s2, o); }
                    if (l16 == 0) { rsq[row] = C_MLA / sqrtf(s1 * (1.f / 512) + EPS); rskv[row] = 1.0f / sqrtf(s2 * (1.f / 512) + EPS); }
                    const float z = row < NTOK ? 1.f : 0.f;
                    const float x1a = bflo(x1w) * z, x1b = bfhi(x1w) * z, x2a = bflo(x2w) * z, x2b = bfhi(x2w) * z;
                    const unsigned w1 = pk2(x1a * cs[0] - x2a * cs[1], x1b * cs[2] - x2b * cs[3]), w2 = pk2(x2a * cs[0] + x1a * cs[1], x2b * cs[2] + x1b * cs[3]);
                    bf16* kr = Kc + (size_t)row * KCW + 128 + 2 * l16;
#pragma unroll
                    for (int h = 0; h < 8; ++h) { *(unsigned*)(kr + h * 192) = w1; *(unsigned*)(kr + h * 192 + 32) = w2; }
                } }
            GRID_BAR();
            if (EN(3)) {
                WSL();
                pg8::Gemm g{Z + ZQL, Wuq, ZW, 512, 512};
                pg8::TileOrder S; S.init(NR / 256, 6, G, bx, 0);
                pg8::EpiBf16S E{Qb, QW, rsq, 0, 0, 1.f};
                pg8::gemm_phase(ldsl, g, S, E);
            }
            if (EN(4)) {
                WSL();
                pg8::Gemm g{Z + ZKVL, Wukv, ZW, 512, 512};
                pg8::TileOrder S; S.init(NR / 256, 8, G, G == 256 ? (bx + 248) & 255 : bx, 0);
                pg8::EpiKV E{Kc, Vm, rskv};
                pg8::gemm_phase(ldsl, g, S, E);
            }
            GRID_BAR();
            {
                WSL();
                constexpr int N_MLA = 1024 + 128, N_NA = 1040;
                float* tab = (float*)(lds + 3 * 16384 + 3 * 16384 + 2048);
                float* PART = (float*)(wsl + WS_PART);
                unsigned* ticket = (unsigned*)(wsl + WS_CTL) + CW_TICKET;
                for (int u0 = vcu; ; ) {
                    int u;
                    if (u0 < 1024) { u = u0; u0 += G; }
                    else {
                        if (threadIdx.x == 0) MISC[16] = 1024u + __hip_atomic_fetch_add(ticket, 1u, __ATOMIC_RELAXED, __HIP_MEMORY_SCOPE_AGENT);
                        __syncthreads();
                        u = (int)MISC[16];
                        if (u >= N_MLA + N_NA) {
                            const int c = u - (N_MLA + N_NA);
                            if (G != 256 || c >= (CV_MAIN0 + CV_CHUNK - 1) / CV_CHUNK) break;
                            const int ln = threadIdx.x & 63, wv = __builtin_amdgcn_readfirstlane((int)threadIdx.x >> 6), hi_ = (c + 1) * CV_CHUNK < CV_MAIN0 ? (c + 1) * CV_CHUNK : CV_MAIN0;
                            convert_experts(P.ec_w_gate, P.ec_w_up, P.ec_w_down, P.norm_ffn, Wgu, Wd, (LAS float*)ldsl, wv, NWAVES, ln, c * CV_CHUNK, hi_);
                            __syncthreads();
                            continue;
                        }
                    }
                    if (u < N_MLA) { if (EN(6)) {
                        int b, h, qb, sp; if (u < 1024) { const int bh = u >> 6; b = bh >> 3; h = bh & 7; qb = u & 63; sp = -1; } else { const int v = u - 1024; const int bh = v >> 3; b = bh >> 3; h = bh & 7; qb = 64; sp = v & 7; }
                        att::PolMLA pol; pol.init(Kc, Vm, Qb, AO, PART, rope, b, h, qb, sp);
                        att::attn_unit<192, 128>(pol, (char*)lds); }
                    } else if (EN(7)) {
                        const int v = u - N_MLA; int b, h, qb; if (v < 1024) { const int bh = v >> 6; b = bh >> 3; h = bh & 7; qb = v & 63; } else { const int bh = v - 1024; b = bh >> 3; h = bh & 7; qb = 64; }
                        for (int i = threadIdx.x; i < 15 * 31; i += NTHREADS) tab[i] = P.ab_rpb[h * 465 + i] * LOG2E;
                        __syncthreads();
                        att::PolNA pol; pol.init(Z, AO, tab, b, h, qb);
                        att::attn_unit<128, 128>(pol, (char*)lds);
                    }
                }
            }
            GRID_BAR();
            {
                PH_IDS();
                const float* PART = (const float*)(wsl + WS_PART);
                for (int it = gw; it < 2 * 8 * 16; it += NGW) {
                    const int row = it & 15, bh = it >> 4, b = bh >> 3, h = bh & 7;
                    const float* pp = PART + ((size_t)(bh * 8) * 16 + row) * 132;
                    float M = -3e38f;
#pragma unroll
                    for (int sp = 0; sp < 8; ++sp) M = fmaxf(M, pp[(size_t)sp * 16 * 132 + 128]);
                    float L = 0.f, o0 = 0.f, o1 = 0.f;
#pragma unroll
                    for (int sp = 0; sp < 8; ++sp) { const float* q = pp + (size_t)sp * 16 * 132; const float w = __builtin_amdgcn_exp2f(q[128] - M); L += w * q[129]; o0 += w * q[lane]; o1 += w * q[64 + lane]; }
                    const float rl = 1.0f / L; bf16* op = AO + (size_t)(RMETA + 16 * b + row) * AOW + h * 128;
                    op[lane] = (bf16)f2bf(o0 * rl); op[64 + lane] = (bf16)f2bf(o1 * rl);
                }
            }
        } else {
            WSL();
            if (EN(8)) {
                const int wv = __builtin_amdgcn_readfirstlane((int)threadIdx.x >> 6);
                for (int u = vcu; u < 4096; u += G) {
                    att::PolSWAG pol; pol.init(Z, AO, P.c_sinks, u >> 11, (u >> 9) & 3, u & 511, wv);
                    att::attn_unit<64, 64>(pol, (char*)lds);
                }
                for (int u = vcu; u < 64; u += G) {
                    att::PolSWA pol; pol.init(Z, AO, P.c_sinks, u >> 5, u & 31, 64);
                    att::attn_unit<64, 64>(pol, (char*)lds);
                }
            }
        }
        GRID_BAR();
        if (EN(9)) {
            WSL();
            pg8::Gemm g{AO, layer == 0 ? Wout0 : Wout1, AOW, D, D};
            const int ng = G == 256 ? NG_OUT : 0;
            pg8::EpiResid E{Hm, D, layer == 0 ? P.x : nullptr, P.meta};
            if (ng == 0 || (bx >> 3) < ng) {
                pg8::TileOrder S; if (ng) S.init(NR / 256, 8, 8 * ng, bx, 0); else S.init(NR / 256, 8, G, bx, 0);
                pg8::gemm_phase(ldsl, g, S, E);
            } else {
                PH_IDS(); const size_t lo = (size_t)layer * NE * D * D;
                convert_experts(P.ec_w_gate + lo, P.ec_w_up + lo, P.ec_w_down + lo, P.norm_ffn + (size_t)layer * D, Wgu, Wd, (LAS float*)ldsl, (bx - 8 * ng) * NWAVES + wave, (256 - 8 * ng) * NWAVES, lane, CV_ITEMS - CV_OUT, CV_ITEMS);
            }
        }
        GRID_BAR();
        if (EN(10)) {
            PH_IDS();
            LAS float* wb = (LAS float*)ldsl;
            LAS float* red = (LAS float*)(ldsl + 131072);
            const float* wsrc = P.ec_w_router + (size_t)layer * D * NE; const float* gf = P.norm_ffn + (size_t)layer * D;
            for (int i = tid; i < D * 4; i += NTHREADS) { const int k = i >> 2, eg = i & 3; const f32x4 w4 = *(const f32x4*)(wsrc + (size_t)k * NE + 4 * eg) * gf[k];
                const int base = ((k >> 2) * 16 + 4 * eg) * 4 + (k & 3);
                wb[base] = w4.x; wb[base + 4] = w4.y; wb[base + 8] = w4.z; wb[base + 12] = w4.w; }
            __syncthreads();
            const int r = lane & 15, kq = lane >> 4;
            u32x4 hv[8];
            { const bf16* hp = Hm + (size_t)(vcu * 16 + r) * D + 256 * wave + 8 * kq;
#pragma unroll
              for (int i = 0; i < 8; ++i) hv[i] = *(const u32x4*)(hp + 32 * i); }
            for (int blk = vcu; blk < NTOK / 16; blk += G) {
                const int row0 = blk * 16;
                f32x4 acc = {0.f, 0.f, 0.f, 0.f}; float ss = 0.f;
#pragma unroll
                for (int i = 0; i < 8; ++i) {
                    const LAS f32x4* bp = (const LAS f32x4*)wb + (((wave * 8 + i) * 4 + kq) * 2) * 16 + r;
                    const f32x4 b0 = bp[0], b1 = bp[16];
                    const float a0 = bflo(hv[i].x), a1 = bfhi(hv[i].x), a2 = bflo(hv[i].y), a3 = bfhi(hv[i].y), a4 = bflo(hv[i].z), a5 = bfhi(hv[i].z), a6 = bflo(hv[i].w), a7 = bfhi(hv[i].w);
                    acc = __builtin_amdgcn_mfma_f32_16x16x4f32(a0, b0.x, acc, 0, 0, 0); acc = __builtin_amdgcn_mfma_f32_16x16x4f32(a1, b0.y, acc, 0, 0, 0);
                    acc = __builtin_amdgcn_mfma_f32_16x16x4f32(a2, b0.z, acc, 0, 0, 0); acc = __builtin_amdgcn_mfma_f32_16x16x4f32(a3, b0.w, acc, 0, 0, 0);
                    acc = __builtin_amdgcn_mfma_f32_16x16x4f32(a4, b1.x, acc, 0, 0, 0); acc = __builtin_amdgcn_mfma_f32_16x16x4f32(a5, b1.y, acc, 0, 0, 0);
                    acc = __builtin_amdgcn_mfma_f32_16x16x4f32(a6, b1.z, acc, 0, 0, 0); acc = __builtin_amdgcn_mfma_f32_16x16x4f32(a7, b1.w, acc, 0, 0, 0);
                    ss += (a0 * a0 + a1 * a1) + (a2 * a2 + a3 * a3) + (a4 * a4 + a5 * a5) + (a6 * a6 + a7 * a7);
                }
                if (blk + G < NTOK / 16) {
                    const bf16* hp = Hm + (size_t)((blk + G) * 16 + r) * D + 256 * wave + 8 * kq;
#pragma unroll
                    for (int i = 0; i < 8; ++i) hv[i] = *(const u32x4*)(hp + 32 * i); }
                ss += __shfl_xor(ss, 16); ss += __shfl_xor(ss, 32);
                LAS float* rw = red + wave * 272;
                *(LAS f32x4*)(rw + 4 * lane) = acc;
                if (lane < 16) rw[256 + lane] = ss;
                __syncthreads();
                if (wave == 0) {
                    f32x4 lg = {0.f, 0.f, 0.f, 0.f}; float sq[4] = {0.f, 0.f, 0.f, 0.f};
#pragma unroll
                    for (int w = 0; w < 8; ++w) { lg = lg + *(const LAS f32x4*)(red + w * 272 + 4 * lane);
#pragma unroll
                        for (int j = 0; j < 4; ++j) sq[j] += red[w * 272 + 256 + 4 * kq + j]; }
#pragma unroll
                    for (int j = 0; j < 4; ++j) {
                        const int row = row0 + 4 * kq + j; const float rs = 1.0f / sqrtf(sq[j] * (1.f / D) + EPS);
                        const float x = lg[j] * rs;
                        float mx = x; mx = fmaxf(mx, __shfl_xor(mx, 1)); mx = fmaxf(mx, __shfl_xor(mx, 2)); mx = fmaxf(mx, __shfl_xor(mx, 4)); mx = fmaxf(mx, __shfl_xor(mx, 8));
                        const float p = __expf(x - mx); float sum = p;
                        sum += __shfl_xor(sum, 1); sum += __shfl_xor(sum, 2); sum += __shfl_xor(sum, 4); sum += __shfl_xor(sum, 8);
                        const int b = row < RMETA ? (row >> 14) : ((row - RMETA) >> 4); const int tok = row < RMETA ? NMETA + (row & (SEQ - 1)) : ((row - RMETA) & 15);
                        aff[(size_t)(b * NE + r) * LTOK + tok] = p / sum;
                        if (r == 0) rsf[row] = rs;
                    }
                }
                __syncthreads();
            }
        }
        GRID_BAR();
        if (EN(11) && vcu < 32) {
            PH_IDS();
            const int be = vcu, b = be >> 4, e = be & 15;
            LAS unsigned* keys = (LAS unsigned*)ldsl;
            LAS unsigned* hist = (LAS unsigned*)(ldsl + 66560);
            LAS unsigned* sh = (LAS unsigned*)(ldsl + 66560 + 1024);
            const float* av = aff + (size_t)be * LTOK;
            for (int i = tid; i < LTOK; i += NTHREADS) keys[i] = __float_as_uint(av[i]);
            __syncthreads();
            const int i0 = tid * 33, i1 = (i0 + 33 < LTOK) ? i0 + 33 : LTOK;
            unsigned kv[33];
#pragma unroll
            for (int q = 0; q < 33; ++q) kv[q] = (i0 + q < LTOK) ? keys[i0 + q] : 0u;
            unsigned T = 0u;
            for (int bit = 30; bit >= 0; --bit) {
                const unsigned cand = T | (1u << bit); unsigned c = 0u;
#pragma unroll
                for (int q = 0; q < 33; ++q) c += 1u - ((kv[q] - cand) >> 31);
#pragma unroll
                for (int o = 1; o < 64; o <<= 1) c += __shfl_xor(c, o);
                LAS unsigned* slot = sh + 32 + (bit & 1) * 8;
                if (lane == 0) slot[wave] = c;
                __syncthreads();
                unsigned tot = 0u;
#pragma unroll
                for (int w = 0; w < 8; ++w) tot += slot[w];
                T |= (1u - ((tot - (unsigned)CAP) >> 31)) << bit;
            }
            unsigned cgt = 0u, ceq = 0u;
#pragma unroll
            for (int q = 0; q < 33; ++q) { const unsigned k = kv[q]; cgt += k > T ? 1u : 0u; ceq += (k == T && i0 + q < LTOK) ? 1u : 0u; }
            unsigned pk = cgt | (ceq << 16), incl = pk;
#pragma unroll
            for (int o = 1; o < 64; o <<= 1) { const unsigned t = __shfl_up(incl, o); if (lane >= o) incl += t; }
            if (lane == 63) sh[16 + wave] = incl;
            __syncthreads();
            unsigned wbase = 0u, totgt = 0u;
            for (int w = 0; w < 8; ++w) { const unsigned x = sh[16 + w]; totgt += x & 0xffffu; if (w < wave) wbase += x; }
            const unsigned krem = (unsigned)CAP - totgt;
            const unsigned excl = wbase + incl - pk;
            unsigned ngt = excl & 0xffffu, neq = excl >> 16;
            int* tsl = tokslot + (size_t)be * LTOK; int* stk = slottok + (size_t)be * CAP; float* xg = xgate + (size_t)e * XPE + b * CAP; int* xm = xmap + (size_t)e * XPE + b * CAP; float* xr = xrs + (size_t)e * XPE + b * CAP;
            for (int i = i0; i < i1; ++i) { const unsigned k = keys[i]; bool sel = k > T; if (k == T) { sel = neq < krem; }
                int slot = -1;
                if (sel) { slot = (int)(ngt + (neq < krem ? neq : krem)); if (slot < CAP) { const int trow = i < NMETA ? RMETA + 16 * b + i : b * SEQ + (i - NMETA); stk[slot] = trow; xm[slot] = trow; xg[slot] = __uint_as_float(k); xr[slot] = rsf[trow]; } else slot = -1; }
                if (k > T) ++ngt; if (k == T) ++neq;
                tsl[i] = slot; }
            if (b == 1) for (int i = tid; i < XPE - 2 * CAP; i += NTHREADS) { xgate[(size_t)e * XPE + 2 * CAP + i] = 0.f; xmap[(size_t)e * XPE + 2 * CAP + i] = NR - 1; xrs[(size_t)e * XPE + 2 * CAP + i] = 0.f; }
        }
        else if (EN(11) && G == 256) {
            PH_IDS(); const int cin = layer == 0 ? CV_IN0 : CV_IN1, hi_ = CV_ITEMS - CV_OUT - cin; const size_t lo = (size_t)layer * NE * D * D;
            convert_experts(P.ec_w_gate + lo, P.ec_w_up + lo, P.ec_w_down + lo, P.norm_ffn + (size_t)layer * D, Wgu, Wd, (LAS float*)ldsl, (vcu - 32) * NWAVES + wave, 224 * NWAVES, lane, hi_ - CV_TOPK, hi_);
        }
        GRID_BAR();
        if (EN(13)) {
            WSL();
            pg8::Gemm g{Hm, Wgu, D, D, D, xmap};
            pg8::TileOrder S; S.init(XROWS / 256, 16, G, bx, 17);
            pg8::EpiSwiGLU E{HMID, D, xrs};
            pg8::gemm_phase<true>(ldsl, g, S, E);
        }
        GRID_BAR();
        if (EN(14)) {
            WSL();
            pg8::Gemm g{HMID, Wd, D, D, D};
            pg8::TileOrder S; S.init(XROWS / 256, 8, G, bx, 17);
            pg8::EpiBf16S E{XS, D, xgate, 0, 0, 1.f};
            pg8::gemm_phase(ldsl, g, S, E);
        }
        GRID_BAR();
        if (EN(15)) {
            PH_IDS();
            const float* gn = layer == 0 ? P.norm_mix + D : P.norm_final;
            for (int row = gw; row < (layer == 0 ? NTOK : RMETA); row += NGW) {
                const int b = row < RMETA ? (row >> 14) : ((row - RMETA) >> 4); const int tok = row < RMETA ? NMETA + (row & (SEQ - 1)) : ((row - RMETA) & 15);
                f32x4 v[8]; bf16* hrow = Hm + (size_t)row * D; load_row_bf16(hrow, lane, v);
                int sl[NE];
#pragma unroll
                for (int e = 0; e < NE; ++e) sl[e] = tokslot[(size_t)(b * NE + e) * LTOK + tok];
                int cnt = 0, o0 = 0, o1 = 0, o2 = 0, o3 = 0;
#pragma unroll
                for (int e = 0; e < NE; ++e) {
                    const int s = __builtin_amdgcn_readfirstlane(sl[e]); const int ok = s >= 0 ? 1 : 0, xr_ = e * XPE + b * CAP + s;
                    o0 = (ok && cnt == 0) ? xr_ : o0; o1 = (ok && cnt == 1) ? xr_ : o1; o2 = (ok && cnt == 2) ? xr_ : o2; o3 = (ok && cnt == 3) ? xr_ : o3; cnt += ok;
                }
                { const float w0 = cnt > 0 ? 1.f : 0.f, w1 = cnt > 1 ? 1.f : 0.f, w2 = cnt > 2 ? 1.f : 0.f, w3 = cnt > 3 ? 1.f : 0.f;
                  o1 = cnt > 1 ? o1 : o0; o2 = cnt > 2 ? o2 : o0; o3 = cnt > 3 ? o3 : o0;
                  const u32x2* p0 = (const u32x2*)(XS + (size_t)o0 * D) + lane; const u32x2* p1 = (const u32x2*)(XS + (size_t)o1 * D) + lane;
                  const u32x2* p2 = (const u32x2*)(XS + (size_t)o2 * D) + lane; const u32x2* p3 = (const u32x2*)(XS + (size_t)o3 * D) + lane;
                  u32x2 y0[8], y1[8], y2[8], y3[8];
#pragma unroll
                  for (int j = 0; j < 8; ++j) { y0[j] = p0[64 * j]; y1[j] = p1[64 * j]; y2[j] = p2[64 * j]; y3[j] = p3[64 * j]; }
#pragma unroll
                  for (int j = 0; j < 8; ++j) {
                      v[j].x += (w0 * bflo(y0[j].x) + w1 * bflo(y1[j].x)) + (w2 * bflo(y2[j].x) + w3 * bflo(y3[j].x)); v[j].y += (w0 * bfhi(y0[j].x) + w1 * bfhi(y1[j].x)) + (w2 * bfhi(y2[j].x) + w3 * bfhi(y3[j].x));
                      v[j].z += (w0 * bflo(y0[j].y) + w1 * bflo(y1[j].y)) + (w2 * bflo(y2[j].y) + w3 * bflo(y3[j].y)); v[j].w += (w0 * bfhi(y0[j].y) + w1 * bfhi(y1[j].y)) + (w2 * bfhi(y2[j].y) + w3 * bfhi(y3[j].y)); } }
                if (cnt > 4) {
                    int seen = 0;
#pragma unroll
                    for (int e = 0; e < NE; ++e) {
                        const int s = __builtin_amdgcn_readfirstlane(sl[e]);
                        if (s >= 0) { if (seen >= 4) { const u32x2* yp = (const u32x2*)(XS + (size_t)(e * XPE + b * CAP + s) * D) + lane;
#pragma unroll
                            for (int j = 0; j < 8; ++j) { const u32x2 w = yp[64 * j]; v[j].x += bflo(w.x); v[j].y += bfhi(w.x); v[j].z += bflo(w.y); v[j].w += bfhi(w.y); } }
                          ++seen; }
                    }
                }
                const float rs = row_rs(v);
                if (layer == 0) {
                    store_row_bf16(hrow, lane, v);
                    if (lane == 0) rsm[row] = rs;
                } else {
                    const f32x4* gp = (const f32x4*)gn + lane; f32x4* op = (f32x4*)(P.out + (size_t)row * D) + lane;
#pragma unroll
                    for (int j = 0; j < 8; ++j) op[64 * j] = v[j] * rs * gp[64 * j];
                }
            }
            if (layer == 0) {
                LAS float* scr = (LAS float*)(ldsl + wave * 16640);
                const size_t lo = (size_t)NE * D * D;
                convert_experts(P.ec_w_gate + lo, P.ec_w_up + lo, P.ec_w_down + lo, P.norm_ffn + D, Wgu, Wd, scr, gw, NGW, lane, 0, G == 256 ? CV_ITEMS - CV_IN1 - CV_OUT - CV_TOPK : CV_ITEMS);
            }
        }
        if (layer == 0) GRID_BAR();
    }
#undef GRID_BAR
}

extern "C" void kernel_launch(void* const* d_in, const int* in_sizes, int n_in, void* d_out, int out_size, void* d_ws, size_t ws_size, hipStream_t stream) {
    static int grid = 0;
    if (grid == 0) {
        if (n_in != 19 || ws_size < WS_END) { fprintf(stderr, "kernel_launch: unexpected n_in %d / ws %zu (need %zu)\n", n_in, ws_size, (size_t)WS_END); grid = -1; return; }
        int dev = 0, cus = 0, per_cu = 0;
        if (hipGetDevice(&dev) != hipSuccess || hipDeviceGetAttribute(&cus, hipDeviceAttributeMultiprocessorCount, dev) != hipSuccess) { grid = -1; return; }
        if (hipFuncSetAttribute((const void*)fwd_kernel, hipFuncAttributeMaxDynamicSharedMemorySize, LDS_BYTES) != hipSuccess) { fprintf(stderr, "kernel_launch: hipFuncSetAttribute failed\n"); grid = -1; return; }
        if (hipOccupancyMaxActiveBlocksPerMultiprocessor(&per_cu, (const void*)fwd_kernel, NTHREADS, LDS_BYTES) != hipSuccess || per_cu < 1) { fprintf(stderr, "kernel_launch: occupancy query reports %d\n", per_cu); }
        (void)hipGetLastError();
        grid = cus;
    }
    if (grid < 0) return;
    if (hipMemsetAsync((char*)d_ws + WS_CTL, 0, CTL_BYTES, stream) != hipSuccess) return;
    Params p{};
    p.x = (const float*)d_in[0]; p.meta = (const float*)d_in[1]; p.norm_mix = (const float*)d_in[2]; p.norm_ffn = (const float*)d_in[3]; p.norm_final = (const float*)d_in[4];
    p.ab_w_in = (const float*)d_in[5]; p.ab_q_norm = (const float*)d_in[6]; p.ab_kv_norm = (const float*)d_in[7]; p.ab_w_uq = (const float*)d_in[8]; p.ab_w_ukv = (const float*)d_in[9];
    p.ab_rpb = (const float*)d_in[10]; p.ab_w_out = (const float*)d_in[11]; p.c_w_in = (const float*)d_in[12]; p.c_sinks = (const float*)d_in[13]; p.c_w_out = (const float*)d_in[14];
    p.ec_w_router = (const float*)d_in[15]; p.ec_w_gate = (const float*)d_in[16]; p.ec_w_up = (const float*)d_in[17]; p.ec_w_down = (const float*)d_in[18];
    p.out = (float*)d_out; p.ws = (unsigned char*)d_ws;
    hipLaunchKernelGGL(fwd_kernel, dim3(grid), dim3(NTHREADS), LDS_BYTES, stream, p);
    const hipError_t le = hipPeekAtLastError();
    if (le != hipSuccess) fprintf(stderr, "kernel_launch: launch failed: %s\n", hipGetErrorName(le));
}
```

```cpp
#include <hip/hip_runtime.h>
#include <cstdio>
#include <cstdint>

#define GAS __attribute__((address_space(1)))
#define LAS __attribute__((address_space(3)))
typedef unsigned short bf16;
typedef short bf16x8 __attribute__((ext_vector_type(8)));
typedef short s16x4 __attribute__((ext_vector_type(4)));
typedef float f32x2 __attribute__((ext_vector_type(2)));
typedef float f32x4 __attribute__((ext_vector_type(4)));
typedef float f32x16 __attribute__((ext_vector_type(16)));
typedef unsigned u32x2 __attribute__((ext_vector_type(2)));
typedef unsigned u32x4 __attribute__((ext_vector_type(4)));

constexpr int D = 2048, NBATCH = 2, SEQ = 16384, NMETA = 16, LTOK = 16400, NTOK = 32800, NR = 33024, RMETA = 32768;
constexpr int ZW = 4352, ZQL = 0, ZKVL = 512, ZNAQ = 1024, ZNAK = 2048, ZNAV = 3072, ZKR = 4096;
constexpr int QW = 1536, KCW = 1536, VMW = 1024, Z1W = 2560, AOW = 2048;
constexpr int NE = 16, CAP = 2050, XPE = 4352, XROWS = NE * XPE;
constexpr float EPS = 1e-6f, LOG2E = 1.4426950408889634f;
constexpr float C_MLA = 0.07216878364870322f * LOG2E, C_NA = 0.08838834764831845f * LOG2E, C_SWA = 0.125f * LOG2E;
constexpr int NWAVES = 8, NTHREADS = 512;

constexpr size_t al256(size_t x) { return (x + 255) & ~(size_t)255; }
constexpr size_t WS_CTL = 0, CTL_BYTES = 1u << 20;
constexpr size_t WS_ROPE = WS_CTL + CTL_BYTES;
constexpr size_t WS_RSQ = al256(WS_ROPE + (size_t)LTOK * 32 * 2 * 4);
constexpr size_t WS_RSKV = al256(WS_RSQ + (size_t)NR * 4);
constexpr size_t WS_AFF = al256(WS_RSKV + (size_t)NR * 4);
constexpr size_t WS_TOKSLOT = al256(WS_AFF + (size_t)32 * LTOK * 4);
constexpr size_t WS_SLOTTOK = al256(WS_TOKSLOT + (size_t)32 * LTOK * 4);
constexpr size_t WS_XGATE = al256(WS_SLOTTOK + (size_t)32 * CAP * 4);
constexpr size_t WS_XMAP = al256(WS_XGATE + (size_t)XROWS * 4);
constexpr size_t WS_PART = al256(WS_XMAP + (size_t)XROWS * 4);
constexpr size_t WS_WIN0 = al256(WS_PART + (size_t)2 * 8 * 8 * 16 * 132 * 4);
constexpr size_t WS_WUQ = al256(WS_WIN0 + (size_t)ZW * D * 2);
constexpr size_t WS_WUKV = al256(WS_WUQ + (size_t)1536 * 512 * 2);
constexpr size_t WS_WOUT0 = al256(WS_WUKV + (size_t)2048 * 512 * 2);
constexpr size_t WS_WIN1 = al256(WS_WOUT0 + (size_t)D * D * 2);
constexpr size_t WS_WOUT1 = al256(WS_WIN1 + (size_t)Z1W * D * 2);
constexpr size_t WS_WGU = al256(WS_WOUT1 + (size_t)D * D * 2);
constexpr size_t WS_WD = al256(WS_WGU + (size_t)NE * 4096 * D * 2);
constexpr size_t WS_H = al256(WS_WD + (size_t)NE * D * D * 2);
constexpr size_t WS_RSF = al256(WS_H + (size_t)NR * D * 2);
constexpr size_t WS_XRS = al256(WS_RSF + (size_t)NR * 4);
constexpr size_t WS_RSM = al256(WS_XRS + (size_t)XROWS * 4);
static_assert(WS_RSM + (size_t)NR * 4 <= WS_H + (size_t)NR * D * 4, "h region");
constexpr size_t WS_U = al256(WS_H + (size_t)NR * D * 4);
constexpr size_t WS_R = al256(WS_U + (size_t)NR * D * 2);
constexpr size_t WS_Z = WS_R;
constexpr size_t WS_Q = al256(WS_Z + (size_t)NR * ZW * 2);
constexpr size_t WS_KC = al256(WS_Q + (size_t)NR * QW * 2);
constexpr size_t WS_VM = al256(WS_KC + (size_t)NR * KCW * 2);
constexpr size_t WS_AO = al256(WS_VM + (size_t)NR * VMW * 2);
constexpr size_t WS_END_ATT = al256(WS_AO + (size_t)NR * AOW * 2);
constexpr size_t WS_XS = WS_R;
constexpr size_t WS_HMID = al256(WS_XS + (size_t)XROWS * D * 2);
constexpr size_t WS_END_MOE = al256(WS_HMID + (size_t)XROWS * D * 2);
constexpr size_t WS_END = WS_END_ATT > WS_END_MOE ? WS_END_ATT : WS_END_MOE;
static_assert(WS_END < (size_t)2000 * 1024 * 1024, "workspace map must fit 2 GiB with margin");

constexpr int CW_BAR = 4096, CW_TICKET = 65536;

constexpr int LDS_BYTES = 147456;
constexpr int MISC_OFF = 147456 - 256;

__device__ __forceinline__ unsigned f2bf(float f) { unsigned u = __builtin_bit_cast(unsigned, f); return (u + 0x7fffu + ((u >> 16) & 1u)) >> 16; }
__device__ __forceinline__ unsigned pk2(float lo, float hi) { return f2bf(lo) | (f2bf(hi) << 16); }
__device__ __forceinline__ float bf2f(unsigned short x) { return __builtin_bit_cast(float, (unsigned)x << 16); }
__device__ __forceinline__ float bflo(unsigned w) { return __builtin_bit_cast(float, w << 16); }
__device__ __forceinline__ float bfhi(unsigned w) { return __builtin_bit_cast(float, w & 0xffff0000u); }
__device__ __forceinline__ float wave_sum(float v) {
#pragma unroll
    for (int o = 1; o < 64; o <<= 1) v += __shfl_xor(v, o);
    return v;
}
#define LDS_WAIT() asm volatile("s_waitcnt lgkmcnt(0)" ::: "memory")

#define XB_TMO      128
#define XB_XCNT(j)  (256  + 64 * (j))
#define XB_XSUB(j)  (1280 + 64 * (j))
#define XB_XGEN(j)  (2304 + 64 * (j))
#define XB_TOP      3328
#define XB_TOPGEN   3392
#define XCD_BAR_WORDS 3456
#define XB_SPIN_CAP (1u << 22)

__device__ __forceinline__ unsigned xb_ld(unsigned* p)              { return __hip_atomic_load(p, __ATOMIC_RELAXED, __HIP_MEMORY_SCOPE_AGENT); }
__device__ __forceinline__ unsigned xb_add(unsigned* p, unsigned v) { return __hip_atomic_fetch_add(p, v, __ATOMIC_RELAXED, __HIP_MEMORY_SCOPE_AGENT); }
__device__ __forceinline__ unsigned xb_xcc_id() { return (unsigned)__builtin_amdgcn_readfirstlane((int)((unsigned)__builtin_amdgcn_s_getreg((3 << 11) | 20) & 0xFu)); }
#define XB_SPIN(cond, bar) do { unsigned _sp = 0; while (cond) { __builtin_amdgcn_s_sleep(1); \
    if ((++_sp & 255u) == 0u) { if (xb_ld(&(bar)[XB_TMO])) break; if (_sp > XB_SPIN_CAP) { atomicAdd(&(bar)[XB_TMO], 1u); break; } } } } while (0)

struct XcdBarrier { unsigned* bar; unsigned x; volatile LAS unsigned* st; };

__device__ __forceinline__ XcdBarrier xcd_barrier_post(unsigned* bar, volatile LAS unsigned* st) {
    XcdBarrier b; b.bar = bar; b.x = xb_xcc_id(); b.st = st;
    if (threadIdx.x == 0) (void)xb_add(&bar[XB_XCNT(b.x)], 1u);
    return b;
}
__device__ __forceinline__ void xcd_barrier_complete(unsigned* bar, unsigned x, unsigned& nloc, unsigned& nx) {
    const unsigned G = gridDim.x * gridDim.y * gridDim.z;
    unsigned sum, cnt, mine, sp = 0u;
    for (;;) {
        sum = 0u; cnt = 0u; mine = 0u;
#pragma unroll
        for (unsigned j = 0; j < 16; ++j) { const unsigned c = xb_ld(&bar[XB_XCNT(j)]); sum += c; cnt += (c > 0u) ? 1u : 0u; mine = (j == x) ? c : mine; }
        if (sum == G) break;
        __builtin_amdgcn_s_sleep(1);
        if ((++sp & 255u) == 0u) { if (xb_ld(&bar[XB_TMO])) break; if (sp > XB_SPIN_CAP) { atomicAdd(&bar[XB_TMO], 1u); break; } }
    }
    nloc = mine > 0u ? mine : 1u; nx = cnt > 0u ? cnt : 1u;
}
__device__ __forceinline__ void xcd_barrier(const XcdBarrier& b) {
    asm volatile("s_waitcnt vmcnt(0)" ::: "memory");
    __syncthreads();
    if (threadIdx.x == 0) {
        unsigned* bar = b.bar; asm volatile("" : "+s"(bar));
        __builtin_amdgcn_s_waitcnt(0);
        const unsigned bx_ = xb_xcc_id();
        unsigned nloc = b.st[0], nx = b.st[1];
        if (nloc == 0u) { xcd_barrier_complete(bar, bx_, nloc, nx); b.st[0] = nloc; b.st[1] = nx; }
        const unsigned old = xb_add(&bar[XB_XSUB(bx_)], 1u);
        const unsigned gen = old / nloc;
        if (old + 1u == (gen + 1u) * nloc) {
            __builtin_amdgcn_fence(__ATOMIC_RELEASE, "agent");
            asm volatile("s_waitcnt vmcnt(0)" ::: "memory");
            const unsigned og = xb_add(&bar[XB_TOP], 1u);
            const unsigned tg = og / nx;
            if (og + 1u == (tg + 1u) * nx) xb_add(&bar[XB_TOPGEN], 1u);
            else XB_SPIN(xb_ld(&bar[XB_TOPGEN]) == tg, bar);
            __builtin_amdgcn_fence(__ATOMIC_ACQUIRE, "agent");
            xb_add(&bar[XB_XGEN(bx_)], 1u);
            asm volatile("s_waitcnt vmcnt(0)" ::: "memory");
        } else {
            XB_SPIN(xb_ld(&bar[XB_XGEN(bx_)]) == gen, bar);
            __builtin_amdgcn_fence(__ATOMIC_ACQUIRE, "agent");
            asm volatile("s_waitcnt vmcnt(0)" ::: "memory");
        }
    }
    __syncthreads();
}

namespace pg8 {
constexpr int BM = 256, BK = 64, HALF = 128, HTB = HALF * BK * 2, STAGE_BYTES = 8 * HTB, NXCD = 8, WGM = 8;
__host__ __device__ __forceinline__ int lds_byte(int r, int c) { const int st = (r >> 4) * 2 + (c >> 5), rr = r & 15, cc = c & 31, ob = rr * 64 + cc * 2; return st * 1024 + (ob ^ (((ob >> 9) & 1) << 5)); }
__host__ __device__ __forceinline__ void stage_rc(int b, int& R, int& C) { const int st = b / 1024, sb = b % 1024, swz = sb ^ (((sb >> 9) & 1) << 5); R = (st >> 1) * 16 + swz / 64; C = (st & 1) * 32 + (swz % 64) / 2; }
__host__ __device__ __forceinline__ int perm32(int rho) { const int n = rho >> 4, i = rho & 15; return 8 * (i >> 2) + 4 * n + (i & 3); }

struct Unit { int pm, pn, pb; };
struct Gemm { const bf16* A; const bf16* Bt; int lda, ldb, K; const int* amap; };

struct TileOrder {
    int nM, nN, nwg, G, c, grp;
    __device__ void init(int nM_, int nN_, int G_, int c_, int grp_) { nM = nM_; nN = nN_; nwg = nM * nN; G = G_; c = c_; grp = grp_; }
    __device__ bool next(int i, Unit& u) const {
        const long L = (long)i * G + c; if (L >= nwg) return false;
        int wgid = (int)L; { const int q = nwg / NXCD, r = nwg % NXCD, xcd = wgid % NXCD, off = wgid / NXCD; wgid = (xcd < r ? xcd * (q + 1) : r * (q + 1) + (xcd - r) * q) + off; }
        const int nig = WGM * nN, gid = wgid / nig, fm = gid * WGM, gsz = (nM - fm) < WGM ? (nM - fm) : WGM;
        u.pm = fm + ((wgid % nig) % gsz); u.pn = (wgid % nig) / gsz; u.pb = grp ? (u.pm / grp) * nN + u.pn : u.pn; return true;
    }
};

__device__ __forceinline__ unsigned cvt_pk_bf16(float lo, float hi) { unsigned r; asm volatile("v_cvt_pk_bf16_f32 %0, %1, %2" : "=v"(r) : "v"(lo), "v"(hi)); return r; }

struct EpiBf16S {
    static constexpr bool PERM = true;
    bf16* O; int ldc; const float* rowscale; int cs_lo, cs_hi; float cscale;
    __device__ __forceinline__ void operator()(const f32x4 (&acc)[2][2][4][2], const Unit& u, int wr, int wc, int fr, int fq) const {
        const int row0 = u.pm * BM + wr * 64 + fr, col0 = u.pn * BM + wc * 32 + 8 * fq;
        const float cs = (u.pn >= cs_lo && u.pn < cs_hi) ? cscale : 1.f;
#pragma unroll
        for (int ai = 0; ai < 2; ++ai)
#pragma unroll
            for (int m = 0; m < 4; ++m) { const int row = row0 + ai * HALF + m * 16; const float s = (rowscale ? rowscale[row] : 1.f) * cs; bf16* rowp = O + (size_t)row * ldc + col0;
#pragma unroll
                for (int bj = 0; bj < 2; ++bj) { const f32x4 v0 = acc[ai][bj][m][0] * s, v1 = acc[ai][bj][m][1] * s;
                    u32x4 w; w.x = cvt_pk_bf16(v0[0], v0[1]); w.y = cvt_pk_bf16(v0[2], v0[3]); w.z = cvt_pk_bf16(v1[0], v1[1]); w.w = cvt_pk_bf16(v1[2], v1[3]);
                    *(u32x4*)(rowp + bj * HALF) = w; } }
    }
};
struct EpiKV {
    static constexpr bool PERM = true;
    bf16* Kc; bf16* Vm; const float* rowscale;
    __device__ __forceinline__ void operator()(const f32x4 (&acc)[2][2][4][2], const Unit& u, int wr, int wc, int fr, int fq) const {
        const int row0 = u.pm * BM + wr * 64 + fr, cc = wc * 32 + 8 * fq;
#pragma unroll
        for (int ai = 0; ai < 2; ++ai)
#pragma unroll
            for (int m = 0; m < 4; ++m) { const int row = row0 + ai * HALF + m * 16; const float s = rowscale[row];
#pragma unroll
                for (int bj = 0; bj < 2; ++bj) { const f32x4 v0 = acc[ai][bj][m][0] * s, v1 = acc[ai][bj][m][1] * s;
                    u32x4 w; w.x = cvt_pk_bf16(v0[0], v0[1]); w.y = cvt_pk_bf16(v0[2], v0[3]); w.z = cvt_pk_bf16(v1[0], v1[1]); w.w = cvt_pk_bf16(v1[2], v1[3]);
                    bf16* p = bj == 0 ? Kc + (size_t)row * KCW + u.pn * 192 + cc : Vm + (size_t)row * VMW + u.pn * 128 + cc;
                    *(u32x4*)p = w; } }
    }
};
struct EpiResid {
    static constexpr bool PERM = true;
    bf16* Hm; int ldc; const float* X; const float* Mt;
    __device__ __forceinline__ void operator()(const f32x4 (&acc)[2][2][4][2], const Unit& u, int wr, int wc, int fr, int fq) const {
        const int row0 = u.pm * BM + wr * 64 + fr, col0 = u.pn * BM + wc * 32 + 8 * fq;
#pragma unroll
        for (int ai = 0; ai < 2; ++ai)
#pragma unroll
            for (int m = 0; m < 4; ++m) { const int row = row0 + ai * HALF + m * 16; bf16* rowp = Hm + (size_t)row * ldc + col0;
                if (X) {
                    const float* sp = (row < RMETA ? X + (size_t)row * ldc : Mt + (size_t)((row - RMETA) & 15) * ldc) + col0; const float z = row < NTOK ? 1.f : 0.f;
#pragma unroll
                    for (int bj = 0; bj < 2; ++bj) { const f32x4 v0 = *(const f32x4*)(sp + bj * HALF) * z + acc[ai][bj][m][0], v1 = *(const f32x4*)(sp + bj * HALF + 4) * z + acc[ai][bj][m][1];
                        u32x4 w; w.x = cvt_pk_bf16(v0[0], v0[1]); w.y = cvt_pk_bf16(v0[2], v0[3]); w.z = cvt_pk_bf16(v1[0], v1[1]); w.w = cvt_pk_bf16(v1[2], v1[3]);
                        *(u32x4*)(rowp + bj * HALF) = w; }
                } else {
#pragma unroll
                    for (int bj = 0; bj < 2; ++bj) { const u32x4 s = *(const u32x4*)(rowp + bj * HALF);
                        const f32x4 v0 = (f32x4){bflo(s.x), bfhi(s.x), bflo(s.y), bfhi(s.y)} + acc[ai][bj][m][0], v1 = (f32x4){bflo(s.z), bfhi(s.z), bflo(s.w), bfhi(s.w)} + acc[ai][bj][m][1];
                        u32x4 w; w.x = cvt_pk_bf16(v0[0], v0[1]); w.y = cvt_pk_bf16(v0[2], v0[3]); w.z = cvt_pk_bf16(v1[0], v1[1]); w.w = cvt_pk_bf16(v1[2], v1[3]);
                        *(u32x4*)(rowp + bj * HALF) = w; }
                }
            }
    }
};
struct EpiSwiGLU {
    static constexpr bool PERM = true;
    bf16* O; int ldc; const float* rowscale;
    __device__ __forceinline__ void operator()(const f32x4 (&acc)[2][2][4][2], const Unit& u, int wr, int wc, int fr, int fq) const {
        const int row0 = u.pm * BM + wr * 64 + fr, col0 = u.pn * HALF + wc * 32 + 8 * fq;
#pragma unroll
        for (int ai = 0; ai < 2; ++ai)
#pragma unroll
            for (int m = 0; m < 4; ++m) { const int row = row0 + ai * HALF + m * 16; bf16* rowp = O + (size_t)row * ldc + col0; float r[8]; const float rs = rowscale[row];
#pragma unroll
                for (int n = 0; n < 2; ++n)
#pragma unroll
                    for (int j = 0; j < 4; ++j) { const float g = acc[ai][0][m][n][j] * rs, up = acc[ai][1][m][n][j] * rs;
                        const float sg = g * __builtin_amdgcn_rcpf(1.f + __builtin_amdgcn_exp2f(-g * LOG2E)); r[n * 4 + j] = sg * up; }
                u32x4 w; w.x = cvt_pk_bf16(r[0], r[1]); w.y = cvt_pk_bf16(r[2], r[3]); w.z = cvt_pk_bf16(r[4], r[5]); w.w = cvt_pk_bf16(r[6], r[7]);
                *(u32x4*)rowp = w; }
    }
};

template <bool GATHER = false, class Epi, class Sched>
__device__ __forceinline__ void gemm_phase(LAS unsigned char* lds, const Gemm g, const Sched& S, const Epi& E) {
    int tid_ = threadIdx.x; asm volatile("" : "+v"(tid_));
    const int tid = tid_, wid = __builtin_amdgcn_readfirstlane(tid >> 6), lane = tid & 63, wr = wid >> 2, wc = wid & 3, fr = lane & 15, fq = lane >> 4;
    const int K = g.K, nt = K / BK;
    unsigned voffA[2], voffB[2];
#pragma unroll
    for (int i = 0; i < 2; ++i) { int R, C; stage_rc(tid * 16 + i * 8192, R, C); const int Rb = Epi::PERM ? ((R & ~31) + perm32(R & 31)) : R;
        voffA[i] = (unsigned)(R * g.lda + C) * 2u; voffB[i] = (unsigned)(Rb * g.ldb + C) * 2u; }
    int RA[2], CA[2];
#pragma unroll
    for (int i = 0; i < 2; ++i) stage_rc(tid * 16 + i * 8192, RA[i], CA[i]);
    unsigned offC[2][2], offN[2][2]; int rawN[2][2];
#define PG8_GRAW(pm_) do { _Pragma("unroll") for (int h_ = 0; h_ < 2; ++h_) _Pragma("unroll") for (int i_ = 0; i_ < 2; ++i_) rawN[h_][i_] = g.amap[(pm_) * BM + h_ * HALF + RA[i_]]; } while (0)
#define PG8_GCONV(dst) do { _Pragma("unroll") for (int h_ = 0; h_ < 2; ++h_) _Pragma("unroll") for (int i_ = 0; i_ < 2; ++i_) dst[h_][i_] = (unsigned)(rawN[h_][i_] * g.lda + CA[i_]) * 2u; } while (0)
    const size_t kstep = (size_t)(BK * 2);
    const size_t hstepA = (size_t)HALF * g.lda * 2, hstepB = (size_t)HALF * g.ldb * 2;
    const size_t tstepA = 2 * hstepA, tstepB = 2 * hstepB;
    const unsigned ldsw = (unsigned)wid * 1024u;
    const int aoff = lds_byte(wr * 64 + fr, fq * 8), boff = lds_byte(wc * 32 + fr, fq * 8);
#define PG8_SA(b, h) (((b) * 2 + (h)) * HTB)
#define PG8_SB(b, h) ((4 + (b) * 2 + (h)) * HTB)
#define PG8_STAGE(bufoff, gbase, voff) do { _Pragma("unroll") for (int _i = 0; _i < 2; ++_i) \
        __builtin_amdgcn_global_load_lds((const unsigned*)((const char*)(gbase) + (voff)[_i]), (LAS unsigned*)(lds + (bufoff) + ldsw + _i * 8192), 16, 0, 0); } while (0)
#define PG8_LDA(dst, b, h) do { _Pragma("unroll") for (int m = 0; m < 4; ++m) _Pragma("unroll") for (int k = 0; k < 2; ++k) dst[m][k] = *(const LAS bf16x8*)(lds + PG8_SA(b, h) + aoff + m * 2048 + k * 1024); } while (0)
#define PG8_LDB(dst, b, h) do { _Pragma("unroll") for (int n = 0; n < 2; ++n) _Pragma("unroll") for (int k = 0; k < 2; ++k) dst[n][k] = *(const LAS bf16x8*)(lds + PG8_SB(b, h) + boff + n * 2048 + k * 1024); } while (0)
#define PG8_MMA(ai, bj, At, Bt) do { __builtin_amdgcn_s_setprio(1); _Pragma("unroll") for (int m = 0; m < 4; ++m) _Pragma("unroll") for (int n = 0; n < 2; ++n) _Pragma("unroll") for (int k = 0; k < 2; ++k) \
        acc[ai][bj][m][n] = __builtin_amdgcn_mfma_f32_16x16x32_bf16(Bt[n][k], At[m][k], acc[ai][bj][m][n], 0, 0, 0); __builtin_amdgcn_s_setprio(0); } while (0)
#define PG8_WAIT_V(n) asm volatile("s_waitcnt vmcnt(" #n ")" ::: "memory")
#define PG8_WAIT_L(n) asm volatile("s_waitcnt lgkmcnt(" #n ")" ::: "memory")
#define PG8_BAR __builtin_amdgcn_s_barrier()
#define PG8_SCHED __builtin_amdgcn_sched_barrier(0)
    Unit cur, nxt; int ui = 0;
    if (!S.next(0, cur)) return;
    f32x4 acc[2][2][4][2];
#pragma unroll
    for (int a = 0; a < 2; ++a)
#pragma unroll
        for (int b = 0; b < 2; ++b)
#pragma unroll
            for (int m = 0; m < 4; ++m)
#pragma unroll
                for (int n = 0; n < 2; ++n) acc[a][b][m][n] = (f32x4){0.f, 0.f, 0.f, 0.f};
    bf16x8 At[4][2], B0[2][2], B1[2][2];
    const char* cA = GATHER ? (const char*)g.A : (const char*)g.A + (size_t)cur.pm * tstepA; const char* cB = (const char*)g.Bt + (size_t)cur.pb * tstepB;
    if constexpr (GATHER) { PG8_GRAW(cur.pm); PG8_GCONV(offC); }
#define PG8_STAGE_A(bufoff, kbase, h_, offs) do { if constexpr (GATHER) { PG8_STAGE(bufoff, kbase, offs[h_]); } else { PG8_STAGE(bufoff, (kbase) + (h_) * hstepA, voffA); } } while (0)
    PG8_STAGE(PG8_SB(0, 0), cB, voffB); PG8_STAGE(PG8_SB(0, 1), cB + hstepB, voffB); PG8_STAGE_A(PG8_SA(0, 0), cA, 0, offC); PG8_STAGE_A(PG8_SA(0, 1), cA, 1, offC);
    if (wr == 1) PG8_BAR;
    PG8_WAIT_V(2); PG8_BAR;
    PG8_STAGE(PG8_SB(1, 0), cB + kstep, voffB); PG8_STAGE_A(PG8_SA(1, 0), cA + kstep, 0, offC); PG8_STAGE(PG8_SB(1, 1), cB + hstepB + kstep, voffB);
    PG8_WAIT_V(6); PG8_BAR;
    for (;;) {
        const bool has_next = S.next(ui + 1, nxt);
        const char* nA = GATHER ? cA : (has_next ? (const char*)g.A + (size_t)nxt.pm * tstepA : cA); const char* nB = has_next ? (const char*)g.Bt + (size_t)nxt.pb * tstepB : cB;
        if constexpr (GATHER) { if (has_next) PG8_GRAW(nxt.pm); }
        for (int t = 0; t < nt; t += 2) {
            const bool last = (t == nt - 2);
            const char* a1 = cA + (size_t)(t + 1) * kstep;
            const char* a2 = last ? nA : cA + (size_t)(t + 2) * kstep; const char* b2 = last ? nB : cB + (size_t)(t + 2) * kstep;
            unsigned off2[2][2];
            if constexpr (GATHER) { if (last && has_next) { PG8_GCONV(offN); } else if (last) { _Pragma("unroll") for (int h_ = 0; h_ < 2; ++h_) _Pragma("unroll") for (int i_ = 0; i_ < 2; ++i_) offN[h_][i_] = offC[h_][i_]; }
                _Pragma("unroll") for (int h_ = 0; h_ < 2; ++h_) _Pragma("unroll") for (int i_ = 0; i_ < 2; ++i_) off2[h_][i_] = last ? offN[h_][i_] : offC[h_][i_]; }
            const char* a3 = a2 + kstep; const char* b3 = b2 + kstep;
            PG8_LDB(B0, 0, 0); PG8_LDB(B1, 0, 1); PG8_SCHED; PG8_LDA(At, 0, 0); PG8_STAGE_A(PG8_SA(1, 1), a1, 1, offC);
            PG8_WAIT_V(8); PG8_WAIT_L(0); PG8_BAR; PG8_MMA(0, 0, At, B0); PG8_MMA(0, 1, At, B1); PG8_BAR; PG8_SCHED;
            PG8_LDA(At, 0, 1); PG8_STAGE(PG8_SB(0, 0), b2, voffB); PG8_STAGE(PG8_SB(0, 1), b2 + hstepB, voffB); PG8_STAGE_A(PG8_SA(0, 0), a2, 0, off2);
            PG8_WAIT_V(8); PG8_WAIT_L(0); PG8_BAR; PG8_MMA(1, 0, At, B0); PG8_MMA(1, 1, At, B1); PG8_BAR; PG8_SCHED;
            PG8_LDB(B0, 1, 0); PG8_LDB(B1, 1, 1); PG8_SCHED; PG8_LDA(At, 1, 0); PG8_STAGE_A(PG8_SA(0, 1), a2, 1, off2);
            PG8_WAIT_V(8); PG8_WAIT_L(0); PG8_BAR; PG8_MMA(0, 0, At, B0); PG8_MMA(0, 1, At, B1); PG8_BAR; PG8_SCHED;
            PG8_LDA(At, 1, 1); PG8_STAGE(PG8_SB(1, 0), b3, voffB); PG8_STAGE(PG8_SB(1, 1), b3 + hstepB, voffB); PG8_STAGE_A(PG8_SA(1, 0), a3, 0, off2);
            PG8_WAIT_V(8); PG8_WAIT_L(0); PG8_BAR; PG8_MMA(1, 0, At, B0); PG8_MMA(1, 1, At, B1); PG8_BAR; PG8_SCHED;
        }
        if (wr == 0) PG8_BAR;
        E(acc, cur, wr, wc, fr, fq);
        if (!has_next) break;
#pragma unroll
        for (int a = 0; a < 2; ++a)
#pragma unroll
            for (int b = 0; b < 2; ++b)
#pragma unroll
                for (int m = 0; m < 4; ++m)
#pragma unroll
                    for (int n = 0; n < 2; ++n) acc[a][b][m][n] = (f32x4){0.f, 0.f, 0.f, 0.f};
        cur = nxt; cA = nA; cB = nB; ++ui;
        if constexpr (GATHER) { _Pragma("unroll") for (int h_ = 0; h_ < 2; ++h_) _Pragma("unroll") for (int i_ = 0; i_ < 2; ++i_) offC[h_][i_] = offN[h_][i_]; }
        if (wr == 1) PG8_BAR;
    }
    PG8_WAIT_V(0);
    PG8_BAR;
#undef PG8_SA
#undef PG8_SB
#undef PG8_STAGE
#undef PG8_STAGE_A
#undef PG8_GRAW
#undef PG8_GCONV
#undef PG8_LDA
#undef PG8_LDB
#undef PG8_MMA
#undef PG8_WAIT_V
#undef PG8_WAIT_L
#undef PG8_BAR
#undef PG8_SCHED
}
}

namespace att {
#define SBAR() __builtin_amdgcn_sched_barrier(0)
constexpr float NEGBIG = -1e30f, THR = 8.f;
__device__ __forceinline__ int crow(int r, int hi) { return (r & 3) + 8 * (r >> 2) + 4 * hi; }
typedef __bf16 bf16x2_t __attribute__((ext_vector_type(2)));
__device__ __forceinline__ unsigned cvtpk(float lo, float hi) { f32x2 v = {lo, hi}; bf16x2_t b = __builtin_convertvector(v, bf16x2_t); return __builtin_bit_cast(unsigned, b); }

__device__ __forceinline__ void partialSM(f32x16& p0, f32x16& p1, float& m_reg, float& alpha) {
    float pmax = p0[0];
#pragma unroll
    for (int r = 1; r < 16; ++r) pmax = fmaxf(pmax, p0[r]);
#pragma unroll
    for (int r = 0; r < 16; ++r) pmax = fmaxf(pmax, p1[r]);
    { auto rr = __builtin_amdgcn_permlane32_swap(__float_as_uint(pmax), __float_as_uint(pmax), false, false);
      pmax = fmaxf(__uint_as_float(rr[0]), __uint_as_float(rr[1])); }
    float mn;
    if (__builtin_expect(__all(pmax - m_reg <= THR), 1)) { mn = m_reg; alpha = 1.f; }
    else { mn = fmaxf(m_reg, pmax); alpha = __builtin_amdgcn_exp2f(m_reg - mn); m_reg = mn; }
#pragma unroll
    for (int r = 0; r < 16; ++r) { p0[r] = p0[r] - mn; p1[r] = p1[r] - mn; }
#pragma unroll
    for (int r = 0; r < 16; ++r) p0[r] = __builtin_amdgcn_exp2f(p0[r]);
}
__device__ __forceinline__ void finishSM(f32x16& p0, f32x16& p1, float alpha, float& l_reg, bf16x8& pa0, bf16x8& pa1, bf16x8& pa2, bf16x8& pa3) {
#pragma unroll
    for (int r = 0; r < 16; ++r) p1[r] = __builtin_amdgcn_exp2f(p1[r]);
    float ps = 0;
#pragma unroll
    for (int r = 0; r < 16; ++r) ps += p0[r];
#pragma unroll
    for (int r = 0; r < 16; ++r) ps += p1[r];
    { auto rr = __builtin_amdgcn_permlane32_swap(__float_as_uint(ps), __float_as_uint(ps), false, false);
      ps = __uint_as_float(rr[0]) + __uint_as_float(rr[1]); }
    l_reg = l_reg * alpha + ps;
#define PK4(P, BASE, OUT) do { unsigned a0 = cvtpk(P[BASE + 0], P[BASE + 1]), a1 = cvtpk(P[BASE + 2], P[BASE + 3]);   \
    unsigned b0 = cvtpk(P[BASE + 4], P[BASE + 5]), b1 = cvtpk(P[BASE + 6], P[BASE + 7]);                              \
    auto r0 = __builtin_amdgcn_permlane32_swap(a0, b0, false, false); auto r1 = __builtin_amdgcn_permlane32_swap(a1, b1, false, false); \
    u32x4 w = {r0[0], r1[0], r0[1], r1[1]}; OUT = __builtin_bit_cast(bf16x8, w); } while (0)
    PK4(p0, 0, pa0); PK4(p0, 8, pa1); PK4(p1, 0, pa2); PK4(p1, 8, pa3);
#undef PK4
}
template <int NQC>
__device__ __forceinline__ void qkt(f32x16& p0, f32x16& p1, const char* Ks, const bf16x8* qr, int r32, int hi) {
    p0 = f32x16{}; p1 = f32x16{};
#pragma unroll
    for (int d0 = 0; d0 < NQC; ++d0) { const int c = 2 * d0 + hi; const int a = c * 1024 + ((r32 ^ (c & 7)) << 4);
        const bf16x8 b0 = *reinterpret_cast<const bf16x8*>(Ks + a);
        const bf16x8 b1 = *reinterpret_cast<const bf16x8*>(Ks + a + 512);
        p0 = __builtin_amdgcn_mfma_f32_32x32x16_bf16(b0, qr[d0], p0, 0, 0, 0);
        p1 = __builtin_amdgcn_mfma_f32_32x32x16_bf16(b1, qr[d0], p1, 0, 0, 0); }
}
template <int NDB> __device__ __forceinline__ int v_st(int k, int c) { const int kk = (k & ~0xC) | ((k & 4) << 1) | ((k & 8) >> 1); return ((kk >> 3) * NDB + (c >> 5)) * 512 + ((kk & 7) * 32 + (c & 31)) * 2; }
__device__ __forceinline__ int v_rd_base(int lane) { return ((lane & 3) << 3) | (((lane >> 2) & 3) << 6) | (((lane >> 4) & 1) << 5) | (((lane >> 5) & 1) << 8); }
template <int NDB> constexpr int v_rd_off(int d0, int ks, int half) { return d0 * 512 + ks * (NDB * 1024) + half * (NDB * 512); }
template <int OFF> __device__ __forceinline__ s16x4 tr_read(int vb) { s16x4 r; asm volatile("ds_read_b64_tr_b16 %0, %1 offset:%2" : "=&v"(r) : "v"(vb), "i"(OFF) : "memory"); return r; }
template <int D0, int NDB> __device__ __forceinline__ void pv_one(f32x16& od, int vb, bf16x8 pa0, bf16x8 pa1, bf16x8 pa2, bf16x8 pa3) {
    const s16x4 l0 = tr_read<v_rd_off<NDB>(D0, 0, 0)>(vb), h0 = tr_read<v_rd_off<NDB>(D0, 0, 1)>(vb), l1 = tr_read<v_rd_off<NDB>(D0, 1, 0)>(vb), h1 = tr_read<v_rd_off<NDB>(D0, 1, 1)>(vb);
    const s16x4 l2 = tr_read<v_rd_off<NDB>(D0, 2, 0)>(vb), h2 = tr_read<v_rd_off<NDB>(D0, 2, 1)>(vb), l3 = tr_read<v_rd_off<NDB>(D0, 3, 0)>(vb), h3 = tr_read<v_rd_off<NDB>(D0, 3, 1)>(vb);
    asm volatile("s_waitcnt lgkmcnt(0)" ::: "memory"); SBAR();
#define PK(L, H) (bf16x8){L[0], L[1], L[2], L[3], H[0], H[1], H[2], H[3]}
    od = __builtin_amdgcn_mfma_f32_32x32x16_bf16(pa0, PK(l0, h0), od, 0, 0, 0);
    od = __builtin_amdgcn_mfma_f32_32x32x16_bf16(pa1, PK(l1, h1), od, 0, 0, 0);
    od = __builtin_amdgcn_mfma_f32_32x32x16_bf16(pa2, PK(l2, h2), od, 0, 0, 0);
    od = __builtin_amdgcn_mfma_f32_32x32x16_bf16(pa3, PK(l3, h3), od, 0, 0, 0);
#undef PK
}
template <int NDB> __device__ __forceinline__ void pv_all(f32x16* o, int vb, bf16x8 pa0, bf16x8 pa1, bf16x8 pa2, bf16x8 pa3) {
    pv_one<0, NDB>(o[0], vb, pa0, pa1, pa2, pa3); pv_one<1, NDB>(o[1], vb, pa0, pa1, pa2, pa3);
    if constexpr (NDB == 4) { pv_one<2, NDB>(o[2], vb, pa0, pa1, pa2, pa3); pv_one<3, NDB>(o[3], vb, pa0, pa1, pa2, pa3); }
}
__device__ __forceinline__ void mask_meta(f32x16& p0, f32x16& p1) {
#pragma unroll
    for (int r = 8; r < 16; ++r) p0[r] = NEGBIG;
#pragma unroll
    for (int r = 0; r < 16; ++r) p1[r] = NEGBIG;
}
__device__ __forceinline__ void mask_all(f32x16& p0, f32x16& p1) {
#pragma unroll
    for (int r = 0; r < 16; ++r) { p0[r] = NEGBIG; p1[r] = NEGBIG; }
}

template <int DQK, int DV, class P>
__device__ __forceinline__ void attn_unit(const P& pol, char* lds) {
    constexpr int NQC = DQK / 16, NDB = DV / 32, KB = 64 * DQK * 2, VB = 64 * DV * 2;
    constexpr int KCH = DQK / 8, VCH = DV / 8, NKS = (64 * KCH) / 512, NVS = (64 * VCH) / 512;
    int tid_ = threadIdx.x; asm volatile("" : "+v"(tid_));
    const int tid = tid_, wid = tid >> 6, lane = tid & 63, r32 = lane & 31, hi = lane >> 5;
    char* V_lds = lds; char* K_lds = lds + 3 * VB;
    float* ws = (float*)(lds + 3 * VB + 3 * KB) + wid * 64; float* li_l = ws; float* al_l = ws + 32;
    float m_reg = NEGBIG, l_reg = 0.f; f32x16 o[NDB];
#pragma unroll
    for (int d = 0; d < NDB; ++d) o[d] = f32x16{};
    bf16x8 qr[NQC];
    { const bf16* Qw = pol.qptr(wid * 32 + r32) + hi * 8;
#pragma unroll
      for (int d0 = 0; d0 < NQC; ++d0) qr[d0] = *reinterpret_cast<const bf16x8*>(Qw + d0 * 16); }
    pol.qfix(qr, wid * 32 + r32, hi);
    const int vb0 = (int)(uintptr_t)V_lds + v_rd_base(lane);
    bf16x8 ks[NKS], vs[NVS];
    const int srow = tid >> 3, c0 = tid & 7;
    const unsigned koff = (unsigned)(srow * pol.kstride + c0 * 8) * 2u, voff = (unsigned)(srow * pol.vstride + c0 * 8) * 2u;
    const int kst = c0 * 1024 + ((srow ^ c0) << 4), vst = v_st<NDB>(srow, c0 * 8);
    static_assert(NKS == KCH / 8 && NVS == VCH / 8, "staging map");
#define SLOAD(t) do { const char* kb_ = (const char*)pol.kbase(t) + koff; const char* vb_ = (const char*)pol.vbase(t) + voff; \
    _Pragma("unroll") for (int i = 0; i < NKS; ++i) ks[i] = *reinterpret_cast<const bf16x8*>(kb_ + i * 128); \
    _Pragma("unroll") for (int i = 0; i < NVS; ++i) vs[i] = *reinterpret_cast<const bf16x8*>(vb_ + i * 128); } while (0)
#define SWRITE(b) do { \
    _Pragma("unroll") for (int i = 0; i < NKS; ++i) *reinterpret_cast<bf16x8*>(K_lds + (b) * KB + kst + i * 8192) = ks[i]; \
    _Pragma("unroll") for (int i = 0; i < NVS; ++i) *reinterpret_cast<bf16x8*>(V_lds + (b) * VB + vst + i * 1024) = vs[i]; } while (0)
#define RESC(a) do { if (__any((a) < 1.f)) { if (hi == 0) al_l[r32] = (a); asm volatile("s_waitcnt lgkmcnt(0)" ::: "memory"); \
    _Pragma("unroll") for (int d = 0; d < NDB; ++d) _Pragma("unroll") for (int r = 0; r < 16; ++r) o[d][r] *= al_l[crow(r, hi)]; } } while (0)
#define XFORM(pa_, pb_, t) do { if (pol.needs_xform(t)) pol.xform(pa_, pb_, (t), wid, r32, hi); } while (0)
    f32x16 pA0, pA1, pB0, pB1; float alA, alB; bf16x8 pa0, pa1, pa2, pa3; const int NT = pol.nt;
    if constexpr (DQK <= 128) {
        bf16x8 ks2[NKS], vs2[NVS];
        SLOAD(0);
        { const char* kb_ = (const char*)pol.kbase(1) + koff; const char* vb_ = (const char*)pol.vbase(1) + voff;
#pragma unroll
          for (int i = 0; i < NKS; ++i) ks2[i] = *reinterpret_cast<const bf16x8*>(kb_ + i * 128);
#pragma unroll
          for (int i = 0; i < NVS; ++i) vs2[i] = *reinterpret_cast<const bf16x8*>(vb_ + i * 128); }
        asm volatile("s_waitcnt vmcnt(0)" ::: "memory"); SWRITE(0);
#pragma unroll
        for (int i = 0; i < NKS; ++i) *reinterpret_cast<bf16x8*>(K_lds + KB + kst + i * 8192) = ks2[i];
#pragma unroll
        for (int i = 0; i < NVS; ++i) *reinterpret_cast<bf16x8*>(V_lds + VB + vst + i * 1024) = vs2[i];
        __syncthreads();
        qkt<NQC>(pA0, pA1, K_lds, qr, r32, hi); XFORM(pA0, pA1, 0); partialSM(pA0, pA1, m_reg, alA);
    } else {
    SLOAD(0); asm volatile("s_waitcnt vmcnt(0)" ::: "memory"); SWRITE(0); __syncthreads();
    qkt<NQC>(pA0, pA1, K_lds, qr, r32, hi); XFORM(pA0, pA1, 0); partialSM(pA0, pA1, m_reg, alA);
    SLOAD(1); asm volatile("s_waitcnt vmcnt(0)" ::: "memory"); SWRITE(1); __syncthreads();
    }
    int bprev = 0, bcur = 1, bnext = 2;
#define ROT3() do { bprev = bcur; bcur = bnext; bnext = (bnext == 2) ? 0 : bnext + 1; } while (0)
    for (int j = 1; j + 1 < NT; j += 2) {
        SBAR(); qkt<NQC>(pB0, pB1, K_lds + bcur * KB, qr, r32, hi);
        finishSM(pA0, pA1, alA, l_reg, pa0, pa1, pa2, pa3); SBAR();
        SLOAD(j + 1); SBAR();
        pv_all<NDB>(o, vb0 + bprev * VB, pa0, pa1, pa2, pa3); XFORM(pB0, pB1, j); partialSM(pB0, pB1, m_reg, alB);
        asm volatile("s_waitcnt vmcnt(0)" ::: "memory"); SWRITE(bnext);
        RESC(alB); __syncthreads(); ROT3();
        SBAR(); qkt<NQC>(pA0, pA1, K_lds + bcur * KB, qr, r32, hi);
        finishSM(pB0, pB1, alB, l_reg, pa0, pa1, pa2, pa3); SBAR();
        SLOAD(j + 2); SBAR();
        pv_all<NDB>(o, vb0 + bprev * VB, pa0, pa1, pa2, pa3); XFORM(pA0, pA1, j + 1); partialSM(pA0, pA1, m_reg, alA);
        asm volatile("s_waitcnt vmcnt(0)" ::: "memory"); SWRITE(bnext);
        RESC(alA); __syncthreads(); ROT3();
    }
    SBAR(); qkt<NQC>(pB0, pB1, K_lds + bcur * KB, qr, r32, hi);
    finishSM(pA0, pA1, alA, l_reg, pa0, pa1, pa2, pa3); SBAR();
    pv_all<NDB>(o, vb0 + bprev * VB, pa0, pa1, pa2, pa3); XFORM(pB0, pB1, NT - 1); partialSM(pB0, pB1, m_reg, alB);
    RESC(alB);
    finishSM(pB0, pB1, alB, l_reg, pa0, pa1, pa2, pa3); SBAR();
    pv_all<NDB>(o, vb0 + bcur * VB, pa0, pa1, pa2, pa3);
#undef ROT3
    l_reg += pol.sink_term(m_reg);
    if (pol.partial()) {
        if (wid == 0) {
            if (lane < 16) { float* pp = pol.pptr(lane); pp[128] = m_reg; pp[129] = l_reg; }
#pragma unroll
            for (int r = 0; r < 8; ++r) { float* pp = pol.pptr(crow(r, hi));
#pragma unroll
                for (int d0 = 0; d0 < NDB; ++d0) pp[d0 * 32 + r32] = o[d0][r]; }
        }
    } else {
    if (hi == 0) li_l[r32] = l_reg; asm volatile("s_waitcnt lgkmcnt(0)" ::: "memory");
    float rli[16];
#pragma unroll
    for (int r = 0; r < 16; ++r) rli[r] = __builtin_amdgcn_rcpf(li_l[crow(r, hi)]);
#pragma unroll
    for (int r = 0; r < 16; ++r) { const int orow = wid * 32 + crow(r, hi);
        if (pol.ovalid(orow)) { bf16* op = pol.optr(orow);
#pragma unroll
            for (int d0 = 0; d0 < NDB; ++d0) op[d0 * 32 + r32] = (bf16)f2bf(o[d0][r] * rli[r]); } }
    }
    __syncthreads();
#undef SLOAD
#undef SWRITE
#undef RESC
#undef XFORM
}

__device__ __forceinline__ int unit_row(int b, int qb, int r) { int row = qb < 64 ? b * SEQ + qb * 256 + r : RMETA + 16 * b + r; return row < NR ? row : NR - 1; }

struct PolMLA {
    const bf16 *Kc, *Vm, *Q; bf16* O; float* part; const float* rope_; int b, h, qb, nt, kstride, vstride, split;
    __device__ __forceinline__ void init(const bf16* Kc_, const bf16* Vm_, const bf16* Q_, bf16* O_, float* part_, const float* rope__, int b_, int h_, int qb_, int split_) {
        Kc = Kc_; Vm = Vm_; Q = Q_; O = O_; part = part_; rope_ = rope__; b = b_; h = h_; qb = qb_; split = split_; kstride = KCW; vstride = VMW;
        nt = split < 0 ? 258 : (split == 0 ? 34 : 32); }
    __device__ __forceinline__ int krow0(int t) const {
        if (split < 0) return (t == 0 || t == 257) ? RMETA + 16 * b : b * SEQ + (t - 1) * 64;
        if (split == 0) return (t == 0 || t == 33) ? RMETA + 16 * b : b * SEQ + (t - 1) * 64;
        return b * SEQ + (32 * split + t) * 64; }
    __device__ __forceinline__ const bf16* kbase(int t) const { return Kc + (size_t)krow0(t) * KCW + h * 192; }
    __device__ __forceinline__ const bf16* vbase(int t) const { return Vm + (size_t)krow0(t) * VMW + h * 128; }
    __device__ __forceinline__ const bf16* qptr(int r) const { return Q + (size_t)unit_row(b, qb, r) * QW + h * 192; }
    __device__ __forceinline__ bf16* optr(int r) const { return O + (size_t)unit_row(b, qb, r) * AOW + h * 128; }
    __device__ __forceinline__ bool ovalid(int r) const { return qb < 64 || r < 16; }
    __device__ __forceinline__ bool needs_xform(int t) const { return split < 0 ? (t == 0 || t == 257) : (split == 0 && (t == 0 || t == 33)); }
    __device__ __forceinline__ void xform(f32x16& p0, f32x16& p1, int t, int, int, int) const { if (t == 0) mask_meta(p0, p1); else mask_all(p0, p1); }
    __device__ __forceinline__ float sink_term(float) const { return 0.f; }
    __device__ __forceinline__ bool partial() const { return split >= 0; }
    __device__ __forceinline__ void qfix(bf16x8* qr, int r, int hi) const {
        const int row = unit_row(b, qb, r); const int pos = row < RMETA ? NMETA + (row & (SEQ - 1)) : ((row - RMETA) & 15);
        const float* rp = rope_ + 2 * (size_t)(pos * 32);
#pragma unroll
        for (int blk = 0; blk < 2; ++blk) { const f32x4* cs = (const f32x4*)(rp + 2 * (16 * blk + 8 * hi)); f32x4 t[4];
#pragma unroll
            for (int q = 0; q < 4; ++q) t[q] = cs[q];
            bf16x8 x1 = qr[8 + blk], x2 = qr[10 + blk];
#pragma unroll
            for (int e = 0; e < 8; ++e) { const float c = t[e >> 1][(e & 1) * 2], sn = t[e >> 1][(e & 1) * 2 + 1];
                const float a = bf2f((unsigned short)x1[e]), bb = bf2f((unsigned short)x2[e]);
                x1[e] = (short)f2bf(a * c - bb * sn); x2[e] = (short)f2bf(bb * c + a * sn); }
            qr[8 + blk] = x1; qr[10 + blk] = x2; } }
    __device__ __forceinline__ float* pptr(int r) const { return part + ((size_t)((b * 8 + h) * 8 + split) * 16 + r) * 132; }
};

struct PolNA {
    const bf16* Z; bf16* O; const float* tab; int b, h, qb, nt, kstride, vstride, glo, n;
    __device__ __forceinline__ void init(const bf16* Z_, bf16* O_, const float* tab_, int b_, int h_, int qb_) {
        Z = Z_; O = O_; tab = tab_; b = b_; h = h_; qb = qb_; kstride = ZW; vstride = ZW;
        if (qb < 64) { int lo = 4 * qb - 4; lo = lo < 0 ? 0 : (lo > 248 ? 248 : lo); int hi_ = 4 * qb + 3 - 4; hi_ = hi_ < 0 ? 0 : (hi_ > 248 ? 248 : hi_); hi_ += 7; glo = lo; n = hi_ - lo + 1; }
        else { glo = 0; n = 0; }
        nt = (n + 1 + 1) & ~1; }
    __device__ __forceinline__ int krow0(int t) const { return (t == 0 || t > n) ? RMETA + 16 * b : b * SEQ + (glo + t - 1) * 64; }
    __device__ __forceinline__ const bf16* kbase(int t) const { return Z + (size_t)krow0(t) * ZW + ZNAK + h * 128; }
    __device__ __forceinline__ const bf16* vbase(int t) const { return Z + (size_t)krow0(t) * ZW + ZNAV + h * 128; }
    __device__ __forceinline__ const bf16* qptr(int r) const { return Z + (size_t)unit_row(b, qb, r) * ZW + ZNAQ + h * 128; }
    __device__ __forceinline__ bf16* optr(int r) const { return O + (size_t)unit_row(b, qb, r) * AOW + 1024 + h * 128; }
    __device__ __forceinline__ bool ovalid(int r) const { return qb < 64 || r < 16; }
    __device__ __forceinline__ bool needs_xform(int) const { return true; }
    __device__ __forceinline__ void xform(f32x16& p0, f32x16& p1, int t, int wid, int r32, int hi) const {
        if (t == 0) { mask_meta(p0, p1); return; }
        if (t > n) { mask_all(p0, p1); return; }
        const int g = glo + t - 1, r = 4 * qb + (wid >> 1), c = 32 * (wid & 1) + r32;
        int rs = r - 4; rs = rs < 0 ? 0 : (rs > 248 ? 248 : rs);
        if (g < rs || g >= rs + 8) { mask_all(p0, p1); return; }
        int cs = c - 8; cs = cs < 0 ? 0 : (cs > 48 ? 48 : cs);
        const float* trow = tab + (g - r + 7) * 31 + 15 - c;
#pragma unroll
        for (int i = 0; i < 16; ++i) { const int kc = crow(i, hi); const bool ok = kc >= cs && kc < cs + 16; const int kcc = ok ? kc : c;
            const float bv = trow[kcc]; p0[i] = ok ? p0[i] + bv : NEGBIG; }
#pragma unroll
        for (int i = 0; i < 16; ++i) { const int kc = 32 + crow(i, hi); const bool ok = kc >= cs && kc < cs + 16; const int kcc = ok ? kc : c;
            const float bv = trow[kcc]; p1[i] = ok ? p1[i] + bv : NEGBIG; }
    }
    __device__ __forceinline__ float sink_term(float) const { return 0.f; }
    __device__ __forceinline__ bool partial() const { return false; }
    __device__ __forceinline__ float* pptr(int) const { return nullptr; }
    __device__ __forceinline__ void qfix(bf16x8*, int, int) const {}
};

struct PolSWA {
    const bf16* Z; bf16* O; int b, hq, qb, nt, kstride, vstride, klo, n; float slope_l2, sink_l2;
    __device__ __forceinline__ void init(const bf16* Z_, bf16* O_, const float* sinks, int b_, int hq_, int qb_) {
        Z = Z_; O = O_; b = b_; hq = hq_; qb = qb_; kstride = Z1W; vstride = Z1W;
        if (qb < 64) { klo = 4 * qb - 2; if (klo < 0) klo = 0; int khi = 4 * qb + 5; if (khi > 255) khi = 255; n = khi - klo + 1; }
        else { klo = 0; n = 2; }
        nt = (n + 1 + 1) & ~1;
        slope_l2 = __builtin_amdgcn_exp2f(-0.25f * (float)(hq + 1)) * LOG2E; sink_l2 = sinks[hq] * LOG2E; }
    __device__ __forceinline__ int krow0(int t) const { return (t == 0 || t > n) ? RMETA + 16 * b : b * SEQ + (klo + t - 1) * 64; }
    __device__ __forceinline__ const bf16* kbase(int t) const { return Z + (size_t)krow0(t) * Z1W + 2048 + (hq >> 3) * 64; }
    __device__ __forceinline__ const bf16* vbase(int t) const { return Z + (size_t)krow0(t) * Z1W + 2304 + (hq >> 3) * 64; }
    __device__ __forceinline__ const bf16* qptr(int r) const { return Z + (size_t)unit_row(b, qb, r) * Z1W + hq * 64; }
    __device__ __forceinline__ bf16* optr(int r) const { return O + (size_t)unit_row(b, qb, r) * AOW + hq * 64; }
    __device__ __forceinline__ bool ovalid(int r) const { return qb < 64 || r < 16; }
    __device__ __forceinline__ bool needs_xform(int) const { return true; }
    __device__ __forceinline__ void xform(f32x16& p0, f32x16& p1, int t, int wid, int r32, int hi) const {
        if (t == 0) { mask_meta(p0, p1); return; }
        if (t > n) { mask_all(p0, p1); return; }
        const int kt = klo + t - 1;
        if (qb < 64) {
            const int d0 = 64 * kt - (256 * qb + 32 * wid + r32);
#pragma unroll
            for (int i = 0; i < 16; ++i) { int d = d0 + crow(i, hi); d = max(d, -d); const int m = min(max(d - 128, 0), 1); p0[i] = (p0[i] - slope_l2 * (float)d) + NEGBIG * (float)m; }
#pragma unroll
            for (int i = 0; i < 16; ++i) { int d = d0 + 32 + crow(i, hi); d = max(d, -d); const int m = min(max(d - 128, 0), 1); p1[i] = (p1[i] - slope_l2 * (float)d) + NEGBIG * (float)m; }
        } else {
            const int qi = 32 * wid + r32, j0 = 64 * kt;
#pragma unroll
            for (int i = 0; i < 16; ++i) { const int j = j0 + crow(i, hi); const int m = min(max(16 + j - qi - 128, 0), 1); p0[i] = p0[i] + NEGBIG * (float)m; }
#pragma unroll
            for (int i = 0; i < 16; ++i) { const int j = j0 + 32 + crow(i, hi); const int m = min(max(16 + j - qi - 128, 0), 1); p1[i] = p1[i] + NEGBIG * (float)m; }
        }
    }
    __device__ __forceinline__ float sink_term(float m) const { return __builtin_amdgcn_exp2f(sink_l2 - m); }
    __device__ __forceinline__ bool partial() const { return false; }
    __device__ __forceinline__ float* pptr(int) const { return nullptr; }
    __device__ __forceinline__ void qfix(bf16x8*, int, int) const {}
};
struct PolSWAG {
    const bf16* Z; bf16* O; int b, kvh, pb, nt, kstride, vstride, klo, n; float slope_l2, sink_l2;
    __device__ __forceinline__ void init(const bf16* Z_, bf16* O_, const float* sinks, int b_, int kvh_, int pb_, int wv) {
        Z = Z_; O = O_; b = b_; kvh = kvh_; pb = pb_; kstride = Z1W; vstride = Z1W;
        klo = (pb - 4) >> 1; if (klo < 0) klo = 0; int khi = (pb + 4) >> 1; if (khi > 255) khi = 255; n = khi - klo + 1;
        nt = (n + 1 + 1) & ~1;
        const int hq = kvh * 8 + wv;
        slope_l2 = __builtin_amdgcn_exp2f(-0.25f * (float)(hq + 1)) * LOG2E; sink_l2 = sinks[hq] * LOG2E; }
    __device__ __forceinline__ int krow0(int t) const { return (t == 0 || t > n) ? RMETA + 16 * b : b * SEQ + (klo + t - 1) * 64; }
    __device__ __forceinline__ const bf16* kbase(int t) const { return Z + (size_t)krow0(t) * Z1W + 2048 + kvh * 64; }
    __device__ __forceinline__ const bf16* vbase(int t) const { return Z + (size_t)krow0(t) * Z1W + 2304 + kvh * 64; }
    __device__ __forceinline__ const bf16* qptr(int r) const { return Z + (size_t)(b * SEQ + 32 * pb + (r & 31)) * Z1W + (kvh * 8 + (r >> 5)) * 64; }
    __device__ __forceinline__ bf16* optr(int r) const { return O + (size_t)(b * SEQ + 32 * pb + (r & 31)) * AOW + (kvh * 8 + (r >> 5)) * 64; }
    __device__ __forceinline__ bool ovalid(int) const { return true; }
    __device__ __forceinline__ bool needs_xform(int) const { return true; }
    __device__ __forceinline__ void xform(f32x16& p0, f32x16& p1, int t, int, int r32, int hi) const {
        if (t == 0) { mask_meta(p0, p1); return; }
        if (t > n) { mask_all(p0, p1); return; }
        const int rel = 64 * (klo + t - 1) - 32 * pb;
        const int d0 = rel - r32;
        if (rel == -96 || rel == -64 || rel == 32 || rel == 64) {
            const float sg = rel < 0 ? slope_l2 : -slope_l2;
            const float sb0 = sg * (float)(d0 + 4 * hi), sb1 = sb0 + sg * 32.f;
#pragma unroll
            for (int i = 0; i < 16; ++i) p0[i] = __builtin_fmaf(sg, (float)((i & 3) + 8 * (i >> 2)), p0[i] + sb0);
#pragma unroll
            for (int i = 0; i < 16; ++i) p1[i] = __builtin_fmaf(sg, (float)((i & 3) + 8 * (i >> 2)), p1[i] + sb1);
            return;
        }
        if (rel == -32 || rel == 0) {
#pragma unroll
            for (int i = 0; i < 16; ++i) { int d = d0 + crow(i, hi); d = max(d, -d); p0[i] = p0[i] - slope_l2 * (float)d; }
#pragma unroll
            for (int i = 0; i < 16; ++i) { int d = d0 + 32 + crow(i, hi); d = max(d, -d); p1[i] = p1[i] - slope_l2 * (float)d; }
            return;
        }
#pragma unroll
        for (int i = 0; i < 16; ++i) { int d = d0 + crow(i, hi); d = max(d, -d); const int m = min(max(d - 128, 0), 1); p0[i] = (p0[i] - slope_l2 * (float)d) + NEGBIG * (float)m; }
#pragma unroll
        for (int i = 0; i < 16; ++i) { int d = d0 + 32 + crow(i, hi); d = max(d, -d); const int m = min(max(d - 128, 0), 1); p1[i] = (p1[i] - slope_l2 * (float)d) + NEGBIG * (float)m; }
    }
    __device__ __forceinline__ float sink_term(float m) const { return __builtin_amdgcn_exp2f(sink_l2 - m); }
    __device__ __forceinline__ bool partial() const { return false; }
    __device__ __forceinline__ float* pptr(int) const { return nullptr; }
    __device__ __forceinline__ void qfix(bf16x8*, int, int) const {}
};
#undef SBAR
}

struct Params {
    const float* x; const float* meta; const float* norm_mix; const float* norm_ffn; const float* norm_final;
    const float* ab_w_in; const float* ab_q_norm; const float* ab_kv_norm; const float* ab_w_uq; const float* ab_w_ukv; const float* ab_rpb; const float* ab_w_out;
    const float* c_w_in; const float* c_sinks; const float* c_w_out;
    const float* ec_w_router; const float* ec_w_gate; const float* ec_w_up; const float* ec_w_down;
    float* out; unsigned char* ws;
};

__device__ __forceinline__ void load_row(const float* row, int lane, f32x4 (&v)[8]) {
    const f32x4* r = (const f32x4*)row + lane;
#pragma unroll
    for (int j = 0; j < 8; ++j) v[j] = r[64 * j];
}
__device__ __forceinline__ void load_row_bf16(const bf16* row, int lane, f32x4 (&v)[8]) {
    const u32x2* r = (const u32x2*)row + lane;
#pragma unroll
    for (int j = 0; j < 8; ++j) { const u32x2 w = r[64 * j]; v[j] = (f32x4){bflo(w.x), bfhi(w.x), bflo(w.y), bfhi(w.y)}; }
}
__device__ __forceinline__ void store_row_bf16(bf16* row, int lane, const f32x4 (&v)[8]) {
    u32x2* o8 = (u32x2*)row + lane;
#pragma unroll
    for (int j = 0; j < 8; ++j) { u32x2 w; w.x = pk2(v[j].x, v[j].y); w.y = pk2(v[j].z, v[j].w); o8[64 * j] = w; }
}
__device__ __forceinline__ float row_rs(const f32x4 (&v)[8]) {
    float s = 0.f;
#pragma unroll
    for (int j = 0; j < 8; ++j) s += (v[j].x * v[j].x + v[j].y * v[j].y) + (v[j].z * v[j].z + v[j].w * v[j].w);
    return 1.0f / sqrtf(wave_sum(s) * (1.f / D) + EPS);
}
__device__ __forceinline__ void store_norm_bf16(bf16* urow, int lane, const f32x4 (&v)[8], float rs, const float* g) {
    const f32x4* gp = (const f32x4*)g + lane; u32x2* o8 = (u32x2*)urow + lane;
#pragma unroll
    for (int j = 0; j < 8; ++j) { const f32x4 gg = gp[64 * j]; u32x2 w; w.x = pk2(v[j].x * rs * gg.x, v[j].y * rs * gg.y); w.y = pk2(v[j].z * rs * gg.z, v[j].w * rs * gg.w); o8[64 * j] = w; }
}
__device__ __forceinline__ void store_zero_bf16(bf16* urow, int lane) {
    u32x2* o8 = (u32x2*)urow + lane;
#pragma unroll
    for (int j = 0; j < 8; ++j) o8[64 * j] = (u32x2){0u, 0u};
}

__device__ __forceinline__ void transpose_item(const float* src, int srcN, int k0, int n0, bf16* dst, int dstK, int dst_row0, const float* kscale, LAS float*, int lane) {
    const int kg = lane >> 4, ng = lane & 15;
    f32x4 v[2][8];
#pragma unroll
    for (int half = 0; half < 2; ++half) { const int kk0 = k0 + 32 * half + 8 * kg;
#pragma unroll
        for (int j = 0; j < 8; ++j) v[half][j] = *(const f32x4*)(src + (size_t)(kk0 + j) * srcN + n0 + 4 * ng); }
#pragma unroll
    for (int half = 0; half < 2; ++half) {
        const int kk0 = k0 + 32 * half + 8 * kg;
        if (kscale) {
#pragma unroll
            for (int j = 0; j < 8; ++j) v[half][j] = v[half][j] * kscale[kk0 + j]; }
#pragma unroll
        for (int q = 0; q < 4; ++q) { u32x4 o; o.x = pk2(v[half][0][q], v[half][1][q]); o.y = pk2(v[half][2][q], v[half][3][q]); o.z = pk2(v[half][4][q], v[half][5][q]); o.w = pk2(v[half][6][q], v[half][7][q]);
            *(u32x4*)(dst + (size_t)(dst_row0 + 4 * ng + q) * dstK + kk0) = o; }
    }
}
template <class Map>
__device__ __forceinline__ void transpose_matrix(const float* W, int K, int N, bf16* WT, const float* kscale, LAS float* scr, int gw, int ngw, int lane, const Map& map) {
    const int nkb = K / 64, nnb = N / 64, items = nkb * nnb;
    for (int it = gw; it < items; it += ngw) { const int kb = it / nnb, nb = it % nnb; transpose_item(W, N, kb * 64, nb * 64, WT, K, map(nb * 64), kscale, scr, lane); }
}
__device__ __forceinline__ void convert_experts(const float* wg, const float* wu, const float* wd, const float* gk, bf16* Wgu, bf16* Wd, LAS float* scr, int gw, int ngw, int lane, int lo, int hi) {
    constexpr int PER = 32 * 32;
    for (int it = lo + gw; it < hi; it += ngw) {
        const int e = it / (3 * PER), r = it % (3 * PER), which = r / PER, q = r % PER, kb = q / 32, nb = q % 32, n0 = nb * 64;
        const size_t eoff = (size_t)e * D * D;
        if (which == 0) transpose_item(wg + eoff, D, kb * 64, n0, Wgu + (size_t)e * 4096 * D, D, (n0 >> 7) * 256 + (n0 & 127), gk, scr, lane);
        else if (which == 1) transpose_item(wu + eoff, D, kb * 64, n0, Wgu + (size_t)e * 4096 * D, D, (n0 >> 7) * 256 + 128 + (n0 & 127), gk, scr, lane);
        else transpose_item(wd + eoff, D, kb * 64, n0, Wd + eoff, D, n0, nullptr, scr, lane);
    }
}

constexpr int CV_ITEMS = NE * 3 * 32 * 32, CV_TAIL_PER_CU = 80;
constexpr int CV_TOPK = 224 * 30;
constexpr int CV_CHUNK = 64;
constexpr int CV_IN0 = (256 - (129 * 17) % 256) * CV_TAIL_PER_CU, CV_OUT = (256 - (129 * 8) % 256) * CV_TAIL_PER_CU, CV_IN1 = (256 - (129 * 10) % 256) * CV_TAIL_PER_CU;
constexpr int CV_MAIN0 = CV_ITEMS - CV_IN0 - CV_OUT - CV_TOPK;
#ifndef PHASES
#define PHASES 0xffffffffu
#endif
#define EN(k) (((PHASES) >> (k)) & 1u)
#define PH_IDS() int tid = threadIdx.x; asm volatile("" : "+v"(tid)); const int lane = tid & 63, wave = __builtin_amdgcn_readfirstlane(tid >> 6), gw = vcu * NWAVES + wave; (void)lane; (void)wave; (void)gw; WSL()
__global__ void __launch_bounds__(NTHREADS, 2) fwd_kernel(Params P) {
    extern __shared__ __attribute__((aligned(16))) unsigned char lds[];
    LAS unsigned char* ldsl = (LAS unsigned char*)lds;
    volatile LAS unsigned* MISC = (volatile LAS unsigned*)(ldsl + MISC_OFF);
    const int G = gridDim.x, bx = blockIdx.x;
    const int vcu = (G % 8 == 0) ? (bx % 8) * (G / 8) + bx / 8 : bx;
    const int NGW = G * NWAVES;
    unsigned* ctl = (unsigned*)(P.ws + WS_CTL);
    for (int u = threadIdx.x; u < 64; u += NTHREADS) MISC[u] = 0u;
    __syncthreads();
    XcdBarrier bar = xcd_barrier_post(ctl + CW_BAR, MISC + 8);
#define GRID_BAR() xcd_barrier(bar)

#define WSL() GAS unsigned char* wsg_ = (GAS unsigned char*)P.ws; asm volatile("" : "+s"(wsg_)); unsigned char* wsl = (unsigned char*)wsg_
#define rope ((float*)(wsl + WS_ROPE))
#define rsq ((float*)(wsl + WS_RSQ))
#define rskv ((float*)(wsl + WS_RSKV))
#define aff ((float*)(wsl + WS_AFF))
#define tokslot ((int*)(wsl + WS_TOKSLOT))
#define slottok ((int*)(wsl + WS_SLOTTOK))
#define xgate ((float*)(wsl + WS_XGATE))
#define xmap ((int*)(wsl + WS_XMAP))
#define rsf ((float*)(wsl + WS_RSF))
#define xrs ((float*)(wsl + WS_XRS))
#define rsm ((float*)(wsl + WS_RSM))
#define Win0 ((bf16*)(wsl + WS_WIN0))
#define Wuq ((bf16*)(wsl + WS_WUQ))
#define Wukv ((bf16*)(wsl + WS_WUKV))
#define Wout0 ((bf16*)(wsl + WS_WOUT0))
#define Win1 ((bf16*)(wsl + WS_WIN1))
#define Wout1 ((bf16*)(wsl + WS_WOUT1))
#define Wgu ((bf16*)(wsl + WS_WGU))
#define Wd ((bf16*)(wsl + WS_WD))
#define Hm ((bf16*)(wsl + WS_H))
#define U ((bf16*)(wsl + WS_U))
#define Z ((bf16*)(wsl + WS_Z))
#define Qb ((bf16*)(wsl + WS_Q))
#define Kc ((bf16*)(wsl + WS_KC))
#define Vm ((bf16*)(wsl + WS_VM))
#define AO ((bf16*)(wsl + WS_AO))
#define XS ((bf16*)(wsl + WS_XS))
#define HMID ((bf16*)(wsl + WS_HMID))

    if (EN(0)) {
        PH_IDS();
        LAS float* scr = (LAS float*)(ldsl + wave * 16640);
        transpose_matrix(P.ab_w_in, D, 4160, Win0, nullptr, scr, gw, NGW, lane, [](int n0) { return n0 < 1024 ? n0 : (n0 < 1088 ? 4096 + (n0 - 1024) : n0 - 64); });
        transpose_matrix(P.ab_w_uq, 512, 1536, Wuq, P.ab_q_norm, scr, gw, NGW, lane, [](int n0) { return n0; });
        transpose_matrix(P.ab_w_ukv, 512, 2048, Wukv, P.ab_kv_norm, scr, gw, NGW, lane, [](int n0) { return n0; });
        transpose_matrix(P.ab_w_out, D, D, Wout0, nullptr, scr, gw, NGW, lane, [](int n0) { return n0; });
        transpose_matrix(P.c_w_in, D, Z1W, Win1, P.norm_mix + D, scr, gw, NGW, lane, [](int n0) { return n0; });
        transpose_matrix(P.c_w_out, D, D, Wout1, nullptr, scr, gw, NGW, lane, [](int n0) { return n0; });
        if (G != 256) convert_experts(P.ec_w_gate, P.ec_w_up, P.ec_w_down, P.norm_ffn, Wgu, Wd, scr, gw, NGW, lane, 0, CV_ITEMS);
        for (int row = NTOK + gw * 64 + lane; row < NR; row += NGW * 64) rsm[row] = 0.f;
        for (int i = gw * 64 + lane; i < 192 * D / 8; i += NGW * 64) ((u32x4*)(Win0 + (size_t)4160 * D))[i] = (u32x4){0u, 0u, 0u, 0u};
        for (int row = gw; row < NR; row += NGW) {
            bf16* urow = U + (size_t)row * D;
            if (row < NTOK) {
                const float* src = row < RMETA ? P.x + (size_t)row * D : P.meta + (size_t)((row - RMETA) & 15) * D;
                f32x4 v[8]; load_row(src, lane, v);
                const float rs = row_rs(v); store_norm_bf16(urow, lane, v, rs, P.norm_mix);
            } else store_zero_bf16(urow, lane);
        }
        for (int i = gw * 64 + lane; i < LTOK * 32; i += NGW * 64) {
            const int pos = i >> 5, j = i & 31;
            double f = 1.0; { double r = 0.74989420933245582730;   for (int q = 0; q < j; ++q) f *= r; }
            const double rev = (double)pos * f * 0.15915494309189533577;
            const float fr = (float)(rev - __builtin_floor(rev));
            rope[2 * i] = __builtin_amdgcn_cosf(fr); rope[2 * i + 1] = __builtin_amdgcn_sinf(fr);
        }
    }
    GRID_BAR();

    for (int layer = 0; layer < 2; ++layer) {
        if (EN(1)) {
            WSL();
            const int nN = layer == 0 ? 17 : 10, ldz = layer == 0 ? ZW : Z1W;
            pg8::Gemm g{layer == 0 ? U : Hm, layer == 0 ? Win0 : Win1, D, D, D};
            pg8::TileOrder S; S.init(NR / 256, nN, G, bx, 0);
            pg8::EpiBf16S E{Z, ldz, layer == 0 ? nullptr : rsm, layer == 0 ? 4 : 0, 8, layer == 0 ? C_NA : C_SWA};
            pg8::gemm_phase(ldsl, g, S, E);
            if (G == 256) {
                const int rem = (129 * nN) % 256;
                if (bx >= rem) { PH_IDS(); const int cnt = layer == 0 ? CV_IN0 : CV_IN1, base = CV_ITEMS - CV_OUT - cnt; const size_t lo = (size_t)layer * NE * D * D;
                    convert_experts(P.ec_w_gate + lo, P.ec_w_up + lo, P.ec_w_down + lo, P.norm_ffn + (size_t)layer * D, Wgu, Wd, (LAS float*)ldsl, (bx - rem) * NWAVES + wave, (256 - rem) * NWAVES, lane, base, base + cnt); }
            }
        }
        GRID_BAR();
        if (layer == 0) {
            if (EN(2)) { PH_IDS();
                const int sub = lane >> 4, l16 = lane & 15;
                for (int row4 = gw * 4; row4 < NR; row4 += NGW * 4) {
                    const int row = row4 + sub;
                    const bf16* zr = Z + (size_t)row * ZW;
                    u32x4 a[4], bq[4];
#pragma unroll
                    for (int i = 0; i < 4; ++i) { a[i] = *(const u32x4*)(zr + ZQL + 128 * i + 8 * l16); bq[i] = *(const u32x4*)(zr + ZKVL + 128 * i + 8 * l16); }
                    const int pos = row < RMETA ? NMETA + (row & (SEQ - 1)) : ((row - RMETA) & 15);
                    const unsigned x1w = *(const unsigned*)(zr + ZKR + 2 * l16), x2w = *(const unsigned*)(zr + ZKR + 32 + 2 * l16);
                    const f32x4 cs = *(const f32x4*)(rope + 2 * (pos * 32 + 2 * l16));
                    float s1 = 0.f, s2 = 0.f;
#pragma unroll
                    for (int i = 0; i < 4; ++i)
#pragma unroll
                        for (int q = 0; q < 4; ++q) { const float a0 = bflo(a[i][q]), a1 = bfhi(a[i][q]), b0 = bflo(bq[i][q]), b1 = bfhi(bq[i][q]); s1 += a0 * a0 + a1 * a1; s2 += b0 * b0 + b1 * b1; }
#pragma unroll
                    for (int o = 1; o < 16; o <<= 1) { s1 += __shfl_xor(s1, o); s2 += __shfl_xor(s2, o); }
                    if (l16 == 0) { rsq[row] = C_MLA / sqrtf(s1 * (1.f / 512) + EPS); rskv[row] = 1.0f / sqrtf(s2 * (1.f / 512) + EPS); }
                    const float z = row < NTOK ? 1.f : 0.f;
                    const float x1a = bflo(x1w) * z, x1b = bfhi(x1w) * z, x2a = bflo(x2w) * z, x2b = bfhi(x2w) * z;
                    const unsigned w1 = pk2(x1a * cs[0] - x2a * cs[1], x1b * cs[2] - x2b * cs[3]), w2 = pk2(x2a * cs[0] + x1a * cs[1], x2b * cs[2] + x1b * cs[3]);
                    bf16* kr = Kc + (size_t)row * KCW + 128 + 2 * l16;
#pragma unroll
                    for (int h = 0; h < 8; ++h) { *(unsigned*)(kr + h * 192) = w1; *(unsigned*)(kr + h * 192 + 32) = w2; }
                } }
            GRID_BAR();
            if (EN(3)) {
                WSL();
                pg8::Gemm g{Z + ZQL, Wuq, ZW, 512, 512};
                pg8::TileOrder S; S.init(NR / 256, 6, G, bx, 0);
                pg8::EpiBf16S E{Qb, QW, rsq, 0, 0, 1.f};
                pg8::gemm_phase(ldsl, g, S, E);
            }
            if (EN(4)) {
                WSL();
                pg8::Gemm g{Z + ZKVL, Wukv, ZW, 512, 512};
                pg8::TileOrder S; S.init(NR / 256, 8, G, G == 256 ? (bx + 248) & 255 : bx, 0);
                pg8::EpiKV E{Kc, Vm, rskv};
                pg8::gemm_phase(ldsl, g, S, E);
            }
            GRID_BAR();
            {
                WSL();
                constexpr int N_MLA = 1024 + 128, N_NA = 1040;
                float* tab = (float*)(lds + 3 * 16384 + 3 * 16384 + 2048);
                float* PART = (float*)(wsl + WS_PART);
                unsigned* ticket = (unsigned*)(wsl + WS_CTL) + CW_TICKET;
                for (int u0 = vcu; ; ) {
                    int u;
                    if (u0 < 1024) { u = u0; u0 += G; }
                    else {
                        if (threadIdx.x == 0) MISC[16] = 1024u + __hip_atomic_fetch_add(ticket, 1u, __ATOMIC_RELAXED, __HIP_MEMORY_SCOPE_AGENT);
                        __syncthreads();
                        u = (int)MISC[16];
                        if (u >= N_MLA + N_NA) {
                            const int c = u - (N_MLA + N_NA);
                            if (G != 256 || c >= (CV_MAIN0 + CV_CHUNK - 1) / CV_CHUNK) break;
                            const int ln = threadIdx.x & 63, wv = __builtin_amdgcn_readfirstlane((int)threadIdx.x >> 6), hi_ = (c + 1) * CV_CHUNK < CV_MAIN0 ? (c + 1) * CV_CHUNK : CV_MAIN0;
                            convert_experts(P.ec_w_gate, P.ec_w_up, P.ec_w_down, P.norm_ffn, Wgu, Wd, (LAS float*)ldsl, wv, NWAVES, ln, c * CV_CHUNK, hi_);
                            __syncthreads();
                            continue;
                        }
                    }
                    if (u < N_MLA) { if (EN(6)) {
                        int b, h, qb, sp; if (u < 1024) { const int bh = u >> 6; b = bh >> 3; h = bh & 7; qb = u & 63; sp = -1; } else { const int v = u - 1024; const int bh = v >> 3; b = bh >> 3; h = bh & 7; qb = 64; sp = v & 7; }
                        att::PolMLA pol; pol.init(Kc, Vm, Qb, AO, PART, rope, b, h, qb, sp);
                        att::attn_unit<192, 128>(pol, (char*)lds); }
                    } else if (EN(7)) {
                        const int v = u - N_MLA; int b, h, qb; if (v < 1024) { const int bh = v >> 6; b = bh >> 3; h = bh & 7; qb = v & 63; } else { const int bh = v - 1024; b = bh >> 3; h = bh & 7; qb = 64; }
                        for (int i = threadIdx.x; i < 15 * 31; i += NTHREADS) tab[i] = P.ab_rpb[h * 465 + i] * LOG2E;
                        __syncthreads();
                        att::PolNA pol; pol.init(Z, AO, tab, b, h, qb);
                        att::attn_unit<128, 128>(pol, (char*)lds);
                    }
                }
            }
            GRID_BAR();
            {
                PH_IDS();
                const float* PART = (const float*)(wsl + WS_PART);
                for (int it = gw; it < 2 * 8 * 16; it += NGW) {
                    const int row = it & 15, bh = it >> 4, b = bh >> 3, h = bh & 7;
                    const float* pp = PART + ((size_t)(bh * 8) * 16 + row) * 132;
                    float M = -3e38f;
#pragma unroll
                    for (int sp = 0; sp < 8; ++sp) M = fmaxf(M, pp[(size_t)sp * 16 * 132 + 128]);
                    float L = 0.f, o0 = 0.f, o1 = 0.f;
#pragma unroll
                    for (int sp = 0; sp < 8; ++sp) { const float* q = pp + (size_t)sp * 16 * 132; const float w = __builtin_amdgcn_exp2f(q[128] - M); L += w * q[129]; o0 += w * q[lane]; o1 += w * q[64 + lane]; }
                    const float rl = 1.0f / L; bf16* op = AO + (size_t)(RMETA + 16 * b + row) * AOW + h * 128;
                    op[lane] = (bf16)f2bf(o0 * rl); op[64 + lane] = (bf16)f2bf(o1 * rl);
                }
            }
        } else {
            WSL();
            if (EN(8)) {
                const int wv = __builtin_amdgcn_readfirstlane((int)threadIdx.x >> 6);
                for (int u = vcu; u < 4096; u += G) {
                    att::PolSWAG pol; pol.init(Z, AO, P.c_sinks, u >> 11, (u >> 9) & 3, u & 511, wv);
                    att::attn_unit<64, 64>(pol, (char*)lds);
                }
                for (int u = vcu; u < 64; u += G) {
                    att::PolSWA pol; pol.init(Z, AO, P.c_sinks, u >> 5, u & 31, 64);
                    att::attn_unit<64, 64>(pol, (char*)lds);
                }
            }
        }
        GRID_BAR();
        if (EN(9)) {
            WSL();
            pg8::Gemm g{AO, layer == 0 ? Wout0 : Wout1, AOW, D, D};
            pg8::TileOrder S; S.init(NR / 256, 8, G, bx, 0);
            pg8::EpiResid E{Hm, D, layer == 0 ? P.x : nullptr, P.meta};
            pg8::gemm_phase(ldsl, g, S, E);
            if (G == 256) {
                const int rem = (129 * 8) % 256;
                if (bx >= rem) { PH_IDS(); const size_t lo = (size_t)layer * NE * D * D;
                    convert_experts(P.ec_w_gate + lo, P.ec_w_up + lo, P.ec_w_down + lo, P.norm_ffn + (size_t)layer * D, Wgu, Wd, (LAS float*)ldsl, (bx - rem) * NWAVES + wave, (256 - rem) * NWAVES, lane, CV_ITEMS - CV_OUT, CV_ITEMS); }
            }
        }
        GRID_BAR();
        if (EN(10)) {
            PH_IDS();
            LAS float* wb = (LAS float*)ldsl;
            LAS float* red = (LAS float*)(ldsl + 131072);
            const float* wsrc = P.ec_w_router + (size_t)layer * D * NE; const float* gf = P.norm_ffn + (size_t)layer * D;
            for (int i = tid; i < D * 4; i += NTHREADS) { const int k = i >> 2, eg = i & 3; const f32x4 w4 = *(const f32x4*)(wsrc + (size_t)k * NE + 4 * eg) * gf[k];
                const int base = ((k >> 2) * 16 + 4 * eg) * 4 + (k & 3);
                wb[base] = w4.x; wb[base + 4] = w4.y; wb[base + 8] = w4.z; wb[base + 12] = w4.w; }
            __syncthreads();
            const int r = lane & 15, kq = lane >> 4;
            u32x4 hv[8];
            { const bf16* hp = Hm + (size_t)(vcu * 16 + r) * D + 256 * wave + 8 * kq;
#pragma unroll
              for (int i = 0; i < 8; ++i) hv[i] = *(const u32x4*)(hp + 32 * i); }
            for (int blk = vcu; blk < NTOK / 16; blk += G) {
                const int row0 = blk * 16;
                f32x4 acc = {0.f, 0.f, 0.f, 0.f}; float ss = 0.f;
#pragma unroll
                for (int i = 0; i < 8; ++i) {
                    const LAS f32x4* bp = (const LAS f32x4*)wb + (((wave * 8 + i) * 4 + kq) * 2) * 16 + r;
                    const f32x4 b0 = bp[0], b1 = bp[16];
                    const float a0 = bflo(hv[i].x), a1 = bfhi(hv[i].x), a2 = bflo(hv[i].y), a3 = bfhi(hv[i].y), a4 = bflo(hv[i].z), a5 = bfhi(hv[i].z), a6 = bflo(hv[i].w), a7 = bfhi(hv[i].w);
                    acc = __builtin_amdgcn_mfma_f32_16x16x4f32(a0, b0.x, acc, 0, 0, 0); acc = __builtin_amdgcn_mfma_f32_16x16x4f32(a1, b0.y, acc, 0, 0, 0);
                    acc = __builtin_amdgcn_mfma_f32_16x16x4f32(a2, b0.z, acc, 0, 0, 0); acc = __builtin_amdgcn_mfma_f32_16x16x4f32(a3, b0.w, acc, 0, 0, 0);
                    acc = __builtin_amdgcn_mfma_f32_16x16x4f32(a4, b1.x, acc, 0, 0, 0); acc = __builtin_amdgcn_mfma_f32_16x16x4f32(a5, b1.y, acc, 0, 0, 0);
                    acc = __builtin_amdgcn_mfma_f32_16x16x4f32(a6, b1.z, acc, 0, 0, 0); acc = __builtin_amdgcn_mfma_f32_16x16x4f32(a7, b1.w, acc, 0, 0, 0);
                    ss += (a0 * a0 + a1 * a1) + (a2 * a2 + a3 * a3) + (a4 * a4 + a5 * a5) + (a6 * a6 + a7 * a7);
                }
                if (blk + G < NTOK / 16) {
                    const bf16* hp = Hm + (size_t)((blk + G) * 16 + r) * D + 256 * wave + 8 * kq;
#pragma unroll
                    for (int i = 0; i < 8; ++i) hv[i] = *(const u32x4*)(hp + 32 * i); }
                ss += __shfl_xor(ss, 16); ss += __shfl_xor(ss, 32);
                LAS float* rw = red + wave * 272;
                *(LAS f32x4*)(rw + 4 * lane) = acc;
                if (lane < 16) rw[256 + lane] = ss;
                __syncthreads();
                if (wave == 0) {
                    f32x4 lg = {0.f, 0.f, 0.f, 0.f}; float sq[4] = {0.f, 0.f, 0.f, 0.f};
#pragma unroll
                    for (int w = 0; w < 8; ++w) { lg = lg + *(const LAS f32x4*)(red + w * 272 + 4 * lane);
#pragma unroll
                        for (int j = 0; j < 4; ++j) sq[j] += red[w * 272 + 256 + 4 * kq + j]; }
#pragma unroll
                    for (int j = 0; j < 4; ++j) {
                        const int row = row0 + 4 * kq + j; const float rs = 1.0f / sqrtf(sq[j] * (1.f / D) + EPS);
                        const float x = lg[j] * rs;
                        float mx = x; mx = fmaxf(mx, __shfl_xor(mx, 1)); mx = fmaxf(mx, __shfl_xor(mx, 2)); mx = fmaxf(mx, __shfl_xor(mx, 4)); mx = fmaxf(mx, __shfl_xor(mx, 8));
                        const float p = __expf(x - mx); float sum = p;
                        sum += __shfl_xor(sum, 1); sum += __shfl_xor(sum, 2); sum += __shfl_xor(sum, 4); sum += __shfl_xor(sum, 8);
                        const int b = row < RMETA ? (row >> 14) : ((row - RMETA) >> 4); const int tok = row < RMETA ? NMETA + (row & (SEQ - 1)) : ((row - RMETA) & 15);
                        aff[(size_t)(b * NE + r) * LTOK + tok] = p / sum;
                        if (r == 0) rsf[row] = rs;
                    }
                }
                __syncthreads();
            }
        }
        GRID_BAR();
        if (EN(11) && vcu < 32) {
            PH_IDS();
            const int be = vcu, b = be >> 4, e = be & 15;
            LAS unsigned* keys = (LAS unsigned*)ldsl;
            LAS unsigned* hist = (LAS unsigned*)(ldsl + 66560);
            LAS unsigned* sh = (LAS unsigned*)(ldsl + 66560 + 1024);
            const float* av = aff + (size_t)be * LTOK;
            for (int i = tid; i < LTOK; i += NTHREADS) keys[i] = __float_as_uint(av[i]);
            __syncthreads();
            const int i0 = tid * 33, i1 = (i0 + 33 < LTOK) ? i0 + 33 : LTOK;
            unsigned kv[33];
#pragma unroll
            for (int q = 0; q < 33; ++q) kv[q] = (i0 + q < LTOK) ? keys[i0 + q] : 0u;
            unsigned T = 0u;
            for (int bit = 30; bit >= 0; --bit) {
                const unsigned cand = T | (1u << bit); unsigned c = 0u;
#pragma unroll
                for (int q = 0; q < 33; ++q) c += 1u - ((kv[q] - cand) >> 31);
#pragma unroll
                for (int o = 1; o < 64; o <<= 1) c += __shfl_xor(c, o);
                LAS unsigned* slot = sh + 32 + (bit & 1) * 8;
                if (lane == 0) slot[wave] = c;
                __syncthreads();
                unsigned tot = 0u;
#pragma unroll
                for (int w = 0; w < 8; ++w) tot += slot[w];
                T |= (1u - ((tot - (unsigned)CAP) >> 31)) << bit;
            }
            unsigned cgt = 0u, ceq = 0u;
#pragma unroll
            for (int q = 0; q < 33; ++q) { const unsigned k = kv[q]; cgt += k > T ? 1u : 0u; ceq += (k == T && i0 + q < LTOK) ? 1u : 0u; }
            unsigned pk = cgt | (ceq << 16), incl = pk;
#pragma unroll
            for (int o = 1; o < 64; o <<= 1) { const unsigned t = __shfl_up(incl, o); if (lane >= o) incl += t; }
            if (lane == 63) sh[16 + wave] = incl;
            __syncthreads();
            unsigned wbase = 0u, totgt = 0u;
            for (int w = 0; w < 8; ++w) { const unsigned x = sh[16 + w]; totgt += x & 0xffffu; if (w < wave) wbase += x; }
            const unsigned krem = (unsigned)CAP - totgt;
            const unsigned excl = wbase + incl - pk;
            unsigned ngt = excl & 0xffffu, neq = excl >> 16;
            int* tsl = tokslot + (size_t)be * LTOK; int* stk = slottok + (size_t)be * CAP; float* xg = xgate + (size_t)e * XPE + b * CAP; int* xm = xmap + (size_t)e * XPE + b * CAP; float* xr = xrs + (size_t)e * XPE + b * CAP;
            for (int i = i0; i < i1; ++i) { const unsigned k = keys[i]; bool sel = k > T; if (k == T) { sel = neq < krem; }
                int slot = -1;
                if (sel) { slot = (int)(ngt + (neq < krem ? neq : krem)); if (slot < CAP) { const int trow = i < NMETA ? RMETA + 16 * b + i : b * SEQ + (i - NMETA); stk[slot] = trow; xm[slot] = trow; xg[slot] = __uint_as_float(k); xr[slot] = rsf[trow]; } else slot = -1; }
                if (k > T) ++ngt; if (k == T) ++neq;
                tsl[i] = slot; }
            if (b == 1) for (int i = tid; i < XPE - 2 * CAP; i += NTHREADS) { xgate[(size_t)e * XPE + 2 * CAP + i] = 0.f; xmap[(size_t)e * XPE + 2 * CAP + i] = NR - 1; xrs[(size_t)e * XPE + 2 * CAP + i] = 0.f; }
        }
        else if (EN(11) && G == 256) {
            PH_IDS(); const int cin = layer == 0 ? CV_IN0 : CV_IN1, hi_ = CV_ITEMS - CV_OUT - cin; const size_t lo = (size_t)layer * NE * D * D;
            convert_experts(P.ec_w_gate + lo, P.ec_w_up + lo, P.ec_w_down + lo, P.norm_ffn + (size_t)layer * D, Wgu, Wd, (LAS float*)ldsl, (vcu - 32) * NWAVES + wave, 224 * NWAVES, lane, hi_ - CV_TOPK, hi_);
        }
        GRID_BAR();
        if (EN(13)) {
            WSL();
            pg8::Gemm g{Hm, Wgu, D, D, D, xmap};
            pg8::TileOrder S; S.init(XROWS / 256, 16, G, bx, 17);
            pg8::EpiSwiGLU E{HMID, D, xrs};
            pg8::gemm_phase<true>(ldsl, g, S, E);
        }
        GRID_BAR();
        if (EN(14)) {
            WSL();
            pg8::Gemm g{HMID, Wd, D, D, D};
            pg8::TileOrder S; S.init(XROWS / 256, 8, G, bx, 17);
            pg8::EpiBf16S E{XS, D, xgate, 0, 0, 1.f};
            pg8::gemm_phase(ldsl, g, S, E);
        }
        GRID_BAR();
        if (EN(15)) {
            PH_IDS();
            const float* gn = layer == 0 ? P.norm_mix + D : P.norm_final;
            for (int row = gw; row < (layer == 0 ? NTOK : RMETA); row += NGW) {
                const int b = row < RMETA ? (row >> 14) : ((row - RMETA) >> 4); const int tok = row < RMETA ? NMETA + (row & (SEQ - 1)) : ((row - RMETA) & 15);
                f32x4 v[8]; bf16* hrow = Hm + (size_t)row * D; load_row_bf16(hrow, lane, v);
                int sl[NE];
#pragma unroll
                for (int e = 0; e < NE; ++e) sl[e] = tokslot[(size_t)(b * NE + e) * LTOK + tok];
                int cnt = 0, o0 = 0, o1 = 0, o2 = 0, o3 = 0;
#pragma unroll
                for (int e = 0; e < NE; ++e) {
                    const int s = __builtin_amdgcn_readfirstlane(sl[e]); const int ok = s >= 0 ? 1 : 0, xr_ = e * XPE + b * CAP + s;
                    o0 = (ok && cnt == 0) ? xr_ : o0; o1 = (ok && cnt == 1) ? xr_ : o1; o2 = (ok && cnt == 2) ? xr_ : o2; o3 = (ok && cnt == 3) ? xr_ : o3; cnt += ok;
                }
                { const float w0 = cnt > 0 ? 1.f : 0.f, w1 = cnt > 1 ? 1.f : 0.f, w2 = cnt > 2 ? 1.f : 0.f, w3 = cnt > 3 ? 1.f : 0.f;
                  o1 = cnt > 1 ? o1 : o0; o2 = cnt > 2 ? o2 : o0; o3 = cnt > 3 ? o3 : o0;
                  const u32x2* p0 = (const u32x2*)(XS + (size_t)o0 * D) + lane; const u32x2* p1 = (const u32x2*)(XS + (size_t)o1 * D) + lane;
                  const u32x2* p2 = (const u32x2*)(XS + (size_t)o2 * D) + lane; const u32x2* p3 = (const u32x2*)(XS + (size_t)o3 * D) + lane;
                  u32x2 y0[8], y1[8], y2[8], y3[8];
#pragma unroll
                  for (int j = 0; j < 8; ++j) { y0[j] = p0[64 * j]; y1[j] = p1[64 * j]; y2[j] = p2[64 * j]; y3[j] = p3[64 * j]; }
#pragma unroll
                  for (int j = 0; j < 8; ++j) {
                      v[j].x += (w0 * bflo(y0[j].x) + w1 * bflo(y1[j].x)) + (w2 * bflo(y2[j].x) + w3 * bflo(y3[j].x)); v[j].y += (w0 * bfhi(y0[j].x) + w1 * bfhi(y1[j].x)) + (w2 * bfhi(y2[j].x) + w3 * bfhi(y3[j].x));
                      v[j].z += (w0 * bflo(y0[j].y) + w1 * bflo(y1[j].y)) + (w2 * bflo(y2[j].y) + w3 * bflo(y3[j].y)); v[j].w += (w0 * bfhi(y0[j].y) + w1 * bfhi(y1[j].y)) + (w2 * bfhi(y2[j].y) + w3 * bfhi(y3[j].y)); } }
                if (cnt > 4) {
                    int seen = 0;
#pragma unroll
                    for (int e = 0; e < NE; ++e) {
                        const int s = __builtin_amdgcn_readfirstlane(sl[e]);
                        if (s >= 0) { if (seen >= 4) { const u32x2* yp = (const u32x2*)(XS + (size_t)(e * XPE + b * CAP + s) * D) + lane;
#pragma unroll
                            for (int j = 0; j < 8; ++j) { const u32x2 w = yp[64 * j]; v[j].x += bflo(w.x); v[j].y += bfhi(w.x); v[j].z += bflo(w.y); v[j].w += bfhi(w.y); } }
                          ++seen; }
                    }
                }
                const float rs = row_rs(v);
                if (layer == 0) {
                    store_row_bf16(hrow, lane, v);
                    if (lane == 0) rsm[row] = rs;
                } else {
                    const f32x4* gp = (const f32x4*)gn + lane; f32x4* op = (f32x4*)(P.out + (size_t)row * D) + lane;
#pragma unroll
                    for (int j = 0; j < 8; ++j) op[64 * j] = v[j] * rs * gp[64 * j];
                }
            }
            if (layer == 0) {
                LAS float* scr = (LAS float*)(ldsl + wave * 16640);
                const size_t lo = (size_t)NE * D * D;
                convert_experts(P.ec_w_gate + lo, P.ec_w_up + lo, P.ec_w_down + lo, P.norm_ffn + D, Wgu, Wd, scr, gw, NGW, lane, 0, G == 256 ? CV_ITEMS - CV_IN1 - CV_OUT - CV_TOPK : CV_ITEMS);
            }
        }
        if (layer == 0) GRID_BAR();
    }
#undef GRID_BAR
}

extern "C" void kernel_launch(void* const* d_in, const int* in_sizes, int n_in, void* d_out, int out_size, void* d_ws, size_t ws_size, hipStream_t stream) {
    static int grid = 0;
    if (grid == 0) {
        if (n_in != 19 || ws_size < WS_END) { fprintf(stderr, "kernel_launch: unexpected n_in %d / ws %zu (need %zu)\n", n_in, ws_size, (size_t)WS_END); grid = -1; return; }
        int dev = 0, cus = 0, per_cu = 0;
        if (hipGetDevice(&dev) != hipSuccess || hipDeviceGetAttribute(&cus, hipDeviceAttributeMultiprocessorCount, dev) != hipSuccess) { grid = -1; return; }
        if (hipFuncSetAttribute((const void*)fwd_kernel, hipFuncAttributeMaxDynamicSharedMemorySize, LDS_BYTES) != hipSuccess) { fprintf(stderr, "kernel_launch: hipFuncSetAttribute failed\n"); grid = -1; return; }
        if (hipOccupancyMaxActiveBlocksPerMultiprocessor(&per_cu, (const void*)fwd_kernel, NTHREADS, LDS_BYTES) != hipSuccess || per_cu < 1) { fprintf(stderr, "kernel_launch: occupancy query reports %d\n", per_cu); }
        (void)hipGetLastError();
        grid = cus;
    }
    if (grid < 0) return;
    if (hipMemsetAsync((char*)d_ws + WS_CTL, 0, CTL_BYTES, stream) != hipSuccess) return;
    Params p{};
    p.x = (const float*)d_in[0]; p.meta = (const float*)d_in[1]; p.norm_mix = (const float*)d_in[2]; p.norm_ffn = (const float*)d_in[3]; p.norm_final = (const float*)d_in[4];
    p.ab_w_in = (const float*)d_in[5]; p.ab_q_norm = (const float*)d_in[6]; p.ab_kv_norm = (const float*)d_in[7]; p.ab_w_uq = (const float*)d_in[8]; p.ab_w_ukv = (const float*)d_in[9];
    p.ab_rpb = (const float*)d_in[10]; p.ab_w_out = (const float*)d_in[11]; p.c_w_in = (const float*)d_in[12]; p.c_sinks = (const float*)d_in[13]; p.c_w_out = (const float*)d_in[14];
    p.ec_w_router = (const float*)d_in[15]; p.ec_w_gate = (const float*)d_in[16]; p.ec_w_up = (const float*)d_in[17]; p.ec_w_down = (const float*)d_in[18];
    p.out = (float*)d_out; p.ws = (unsigned char*)d_ws;
    hipLaunchKernelGGL(fwd_kernel, dim3(grid), dim3(NTHREADS), LDS_BYTES, stream, p);
    const hipError_t le = hipPeekAtLastError();
    if (le != hipSuccess) fprintf(stderr, "kernel_launch: launch failed: %s\n", hipGetErrorName(le));
}
```

```cpp
#include <hip/hip_runtime.h>
#include <cstdio>
#include <cstdint>

#define GAS __attribute__((address_space(1)))
#define LAS __attribute__((address_space(3)))
typedef unsigned short bf16;
typedef short bf16x8 __attribute__((ext_vector_type(8)));
typedef short s16x4 __attribute__((ext_vector_type(4)));
typedef float f32x2 __attribute__((ext_vector_type(2)));
typedef float f32x4 __attribute__((ext_vector_type(4)));
typedef float f32x16 __attribute__((ext_vector_type(16)));
typedef unsigned u32x2 __attribute__((ext_vector_type(2)));
typedef unsigned u32x4 __attribute__((ext_vector_type(4)));

constexpr int D = 2048, NBATCH = 2, SEQ = 16384, NMETA = 16, LTOK = 16400, NTOK = 32800, NR = 33024, RMETA = 32768;
constexpr int ZW = 4352, ZQL = 0, ZKVL = 512, ZNAQ = 1024, ZNAK = 2048, ZNAV = 3072, ZKR = 4096;
constexpr int QW = 1536, KCW = 1536, VMW = 1024, Z1W = 2560, AOW = 2048;
constexpr int NE = 16, CAP = 2050, XPE = 4352, XROWS = NE * XPE;
constexpr float EPS = 1e-6f, LOG2E = 1.4426950408889634f;
constexpr float C_MLA = 0.07216878364870322f * LOG2E, C_NA = 0.08838834764831845f * LOG2E, C_SWA = 0.125f * LOG2E;
constexpr int NWAVES = 8, NTHREADS = 512;

constexpr size_t al256(size_t x) { return (x + 255) & ~(size_t)255; }
constexpr size_t WS_CTL = 0, CTL_BYTES = 1u << 20;
constexpr size_t WS_ROPE = WS_CTL + CTL_BYTES;
constexpr size_t WS_RSQ = al256(WS_ROPE + (size_t)LTOK * 32 * 2 * 4);
constexpr size_t WS_RSKV = al256(WS_RSQ + (size_t)NR * 4);
constexpr size_t WS_AFF = al256(WS_RSKV + (size_t)NR * 4);
constexpr size_t WS_TOKSLOT = al256(WS_AFF + (size_t)32 * LTOK * 4);
constexpr size_t WS_SLOTTOK = al256(WS_TOKSLOT + (size_t)32 * LTOK * 4);
constexpr size_t WS_XGATE = al256(WS_SLOTTOK + (size_t)32 * CAP * 4);
constexpr size_t WS_XMAP = al256(WS_XGATE + (size_t)XROWS * 4);
constexpr size_t WS_PART = al256(WS_XMAP + (size_t)XROWS * 4);
constexpr size_t WS_WIN0 = al256(WS_PART + (size_t)2 * 8 * 8 * 16 * 132 * 4);
constexpr size_t WS_WUQ = al256(WS_WIN0 + (size_t)ZW * D * 2);
constexpr size_t WS_WUKV = al256(WS_WUQ + (size_t)1536 * 512 * 2);
constexpr size_t WS_WOUT0 = al256(WS_WUKV + (size_t)2048 * 512 * 2);
constexpr size_t WS_WIN1 = al256(WS_WOUT0 + (size_t)D * D * 2);
constexpr size_t WS_WOUT1 = al256(WS_WIN1 + (size_t)Z1W * D * 2);
constexpr size_t WS_WGU = al256(WS_WOUT1 + (size_t)D * D * 2);
constexpr size_t WS_WD = al256(WS_WGU + (size_t)NE * 4096 * D * 2);
constexpr size_t WS_H = al256(WS_WD + (size_t)NE * D * D * 2);
constexpr size_t WS_RSF = al256(WS_H + (size_t)NR * D * 2);
constexpr size_t WS_XRS = al256(WS_RSF + (size_t)NR * 4);
constexpr size_t WS_RSM = al256(WS_XRS + (size_t)XROWS * 4);
static_assert(WS_RSM + (size_t)NR * 4 <= WS_H + (size_t)NR * D * 4, "h region");
constexpr size_t WS_U = al256(WS_H + (size_t)NR * D * 4);
constexpr size_t WS_R = al256(WS_U + (size_t)NR * D * 2);
constexpr size_t WS_Z = WS_R;
constexpr size_t WS_Q = al256(WS_Z + (size_t)NR * ZW * 2);
constexpr size_t WS_KC = al256(WS_Q + (size_t)NR * QW * 2);
constexpr size_t WS_VM = al256(WS_KC + (size_t)NR * KCW * 2);
constexpr size_t WS_AO = al256(WS_VM + (size_t)NR * VMW * 2);
constexpr size_t WS_END_ATT = al256(WS_AO + (size_t)NR * AOW * 2);
constexpr size_t WS_XS = WS_R;
constexpr size_t WS_HMID = al256(WS_XS + (size_t)XROWS * D * 2);
constexpr size_t WS_END_MOE = al256(WS_HMID + (size_t)XROWS * D * 2);
constexpr size_t WS_END = WS_END_ATT > WS_END_MOE ? WS_END_ATT : WS_END_MOE;
static_assert(WS_END < (size_t)2000 * 1024 * 1024, "workspace map must fit 2 GiB with margin");

constexpr int CW_BAR = 4096, CW_TICKET = 65536;

constexpr int LDS_BYTES = 147456;
constexpr int MISC_OFF = 147456 - 256;

__device__ __forceinline__ unsigned f2bf(float f) { unsigned u = __builtin_bit_cast(unsigned, f); return (u + 0x7fffu + ((u >> 16) & 1u)) >> 16; }
__device__ __forceinline__ unsigned pk2(float lo, float hi) { return f2bf(lo) | (f2bf(hi) << 16); }
__device__ __forceinline__ float bf2f(unsigned short x) { return __builtin_bit_cast(float, (unsigned)x << 16); }
__device__ __forceinline__ float bflo(unsigned w) { return __builtin_bit_cast(float, w << 16); }
__device__ __forceinline__ float bfhi(unsigned w) { return __builtin_bit_cast(float, w & 0xffff0000u); }
__device__ __forceinline__ float wave_sum(float v) {
#pragma unroll
    for (int o = 1; o < 64; o <<= 1) v += __shfl_xor(v, o);
    return v;
}
#define LDS_WAIT() asm volatile("s_waitcnt lgkmcnt(0)" ::: "memory")

#define XB_TMO      128
#define XB_XCNT(j)  (256  + 64 * (j))
#define XB_XSUB(j)  (1280 + 64 * (j))
#define XB_XGEN(j)  (2304 + 64 * (j))
#define XB_TOP      3328
#define XB_TOPGEN   3392
#define XCD_BAR_WORDS 3456
#define XB_SPIN_CAP (1u << 22)

__device__ __forceinline__ unsigned xb_ld(unsigned* p)              { return __hip_atomic_load(p, __ATOMIC_RELAXED, __HIP_MEMORY_SCOPE_AGENT); }
__device__ __forceinline__ unsigned xb_add(unsigned* p, unsigned v) { return __hip_atomic_fetch_add(p, v, __ATOMIC_RELAXED, __HIP_MEMORY_SCOPE_AGENT); }
__device__ __forceinline__ unsigned xb_xcc_id() { return (unsigned)__builtin_amdgcn_readfirstlane((int)((unsigned)__builtin_amdgcn_s_getreg((3 << 11) | 20) & 0xFu)); }
#define XB_SPIN(cond, bar) do { unsigned _sp = 0; while (cond) { __builtin_amdgcn_s_sleep(1); \
    if ((++_sp & 255u) == 0u) { if (xb_ld(&(bar)[XB_TMO])) break; if (_sp > XB_SPIN_CAP) { atomicAdd(&(bar)[XB_TMO], 1u); break; } } } } while (0)

struct XcdBarrier { unsigned* bar; unsigned x; volatile LAS unsigned* st; };

__device__ __forceinline__ XcdBarrier xcd_barrier_post(unsigned* bar, volatile LAS unsigned* st) {
    XcdBarrier b; b.bar = bar; b.x = xb_xcc_id(); b.st = st;
    if (threadIdx.x == 0) (void)xb_add(&bar[XB_XCNT(b.x)], 1u);
    return b;
}
__device__ __forceinline__ void xcd_barrier_complete(unsigned* bar, unsigned x, unsigned& nloc, unsigned& nx) {
    const unsigned G = gridDim.x * gridDim.y * gridDim.z;
    unsigned sum, cnt, mine, sp = 0u;
    for (;;) {
        sum = 0u; cnt = 0u; mine = 0u;
#pragma unroll
        for (unsigned j = 0; j < 16; ++j) { const unsigned c = xb_ld(&bar[XB_XCNT(j)]); sum += c; cnt += (c > 0u) ? 1u : 0u; mine = (j == x) ? c : mine; }
        if (sum == G) break;
        __builtin_amdgcn_s_sleep(1);
        if ((++sp & 255u) == 0u) { if (xb_ld(&bar[XB_TMO])) break; if (sp > XB_SPIN_CAP) { atomicAdd(&bar[XB_TMO], 1u); break; } }
    }
    nloc = mine > 0u ? mine : 1u; nx = cnt > 0u ? cnt : 1u;
}
__device__ __forceinline__ void xcd_barrier(const XcdBarrier& b) {
    asm volatile("s_waitcnt vmcnt(0)" ::: "memory");
    __syncthreads();
    if (threadIdx.x == 0) {
        unsigned* bar = b.bar; asm volatile("" : "+s"(bar));
        __builtin_amdgcn_s_waitcnt(0);
        const unsigned bx_ = xb_xcc_id();
        unsigned nloc = b.st[0], nx = b.st[1];
        if (nloc == 0u) { xcd_barrier_complete(bar, bx_, nloc, nx); b.st[0] = nloc; b.st[1] = nx; }
        const unsigned old = xb_add(&bar[XB_XSUB(bx_)], 1u);
        const unsigned gen = old / nloc;
        if (old + 1u == (gen + 1u) * nloc) {
            __builtin_amdgcn_fence(__ATOMIC_RELEASE, "agent");
            asm volatile("s_waitcnt vmcnt(0)" ::: "memory");
            const unsigned og = xb_add(&bar[XB_TOP], 1u);
            const unsigned tg = og / nx;
            if (og + 1u == (tg + 1u) * nx) xb_add(&bar[XB_TOPGEN], 1u);
            else XB_SPIN(xb_ld(&bar[XB_TOPGEN]) == tg, bar);
            __builtin_amdgcn_fence(__ATOMIC_ACQUIRE, "agent");
            xb_add(&bar[XB_XGEN(bx_)], 1u);
            asm volatile("s_waitcnt vmcnt(0)" ::: "memory");
        } else {
            XB_SPIN(xb_ld(&bar[XB_XGEN(bx_)]) == gen, bar);
            __builtin_amdgcn_fence(__ATOMIC_ACQUIRE, "agent");
            asm volatile("s_waitcnt vmcnt(0)" ::: "memory");
        }
    }
    __syncthreads();
}

namespace pg8 {
constexpr int BM = 256, BK = 64, HALF = 128, HTB = HALF * BK * 2, STAGE_BYTES = 8 * HTB, NXCD = 8, WGM = 8;
__host__ __device__ __forceinline__ int lds_byte(int r, int c) { const int st = (r >> 4) * 2 + (c >> 5), rr = r & 15, cc = c & 31, ob = rr * 64 + cc * 2; return st * 1024 + (ob ^ (((ob >> 9) & 1) << 5)); }
__host__ __device__ __forceinline__ void stage_rc(int b, int& R, int& C) { const int st = b / 1024, sb = b % 1024, swz = sb ^ (((sb >> 9) & 1) << 5); R = (st >> 1) * 16 + swz / 64; C = (st & 1) * 32 + (swz % 64) / 2; }
__host__ __device__ __forceinline__ int perm32(int rho) { const int n = rho >> 4, i = rho & 15; return 8 * (i >> 2) + 4 * n + (i & 3); }

struct Unit { int pm, pn, pb; };
struct Gemm { const bf16* A; const bf16* Bt; int lda, ldb, K; const int* amap; };

struct TileOrder {
    int nM, nN, nwg, G, c, grp;
    __device__ void init(int nM_, int nN_, int G_, int c_, int grp_) { nM = nM_; nN = nN_; nwg = nM * nN; G = G_; c = c_; grp = grp_; }
    __device__ bool next(int i, Unit& u) const {
        const long L = (long)i * G + c; if (L >= nwg) return false;
        int wgid = (int)L; { const int q = nwg / NXCD, r = nwg % NXCD, xcd = wgid % NXCD, off = wgid / NXCD; wgid = (xcd < r ? xcd * (q + 1) : r * (q + 1) + (xcd - r) * q) + off; }
        const int nig = WGM * nN, gid = wgid / nig, fm = gid * WGM, gsz = (nM - fm) < WGM ? (nM - fm) : WGM;
        u.pm = fm + ((wgid % nig) % gsz); u.pn = (wgid % nig) / gsz; u.pb = grp ? (u.pm / grp) * nN + u.pn : u.pn; return true;
    }
};

__device__ __forceinline__ unsigned cvt_pk_bf16(float lo, float hi) { unsigned r; asm volatile("v_cvt_pk_bf16_f32 %0, %1, %2" : "=v"(r) : "v"(lo), "v"(hi)); return r; }

struct EpiBf16S {
    static constexpr bool PERM = true;
    bf16* O; int ldc; const float* rowscale; int cs_lo, cs_hi; float cscale;
    __device__ __forceinline__ void operator()(const f32x4 (&acc)[2][2][4][2], const Unit& u, int wr, int wc, int fr, int fq) const {
        const int row0 = u.pm * BM + wr * 64 + fr, col0 = u.pn * BM + wc * 32 + 8 * fq;
        const float cs = (u.pn >= cs_lo && u.pn < cs_hi) ? cscale : 1.f;
#pragma unroll
        for (int ai = 0; ai < 2; ++ai)
#pragma unroll
            for (int m = 0; m < 4; ++m) { const int row = row0 + ai * HALF + m * 16; const float s = (rowscale ? rowscale[row] : 1.f) * cs; bf16* rowp = O + (size_t)row * ldc + col0;
#pragma unroll
                for (int bj = 0; bj < 2; ++bj) { const f32x4 v0 = acc[ai][bj][m][0] * s, v1 = acc[ai][bj][m][1] * s;
                    u32x4 w; w.x = cvt_pk_bf16(v0[0], v0[1]); w.y = cvt_pk_bf16(v0[2], v0[3]); w.z = cvt_pk_bf16(v1[0], v1[1]); w.w = cvt_pk_bf16(v1[2], v1[3]);
                    *(u32x4*)(rowp + bj * HALF) = w; } }
    }
};
struct EpiKV {
    static constexpr bool PERM = true;
    bf16* Kc; bf16* Vm; const float* rowscale;
    __device__ __forceinline__ void operator()(const f32x4 (&acc)[2][2][4][2], const Unit& u, int wr, int wc, int fr, int fq) const {
        const int row0 = u.pm * BM + wr * 64 + fr, cc = wc * 32 + 8 * fq;
#pragma unroll
        for (int ai = 0; ai < 2; ++ai)
#pragma unroll
            for (int m = 0; m < 4; ++m) { const int row = row0 + ai * HALF + m * 16; const float s = rowscale[row];
#pragma unroll
                for (int bj = 0; bj < 2; ++bj) { const f32x4 v0 = acc[ai][bj][m][0] * s, v1 = acc[ai][bj][m][1] * s;
                    u32x4 w; w.x = cvt_pk_bf16(v0[0], v0[1]); w.y = cvt_pk_bf16(v0[2], v0[3]); w.z = cvt_pk_bf16(v1[0], v1[1]); w.w = cvt_pk_bf16(v1[2], v1[3]);
                    bf16* p = bj == 0 ? Kc + (size_t)row * KCW + u.pn * 192 + cc : Vm + (size_t)row * VMW + u.pn * 128 + cc;
                    *(u32x4*)p = w; } }
    }
};
struct EpiResid {
    static constexpr bool PERM = true;
    bf16* Hm; int ldc; const float* X; const float* Mt;
    __device__ __forceinline__ void operator()(const f32x4 (&acc)[2][2][4][2], const Unit& u, int wr, int wc, int fr, int fq) const {
        const int row0 = u.pm * BM + wr * 64 + fr, col0 = u.pn * BM + wc * 32 + 8 * fq;
#pragma unroll
        for (int ai = 0; ai < 2; ++ai)
#pragma unroll
            for (int m = 0; m < 4; ++m) { const int row = row0 + ai * HALF + m * 16; bf16* rowp = Hm + (size_t)row * ldc + col0;
                if (X) {
                    const float* sp = (row < RMETA ? X + (size_t)row * ldc : Mt + (size_t)((row - RMETA) & 15) * ldc) + col0; const float z = row < NTOK ? 1.f : 0.f;
#pragma unroll
                    for (int bj = 0; bj < 2; ++bj) { const f32x4 v0 = *(const f32x4*)(sp + bj * HALF) * z + acc[ai][bj][m][0], v1 = *(const f32x4*)(sp + bj * HALF + 4) * z + acc[ai][bj][m][1];
                        u32x4 w; w.x = cvt_pk_bf16(v0[0], v0[1]); w.y = cvt_pk_bf16(v0[2], v0[3]); w.z = cvt_pk_bf16(v1[0], v1[1]); w.w = cvt_pk_bf16(v1[2], v1[3]);
                        *(u32x4*)(rowp + bj * HALF) = w; }
                } else {
#pragma unroll
                    for (int bj = 0; bj < 2; ++bj) { const u32x4 s = *(const u32x4*)(rowp + bj * HALF);
                        const f32x4 v0 = (f32x4){bflo(s.x), bfhi(s.x), bflo(s.y), bfhi(s.y)} + acc[ai][bj][m][0], v1 = (f32x4){bflo(s.z), bfhi(s.z), bflo(s.w), bfhi(s.w)} + acc[ai][bj][m][1];
                        u32x4 w; w.x = cvt_pk_bf16(v0[0], v0[1]); w.y = cvt_pk_bf16(v0[2], v0[3]); w.z = cvt_pk_bf16(v1[0], v1[1]); w.w = cvt_pk_bf16(v1[2], v1[3]);
                        *(u32x4*)(rowp + bj * HALF) = w; }
                }
            }
    }
};
struct EpiSwiGLU {
    static constexpr bool PERM = true;
    bf16* O; int ldc; const float* rowscale;
    __device__ __forceinline__ void operator()(const f32x4 (&acc)[2][2][4][2], const Unit& u, int wr, int wc, int fr, int fq) const {
        const int row0 = u.pm * BM + wr * 64 + fr, col0 = u.pn * HALF + wc * 32 + 8 * fq;
#pragma unroll
        for (int ai = 0; ai < 2; ++ai)
#pragma unroll
            for (int m = 0; m < 4; ++m) { const int row = row0 + ai * HALF + m * 16; bf16* rowp = O + (size_t)row * ldc + col0; float r[8]; const float rs = rowscale[row];
#pragma unroll
                for (int n = 0; n < 2; ++n)
#pragma unroll
                    for (int j = 0; j < 4; ++j) { const float g = acc[ai][0][m][n][j] * rs, up = acc[ai][1][m][n][j] * rs;
                        const float sg = g * __builtin_amdgcn_rcpf(1.f + __builtin_amdgcn_exp2f(-g * LOG2E)); r[n * 4 + j] = sg * up; }
                u32x4 w; w.x = cvt_pk_bf16(r[0], r[1]); w.y = cvt_pk_bf16(r[2], r[3]); w.z = cvt_pk_bf16(r[4], r[5]); w.w = cvt_pk_bf16(r[6], r[7]);
                *(u32x4*)rowp = w; }
    }
};

template <bool GATHER = false, class Epi, class Sched>
__device__ __forceinline__ void gemm_phase(LAS unsigned char* lds, const Gemm g, const Sched& S, const Epi& E) {
    int tid_ = threadIdx.x; asm volatile("" : "+v"(tid_));
    const int tid = tid_, wid = __builtin_amdgcn_readfirstlane(tid >> 6), lane = tid & 63, wr = wid >> 2, wc = wid & 3, fr = lane & 15, fq = lane >> 4;
    const int K = g.K, nt = K / BK;
    unsigned voffA[2], voffB[2];
#pragma unroll
    for (int i = 0; i < 2; ++i) { int R, C; stage_rc(tid * 16 + i * 8192, R, C); const int Rb = Epi::PERM ? ((R & ~31) + perm32(R & 31)) : R;
        voffA[i] = (unsigned)(R * g.lda + C) * 2u; voffB[i] = (unsigned)(Rb * g.ldb + C) * 2u; }
    int RA[2], CA[2];
#pragma unroll
    for (int i = 0; i < 2; ++i) stage_rc(tid * 16 + i * 8192, RA[i], CA[i]);
    unsigned offC[2][2], offN[2][2]; int rawN[2][2];
#define PG8_GRAW(pm_) do { _Pragma("unroll") for (int h_ = 0; h_ < 2; ++h_) _Pragma("unroll") for (int i_ = 0; i_ < 2; ++i_) rawN[h_][i_] = g.amap[(pm_) * BM + h_ * HALF + RA[i_]]; } while (0)
#define PG8_GCONV(dst) do { _Pragma("unroll") for (int h_ = 0; h_ < 2; ++h_) _Pragma("unroll") for (int i_ = 0; i_ < 2; ++i_) dst[h_][i_] = (unsigned)(rawN[h_][i_] * g.lda + CA[i_]) * 2u; } while (0)
    const size_t kstep = (size_t)(BK * 2);
    const size_t hstepA = (size_t)HALF * g.lda * 2, hstepB = (size_t)HALF * g.ldb * 2;
    const size_t tstepA = 2 * hstepA, tstepB = 2 * hstepB;
    const unsigned ldsw = (unsigned)wid * 1024u;
    const int aoff = lds_byte(wr * 64 + fr, fq * 8), boff = lds_byte(wc * 32 + fr, fq * 8);
#define PG8_SA(b, h) (((b) * 2 + (h)) * HTB)
#define PG8_SB(b, h) ((4 + (b) * 2 + (h)) * HTB)
#define PG8_STAGE(bufoff, gbase, voff) do { _Pragma("unroll") for (int _i = 0; _i < 2; ++_i) \
        __builtin_amdgcn_global_load_lds((const unsigned*)((const char*)(gbase) + (voff)[_i]), (LAS unsigned*)(lds + (bufoff) + ldsw + _i * 8192), 16, 0, 0); } while (0)
#define PG8_LDA(dst, b, h) do { _Pragma("unroll") for (int m = 0; m < 4; ++m) _Pragma("unroll") for (int k = 0; k < 2; ++k) dst[m][k] = *(const LAS bf16x8*)(lds + PG8_SA(b, h) + aoff + m * 2048 + k * 1024); } while (0)
#define PG8_LDB(dst, b, h) do { _Pragma("unroll") for (int n = 0; n < 2; ++n) _Pragma("unroll") for (int k = 0; k < 2; ++k) dst[n][k] = *(const LAS bf16x8*)(lds + PG8_SB(b, h) + boff + n * 2048 + k * 1024); } while (0)
#define PG8_MMA(ai, bj, At, Bt) do { __builtin_amdgcn_s_setprio(1); _Pragma("unroll") for (int m = 0; m < 4; ++m) _Pragma("unroll") for (int n = 0; n < 2; ++n) _Pragma("unroll") for (int k = 0; k < 2; ++k) \
        acc[ai][bj][m][n] = __builtin_amdgcn_mfma_f32_16x16x32_bf16(Bt[n][k], At[m][k], acc[ai][bj][m][n], 0, 0, 0); __builtin_amdgcn_s_setprio(0); } while (0)
#define PG8_WAIT_V(n) asm volatile("s_waitcnt vmcnt(" #n ")" ::: "memory")
#define PG8_WAIT_L(n) asm volatile("s_waitcnt lgkmcnt(" #n ")" ::: "memory")
#define PG8_BAR __builtin_amdgcn_s_barrier()
#define PG8_SCHED __builtin_amdgcn_sched_barrier(0)
    Unit cur, nxt; int ui = 0;
    if (!S.next(0, cur)) return;
    f32x4 acc[2][2][4][2];
#pragma unroll
    for (int a = 0; a < 2; ++a)
#pragma unroll
        for (int b = 0; b < 2; ++b)
#pragma unroll
            for (int m = 0; m < 4; ++m)
#pragma unroll
                for (int n = 0; n < 2; ++n) acc[a][b][m][n] = (f32x4){0.f, 0.f, 0.f, 0.f};
    bf16x8 At[4][2], B0[2][2], B1[2][2];
    const char* cA = GATHER ? (const char*)g.A : (const char*)g.A + (size_t)cur.pm * tstepA; const char* cB = (const char*)g.Bt + (size_t)cur.pb * tstepB;
    if constexpr (GATHER) { PG8_GRAW(cur.pm); PG8_GCONV(offC); }
#define PG8_STAGE_A(bufoff, kbase, h_, offs) do { if constexpr (GATHER) { PG8_STAGE(bufoff, kbase, offs[h_]); } else { PG8_STAGE(bufoff, (kbase) + (h_) * hstepA, voffA); } } while (0)
    PG8_STAGE(PG8_SB(0, 0), cB, voffB); PG8_STAGE(PG8_SB(0, 1), cB + hstepB, voffB); PG8_STAGE_A(PG8_SA(0, 0), cA, 0, offC); PG8_STAGE_A(PG8_SA(0, 1), cA, 1, offC);
    if (wr == 1) PG8_BAR;
    PG8_WAIT_V(2); PG8_BAR;
    PG8_STAGE(PG8_SB(1, 0), cB + kstep, voffB); PG8_STAGE_A(PG8_SA(1, 0), cA + kstep, 0, offC); PG8_STAGE(PG8_SB(1, 1), cB + hstepB + kstep, voffB);
    PG8_WAIT_V(6); PG8_BAR;
    for (;;) {
        const bool has_next = S.next(ui + 1, nxt);
        const char* nA = GATHER ? cA : (has_next ? (const char*)g.A + (size_t)nxt.pm * tstepA : cA); const char* nB = has_next ? (const char*)g.Bt + (size_t)nxt.pb * tstepB : cB;
        if constexpr (GATHER) { if (has_next) PG8_GRAW(nxt.pm); }
        for (int t = 0; t < nt; t += 2) {
            const bool last = (t == nt - 2);
            const char* a1 = cA + (size_t)(t + 1) * kstep;
            const char* a2 = last ? nA : cA + (size_t)(t + 2) * kstep; const char* b2 = last ? nB : cB + (size_t)(t + 2) * kstep;
            unsigned off2[2][2];
            if constexpr (GATHER) { if (last && has_next) { PG8_GCONV(offN); } else if (last) { _Pragma("unroll") for (int h_ = 0; h_ < 2; ++h_) _Pragma("unroll") for (int i_ = 0; i_ < 2; ++i_) offN[h_][i_] = offC[h_][i_]; }
                _Pragma("unroll") for (int h_ = 0; h_ < 2; ++h_) _Pragma("unroll") for (int i_ = 0; i_ < 2; ++i_) off2[h_][i_] = last ? offN[h_][i_] : offC[h_][i_]; }
            const char* a3 = a2 + kstep; const char* b3 = b2 + kstep;
            PG8_LDB(B0, 0, 0); PG8_LDB(B1, 0, 1); PG8_SCHED; PG8_LDA(At, 0, 0); PG8_STAGE_A(PG8_SA(1, 1), a1, 1, offC);
            PG8_WAIT_V(8); PG8_WAIT_L(0); PG8_BAR; PG8_MMA(0, 0, At, B0); PG8_MMA(0, 1, At, B1); PG8_BAR; PG8_SCHED;
            PG8_LDA(At, 0, 1); PG8_STAGE(PG8_SB(0, 0), b2, voffB); PG8_STAGE(PG8_SB(0, 1), b2 + hstepB, voffB); PG8_STAGE_A(PG8_SA(0, 0), a2, 0, off2);
            PG8_WAIT_V(8); PG8_WAIT_L(0); PG8_BAR; PG8_MMA(1, 0, At, B0); PG8_MMA(1, 1, At, B1); PG8_BAR; PG8_SCHED;
            PG8_LDB(B0, 1, 0); PG8_LDB(B1, 1, 1); PG8_SCHED; PG8_LDA(At, 1, 0); PG8_STAGE_A(PG8_SA(0, 1), a2, 1, off2);
            PG8_WAIT_V(8); PG8_WAIT_L(0); PG8_BAR; PG8_MMA(0, 0, At, B0); PG8_MMA(0, 1, At, B1); PG8_BAR; PG8_SCHED;
            PG8_LDA(At, 1, 1); PG8_STAGE(PG8_SB(1, 0), b3, voffB); PG8_STAGE(PG8_SB(1, 1), b3 + hstepB, voffB); PG8_STAGE_A(PG8_SA(1, 0), a3, 0, off2);
            PG8_WAIT_V(8); PG8_WAIT_L(0); PG8_BAR; PG8_MMA(1, 0, At, B0); PG8_MMA(1, 1, At, B1); PG8_BAR; PG8_SCHED;
        }
        if (wr == 0) PG8_BAR;
        E(acc, cur, wr, wc, fr, fq);
        if (!has_next) break;
#pragma unroll
        for (int a = 0; a < 2; ++a)
#pragma unroll
            for (int b = 0; b < 2; ++b)
#pragma unroll
                for (int m = 0; m < 4; ++m)
#pragma unroll
                    for (int n = 0; n < 2; ++n) acc[a][b][m][n] = (f32x4){0.f, 0.f, 0.f, 0.f};
        cur = nxt; cA = nA; cB = nB; ++ui;
        if constexpr (GATHER) { _Pragma("unroll") for (int h_ = 0; h_ < 2; ++h_) _Pragma("unroll") for (int i_ = 0; i_ < 2; ++i_) offC[h_][i_] = offN[h_][i_]; }
        if (wr == 1) PG8_BAR;
    }
    PG8_WAIT_V(0);
    PG8_BAR;
#undef PG8_SA
#undef PG8_SB
#undef PG8_STAGE
#undef PG8_STAGE_A
#undef PG8_GRAW
#undef PG8_GCONV
#undef PG8_LDA
#undef PG8_LDB
#undef PG8_MMA
#undef PG8_WAIT_V
#undef PG8_WAIT_L
#undef PG8_BAR
#undef PG8_SCHED
}
}

namespace att {
#define SBAR() __builtin_amdgcn_sched_barrier(0)
constexpr float NEGBIG = -1e30f, THR = 8.f;
__device__ __forceinline__ int crow(int r, int hi) { return (r & 3) + 8 * (r >> 2) + 4 * hi; }
typedef __bf16 bf16x2_t __attribute__((ext_vector_type(2)));
__device__ __forceinline__ unsigned cvtpk(float lo, float hi) { f32x2 v = {lo, hi}; bf16x2_t b = __builtin_convertvector(v, bf16x2_t); return __builtin_bit_cast(unsigned, b); }

__device__ __forceinline__ void partialSM(f32x16& p0, f32x16& p1, float& m_reg, float& alpha) {
    float pmax = p0[0];
#pragma unroll
    for (int r = 1; r < 16; ++r) pmax = fmaxf(pmax, p0[r]);
#pragma unroll
    for (int r = 0; r < 16; ++r) pmax = fmaxf(pmax, p1[r]);
    { auto rr = __builtin_amdgcn_permlane32_swap(__float_as_uint(pmax), __float_as_uint(pmax), false, false);
      pmax = fmaxf(__uint_as_float(rr[0]), __uint_as_float(rr[1])); }
    float mn;
    if (__builtin_expect(__all(pmax - m_reg <= THR), 1)) { mn = m_reg; alpha = 1.f; }
    else { mn = fmaxf(m_reg, pmax); alpha = __builtin_amdgcn_exp2f(m_reg - mn); m_reg = mn; }
#pragma unroll
    for (int r = 0; r < 16; ++r) { p0[r] = p0[r] - mn; p1[r] = p1[r] - mn; }
#pragma unroll
    for (int r = 0; r < 16; ++r) p0[r] = __builtin_amdgcn_exp2f(p0[r]);
}
__device__ __forceinline__ void finishSM(f32x16& p0, f32x16& p1, float alpha, float& l_reg, bf16x8& pa0, bf16x8& pa1, bf16x8& pa2, bf16x8& pa3) {
#pragma unroll
    for (int r = 0; r < 16; ++r) p1[r] = __builtin_amdgcn_exp2f(p1[r]);
    float ps = 0;
#pragma unroll
    for (int r = 0; r < 16; ++r) ps += p0[r];
#pragma unroll
    for (int r = 0; r < 16; ++r) ps += p1[r];
    { auto rr = __builtin_amdgcn_permlane32_swap(__float_as_uint(ps), __float_as_uint(ps), false, false);
      ps = __uint_as_float(rr[0]) + __uint_as_float(rr[1]); }
    l_reg = l_reg * alpha + ps;
#define PK4(P, BASE, OUT) do { unsigned a0 = cvtpk(P[BASE + 0], P[BASE + 1]), a1 = cvtpk(P[BASE + 2], P[BASE + 3]);   \
    unsigned b0 = cvtpk(P[BASE + 4], P[BASE + 5]), b1 = cvtpk(P[BASE + 6], P[BASE + 7]);                              \
    auto r0 = __builtin_amdgcn_permlane32_swap(a0, b0, false, false); auto r1 = __builtin_amdgcn_permlane32_swap(a1, b1, false, false); \
    u32x4 w = {r0[0], r1[0], r0[1], r1[1]}; OUT = __builtin_bit_cast(bf16x8, w); } while (0)
    PK4(p0, 0, pa0); PK4(p0, 8, pa1); PK4(p1, 0, pa2); PK4(p1, 8, pa3);
#undef PK4
}
template <int NQC>
__device__ __forceinline__ void qkt(f32x16& p0, f32x16& p1, const char* Ks, const bf16x8* qr, int r32, int hi) {
    p0 = f32x16{}; p1 = f32x16{};
#pragma unroll
    for (int d0 = 0; d0 < NQC; ++d0) { const int c = 2 * d0 + hi; const int a = c * 1024 + ((r32 ^ (c & 7)) << 4);
        const bf16x8 b0 = *reinterpret_cast<const bf16x8*>(Ks + a);
        const bf16x8 b1 = *reinterpret_cast<const bf16x8*>(Ks + a + 512);
        p0 = __builtin_amdgcn_mfma_f32_32x32x16_bf16(b0, qr[d0], p0, 0, 0, 0);
        p1 = __builtin_amdgcn_mfma_f32_32x32x16_bf16(b1, qr[d0], p1, 0, 0, 0); }
}
template <int NDB> __device__ __forceinline__ int v_st(int k, int c) { const int kk = (k & ~0xC) | ((k & 4) << 1) | ((k & 8) >> 1); return ((kk >> 3) * NDB + (c >> 5)) * 512 + ((kk & 7) * 32 + (c & 31)) * 2; }
__device__ __forceinline__ int v_rd_base(int lane) { return ((lane & 3) << 3) | (((lane >> 2) & 3) << 6) | (((lane >> 4) & 1) << 5) | (((lane >> 5) & 1) << 8); }
template <int NDB> constexpr int v_rd_off(int d0, int ks, int half) { return d0 * 512 + ks * (NDB * 1024) + half * (NDB * 512); }
template <int OFF> __device__ __forceinline__ s16x4 tr_read(int vb) { s16x4 r; asm volatile("ds_read_b64_tr_b16 %0, %1 offset:%2" : "=&v"(r) : "v"(vb), "i"(OFF) : "memory"); return r; }
template <int D0, int NDB> __device__ __forceinline__ void pv_one(f32x16& od, int vb, bf16x8 pa0, bf16x8 pa1, bf16x8 pa2, bf16x8 pa3) {
    const s16x4 l0 = tr_read<v_rd_off<NDB>(D0, 0, 0)>(vb), h0 = tr_read<v_rd_off<NDB>(D0, 0, 1)>(vb), l1 = tr_read<v_rd_off<NDB>(D0, 1, 0)>(vb), h1 = tr_read<v_rd_off<NDB>(D0, 1, 1)>(vb);
    const s16x4 l2 = tr_read<v_rd_off<NDB>(D0, 2, 0)>(vb), h2 = tr_read<v_rd_off<NDB>(D0, 2, 1)>(vb), l3 = tr_read<v_rd_off<NDB>(D0, 3, 0)>(vb), h3 = tr_read<v_rd_off<NDB>(D0, 3, 1)>(vb);
    asm volatile("s_waitcnt lgkmcnt(0)" ::: "memory"); SBAR();
#define PK(L, H) (bf16x8){L[0], L[1], L[2], L[3], H[0], H[1], H[2], H[3]}
    od = __builtin_amdgcn_mfma_f32_32x32x16_bf16(pa0, PK(l0, h0), od, 0, 0, 0);
    od = __builtin_amdgcn_mfma_f32_32x32x16_bf16(pa1, PK(l1, h1), od, 0, 0, 0);
    od = __builtin_amdgcn_mfma_f32_32x32x16_bf16(pa2, PK(l2, h2), od, 0, 0, 0);
    od = __builtin_amdgcn_mfma_f32_32x32x16_bf16(pa3, PK(l3, h3), od, 0, 0, 0);
#undef PK
}
template <int NDB> __device__ __forceinline__ void pv_all(f32x16* o, int vb, bf16x8 pa0, bf16x8 pa1, bf16x8 pa2, bf16x8 pa3) {
    pv_one<0, NDB>(o[0], vb, pa0, pa1, pa2, pa3); pv_one<1, NDB>(o[1], vb, pa0, pa1, pa2, pa3);
    if constexpr (NDB == 4) { pv_one<2, NDB>(o[2], vb, pa0, pa1, pa2, pa3); pv_one<3, NDB>(o[3], vb, pa0, pa1, pa2, pa3); }
}
__device__ __forceinline__ void mask_meta(f32x16& p0, f32x16& p1) {
#pragma unroll
    for (int r = 8; r < 16; ++r) p0[r] = NEGBIG;
#pragma unroll
    for (int r = 0; r < 16; ++r) p1[r] = NEGBIG;
}
__device__ __forceinline__ void mask_all(f32x16& p0, f32x16& p1) {
#pragma unroll
    for (int r = 0; r < 16; ++r) { p0[r] = NEGBIG; p1[r] = NEGBIG; }
}

template <int DQK, int DV, class P>
__device__ __forceinline__ void attn_unit(const P& pol, char* lds) {
    constexpr int NQC = DQK / 16, NDB = DV / 32, KB = 64 * DQK * 2, VB = 64 * DV * 2;
    constexpr int KCH = DQK / 8, VCH = DV / 8, NKS = (64 * KCH) / 512, NVS = (64 * VCH) / 512;
    int tid_ = threadIdx.x; asm volatile("" : "+v"(tid_));
    const int tid = tid_, wid = tid >> 6, lane = tid & 63, r32 = lane & 31, hi = lane >> 5;
    char* V_lds = lds; char* K_lds = lds + 3 * VB;
    float* ws = (float*)(lds + 3 * VB + 3 * KB) + wid * 64; float* li_l = ws; float* al_l = ws + 32;
    float m_reg = NEGBIG, l_reg = 0.f; f32x16 o[NDB];
#pragma unroll
    for (int d = 0; d < NDB; ++d) o[d] = f32x16{};
    bf16x8 qr[NQC];
    { const bf16* Qw = pol.qptr(wid * 32 + r32) + hi * 8;
#pragma unroll
      for (int d0 = 0; d0 < NQC; ++d0) qr[d0] = *reinterpret_cast<const bf16x8*>(Qw + d0 * 16); }
    pol.qfix(qr, wid * 32 + r32, hi);
    const int vb0 = (int)(uintptr_t)V_lds + v_rd_base(lane);
    bf16x8 ks[NKS], vs[NVS];
    const int srow = tid >> 3, c0 = tid & 7;
    const unsigned koff = (unsigned)(srow * pol.kstride + c0 * 8) * 2u, voff = (unsigned)(srow * pol.vstride + c0 * 8) * 2u;
    const int kst = c0 * 1024 + ((srow ^ c0) << 4), vst = v_st<NDB>(srow, c0 * 8);
    static_assert(NKS == KCH / 8 && NVS == VCH / 8, "staging map");
#define SLOAD(t) do { const char* kb_ = (const char*)pol.kbase(t) + koff; const char* vb_ = (const char*)pol.vbase(t) + voff; \
    _Pragma("unroll") for (int i = 0; i < NKS; ++i) ks[i] = *reinterpret_cast<const bf16x8*>(kb_ + i * 128); \
    _Pragma("unroll") for (int i = 0; i < NVS; ++i) vs[i] = *reinterpret_cast<const bf16x8*>(vb_ + i * 128); } while (0)
#define SWRITE(b) do { \
    _Pragma("unroll") for (int i = 0; i < NKS; ++i) *reinterpret_cast<bf16x8*>(K_lds + (b) * KB + kst + i * 8192) = ks[i]; \
    _Pragma("unroll") for (int i = 0; i < NVS; ++i) *reinterpret_cast<bf16x8*>(V_lds + (b) * VB + vst + i * 1024) = vs[i]; } while (0)
#define RESC(a) do { if (__any((a) < 1.f)) { if (hi == 0) al_l[r32] = (a); asm volatile("s_waitcnt lgkmcnt(0)" ::: "memory"); \
    _Pragma("unroll") for (int d = 0; d < NDB; ++d) _Pragma("unroll") for (int r = 0; r < 16; ++r) o[d][r] *= al_l[crow(r, hi)]; } } while (0)
#define XFORM(pa_, pb_, t) do { if (pol.needs_xform(t)) pol.xform(pa_, pb_, (t), wid, r32, hi); } while (0)
    f32x16 pA0, pA1, pB0, pB1; float alA, alB; bf16x8 pa0, pa1, pa2, pa3; const int NT = pol.nt;
    if constexpr (DQK <= 128) {
        bf16x8 ks2[NKS], vs2[NVS];
        SLOAD(0);
        { const char* kb_ = (const char*)pol.kbase(1) + koff; const char* vb_ = (const char*)pol.vbase(1) + voff;
#pragma unroll
          for (int i = 0; i < NKS; ++i) ks2[i] = *reinterpret_cast<const bf16x8*>(kb_ + i * 128);
#pragma unroll
          for (int i = 0; i < NVS; ++i) vs2[i] = *reinterpret_cast<const bf16x8*>(vb_ + i * 128); }
        asm volatile("s_waitcnt vmcnt(0)" ::: "memory"); SWRITE(0);
#pragma unroll
        for (int i = 0; i < NKS; ++i) *reinterpret_cast<bf16x8*>(K_lds + KB + kst + i * 8192) = ks2[i];
#pragma unroll
        for (int i = 0; i < NVS; ++i) *reinterpret_cast<bf16x8*>(V_lds + VB + vst + i * 1024) = vs2[i];
        __syncthreads();
        qkt<NQC>(pA0, pA1, K_lds, qr, r32, hi); XFORM(pA0, pA1, 0); partialSM(pA0, pA1, m_reg, alA);
    } else {
    SLOAD(0); asm volatile("s_waitcnt vmcnt(0)" ::: "memory"); SWRITE(0); __syncthreads();
    qkt<NQC>(pA0, pA1, K_lds, qr, r32, hi); XFORM(pA0, pA1, 0); partialSM(pA0, pA1, m_reg, alA);
    SLOAD(1); asm volatile("s_waitcnt vmcnt(0)" ::: "memory"); SWRITE(1); __syncthreads();
    }
    int bprev = 0, bcur = 1, bnext = 2;
#define ROT3() do { bprev = bcur; bcur = bnext; bnext = (bnext == 2) ? 0 : bnext + 1; } while (0)
    for (int j = 1; j + 1 < NT; j += 2) {
        SBAR(); qkt<NQC>(pB0, pB1, K_lds + bcur * KB, qr, r32, hi);
        finishSM(pA0, pA1, alA, l_reg, pa0, pa1, pa2, pa3); SBAR();
        SLOAD(j + 1); SBAR();
        pv_all<NDB>(o, vb0 + bprev * VB, pa0, pa1, pa2, pa3); XFORM(pB0, pB1, j); partialSM(pB0, pB1, m_reg, alB);
        asm volatile("s_waitcnt vmcnt(0)" ::: "memory"); SWRITE(bnext);
        RESC(alB); __syncthreads(); ROT3();
        SBAR(); qkt<NQC>(pA0, pA1, K_lds + bcur * KB, qr, r32, hi);
        finishSM(pB0, pB1, alB, l_reg, pa0, pa1, pa2, pa3); SBAR();
        SLOAD(j + 2); SBAR();
        pv_all<NDB>(o, vb0 + bprev * VB, pa0, pa1, pa2, pa3); XFORM(pA0, pA1, j + 1); partialSM(pA0, pA1, m_reg, alA);
        asm volatile("s_waitcnt vmcnt(0)" ::: "memory"); SWRITE(bnext);
        RESC(alA); __syncthreads(); ROT3();
    }
    SBAR(); qkt<NQC>(pB0, pB1, K_lds + bcur * KB, qr, r32, hi);
    finishSM(pA0, pA1, alA, l_reg, pa0, pa1, pa2, pa3); SBAR();
    pv_all<NDB>(o, vb0 + bprev * VB, pa0, pa1, pa2, pa3); XFORM(pB0, pB1, NT - 1); partialSM(pB0, pB1, m_reg, alB);
    RESC(alB);
    finishSM(pB0, pB1, alB, l_reg, pa0, pa1, pa2, pa3); SBAR();
    pv_all<NDB>(o, vb0 + bcur * VB, pa0, pa1, pa2, pa3);
#undef ROT3
    l_reg += pol.sink_term(m_reg);
    if (pol.partial()) {
        if (wid == 0) {
            if (lane < 16) { float* pp = pol.pptr(lane); pp[128] = m_reg; pp[129] = l_reg; }
#pragma unroll
            for (int r = 0; r < 8; ++r) { float* pp = pol.pptr(crow(r, hi));
#pragma unroll
                for (int d0 = 0; d0 < NDB; ++d0) pp[d0 * 32 + r32] = o[d0][r]; }
        }
    } else {
    if (hi == 0) li_l[r32] = l_reg; asm volatile("s_waitcnt lgkmcnt(0)" ::: "memory");
    float rli[16];
#pragma unroll
    for (int r = 0; r < 16; ++r) rli[r] = __builtin_amdgcn_rcpf(li_l[crow(r, hi)]);
#pragma unroll
    for (int r = 0; r < 16; ++r) { const int orow = wid * 32 + crow(r, hi);
        if (pol.ovalid(orow)) { bf16* op = pol.optr(orow);
#pragma unroll
            for (int d0 = 0; d0 < NDB; ++d0) op[d0 * 32 + r32] = (bf16)f2bf(o[d0][r] * rli[r]); } }
    }
    __syncthreads();
#undef SLOAD
#undef SWRITE
#undef RESC
#undef XFORM
}

__device__ __forceinline__ int unit_row(int b, int qb, int r) { int row = qb < 64 ? b * SEQ + qb * 256 + r : RMETA + 16 * b + r; return row < NR ? row : NR - 1; }

struct PolMLA {
    const bf16 *Kc, *Vm, *Q; bf16* O; float* part; const float* rope_; int b, h, qb, nt, kstride, vstride, split;
    __device__ __forceinline__ void init(const bf16* Kc_, const bf16* Vm_, const bf16* Q_, bf16* O_, float* part_, const float* rope__, int b_, int h_, int qb_, int split_) {
        Kc = Kc_; Vm = Vm_; Q = Q_; O = O_; part = part_; rope_ = rope__; b = b_; h = h_; qb = qb_; split = split_; kstride = KCW; vstride = VMW;
        nt = split < 0 ? 258 : (split == 0 ? 34 : 32); }
    __device__ __forceinline__ int krow0(int t) const {
        if (split < 0) return (t == 0 || t == 257) ? RMETA + 16 * b : b * SEQ + (t - 1) * 64;
        if (split == 0) return (t == 0 || t == 33) ? RMETA + 16 * b : b * SEQ + (t - 1) * 64;
        return b * SEQ + (32 * split + t) * 64; }
    __device__ __forceinline__ const bf16* kbase(int t) const { return Kc + (size_t)krow0(t) * KCW + h * 192; }
    __device__ __forceinline__ const bf16* vbase(int t) const { return Vm + (size_t)krow0(t) * VMW + h * 128; }
    __device__ __forceinline__ const bf16* qptr(int r) const { return Q + (size_t)unit_row(b, qb, r) * QW + h * 192; }
    __device__ __forceinline__ bf16* optr(int r) const { return O + (size_t)unit_row(b, qb, r) * AOW + h * 128; }
    __device__ __forceinline__ bool ovalid(int r) const { return qb < 64 || r < 16; }
    __device__ __forceinline__ bool needs_xform(int t) const { return split < 0 ? (t == 0 || t == 257) : (split == 0 && (t == 0 || t == 33)); }
    __device__ __forceinline__ void xform(f32x16& p0, f32x16& p1, int t, int, int, int) const { if (t == 0) mask_meta(p0, p1); else mask_all(p0, p1); }
    __device__ __forceinline__ float sink_term(float) const { return 0.f; }
    __device__ __forceinline__ bool partial() const { return split >= 0; }
    __device__ __forceinline__ void qfix(bf16x8* qr, int r, int hi) const {
        const int row = unit_row(b, qb, r); const int pos = row < RMETA ? NMETA + (row & (SEQ - 1)) : ((row - RMETA) & 15);
        const float* rp = rope_ + 2 * (size_t)(pos * 32);
#pragma unroll
        for (int blk = 0; blk < 2; ++blk) { const f32x4* cs = (const f32x4*)(rp + 2 * (16 * blk + 8 * hi)); f32x4 t[4];
#pragma unroll
            for (int q = 0; q < 4; ++q) t[q] = cs[q];
            bf16x8 x1 = qr[8 + blk], x2 = qr[10 + blk];
#pragma unroll
            for (int e = 0; e < 8; ++e) { const float c = t[e >> 1][(e & 1) * 2], sn = t[e >> 1][(e & 1) * 2 + 1];
                const float a = bf2f((unsigned short)x1[e]), bb = bf2f((unsigned short)x2[e]);
                x1[e] = (short)f2bf(a * c - bb * sn); x2[e] = (short)f2bf(bb * c + a * sn); }
            qr[8 + blk] = x1; qr[10 + blk] = x2; } }
    __device__ __forceinline__ float* pptr(int r) const { return part + ((size_t)((b * 8 + h) * 8 + split) * 16 + r) * 132; }
};

struct PolNA {
    const bf16* Z; bf16* O; const float* tab; int b, h, qb, nt, kstride, vstride, glo, n;
    __device__ __forceinline__ void init(const bf16* Z_, bf16* O_, const float* tab_, int b_, int h_, int qb_) {
        Z = Z_; O = O_; tab = tab_; b = b_; h = h_; qb = qb_; kstride = ZW; vstride = ZW;
        if (qb < 64) { int lo = 4 * qb - 4; lo = lo < 0 ? 0 : (lo > 248 ? 248 : lo); int hi_ = 4 * qb + 3 - 4; hi_ = hi_ < 0 ? 0 : (hi_ > 248 ? 248 : hi_); hi_ += 7; glo = lo; n = hi_ - lo + 1; }
        else { glo = 0; n = 0; }
        nt = (n + 1 + 1) & ~1; }
    __device__ __forceinline__ int krow0(int t) const { return (t == 0 || t > n) ? RMETA + 16 * b : b * SEQ + (glo + t - 1) * 64; }
    __device__ __forceinline__ const bf16* kbase(int t) const { return Z + (size_t)krow0(t) * ZW + ZNAK + h * 128; }
    __device__ __forceinline__ const bf16* vbase(int t) const { return Z + (size_t)krow0(t) * ZW + ZNAV + h * 128; }
    __device__ __forceinline__ const bf16* qptr(int r) const { return Z + (size_t)unit_row(b, qb, r) * ZW + ZNAQ + h * 128; }
    __device__ __forceinline__ bf16* optr(int r) const { return O + (size_t)unit_row(b, qb, r) * AOW + 1024 + h * 128; }
    __device__ __forceinline__ bool ovalid(int r) const { return qb < 64 || r < 16; }
    __device__ __forceinline__ bool needs_xform(int) const { return true; }
    __device__ __forceinline__ void xform(f32x16& p0, f32x16& p1, int t, int wid, int r32, int hi) const {
        if (t == 0) { mask_meta(p0, p1); return; }
        if (t > n) { mask_all(p0, p1); return; }
        const int g = glo + t - 1, r = 4 * qb + (wid >> 1), c = 32 * (wid & 1) + r32;
        int rs = r - 4; rs = rs < 0 ? 0 : (rs > 248 ? 248 : rs);
        if (g < rs || g >= rs + 8) { mask_all(p0, p1); return; }
        int cs = c - 8; cs = cs < 0 ? 0 : (cs > 48 ? 48 : cs);
        const float* trow = tab + (g - r + 7) * 31 + 15 - c;
#pragma unroll
        for (int i = 0; i < 16; ++i) { const int kc = crow(i, hi); const bool ok = kc >= cs && kc < cs + 16; const int kcc = ok ? kc : c;
            const float bv = trow[kcc]; p0[i] = ok ? p0[i] + bv : NEGBIG; }
#pragma unroll
        for (int i = 0; i < 16; ++i) { const int kc = 32 + crow(i, hi); const bool ok = kc >= cs && kc < cs + 16; const int kcc = ok ? kc : c;
            const float bv = trow[kcc]; p1[i] = ok ? p1[i] + bv : NEGBIG; }
    }
    __device__ __forceinline__ float sink_term(float) const { return 0.f; }
    __device__ __forceinline__ bool partial() const { return false; }
    __device__ __forceinline__ float* pptr(int) const { return nullptr; }
    __device__ __forceinline__ void qfix(bf16x8*, int, int) const {}
};

struct PolSWA {
    const bf16* Z; bf16* O; int b, hq, qb, nt, kstride, vstride, klo, n; float slope_l2, sink_l2;
    __device__ __forceinline__ void init(const bf16* Z_, bf16* O_, const float* sinks, int b_, int hq_, int qb_) {
        Z = Z_; O = O_; b = b_; hq = hq_; qb = qb_; kstride = Z1W; vstride = Z1W;
        if (qb < 64) { klo = 4 * qb - 2; if (klo < 0) klo = 0; int khi = 4 * qb + 5; if (khi > 255) khi = 255; n = khi - klo + 1; }
        else { klo = 0; n = 2; }
        nt = (n + 1 + 1) & ~1;
        slope_l2 = __builtin_amdgcn_exp2f(-0.25f * (float)(hq + 1)) * LOG2E; sink_l2 = sinks[hq] * LOG2E; }
    __device__ __forceinline__ int krow0(int t) const { return (t == 0 || t > n) ? RMETA + 16 * b : b * SEQ + (klo + t - 1) * 64; }
    __device__ __forceinline__ const bf16* kbase(int t) const { return Z + (size_t)krow0(t) * Z1W + 2048 + (hq >> 3) * 64; }
    __device__ __forceinline__ const bf16* vbase(int t) const { return Z + (size_t)krow0(t) * Z1W + 2304 + (hq >> 3) * 64; }
    __device__ __forceinline__ const bf16* qptr(int r) const { return Z + (size_t)unit_row(b, qb, r) * Z1W + hq * 64; }
    __device__ __forceinline__ bf16* optr(int r) const { return O + (size_t)unit_row(b, qb, r) * AOW + hq * 64; }
    __device__ __forceinline__ bool ovalid(int r) const { return qb < 64 || r < 16; }
    __device__ __forceinline__ bool needs_xform(int) const { return true; }
    __device__ __forceinline__ void xform(f32x16& p0, f32x16& p1, int t, int wid, int r32, int hi) const {
        if (t == 0) { mask_meta(p0, p1); return; }
        if (t > n) { mask_all(p0, p1); return; }
        const int kt = klo + t - 1;
        if (qb < 64) {
            const int d0 = 64 * kt - (256 * qb + 32 * wid + r32);
#pragma unroll
            for (int i = 0; i < 16; ++i) { int d = d0 + crow(i, hi); d = max(d, -d); const int m = min(max(d - 128, 0), 1); p0[i] = (p0[i] - slope_l2 * (float)d) + NEGBIG * (float)m; }
#pragma unroll
            for (int i = 0; i < 16; ++i) { int d = d0 + 32 + crow(i, hi); d = max(d, -d); const int m = min(max(d - 128, 0), 1); p1[i] = (p1[i] - slope_l2 * (float)d) + NEGBIG * (float)m; }
        } else {
            const int qi = 32 * wid + r32, j0 = 64 * kt;
#pragma unroll
            for (int i = 0; i < 16; ++i) { const int j = j0 + crow(i, hi); const int m = min(max(16 + j - qi - 128, 0), 1); p0[i] = p0[i] + NEGBIG * (float)m; }
#pragma unroll
            for (int i = 0; i < 16; ++i) { const int j = j0 + 32 + crow(i, hi); const int m = min(max(16 + j - qi - 128, 0), 1); p1[i] = p1[i] + NEGBIG * (float)m; }
        }
    }
    __device__ __forceinline__ float sink_term(float m) const { return __builtin_amdgcn_exp2f(sink_l2 - m); }
    __device__ __forceinline__ bool partial() const { return false; }
    __device__ __forceinline__ float* pptr(int) const { return nullptr; }
    __device__ __forceinline__ void qfix(bf16x8*, int, int) const {}
};
struct PolSWAG {
    const bf16* Z; bf16* O; int b, kvh, pb, nt, kstride, vstride, klo, n; float slope_l2, sink_l2;
    __device__ __forceinline__ void init(const bf16* Z_, bf16* O_, const float* sinks, int b_, int kvh_, int pb_, int wv) {
        Z = Z_; O = O_; b = b_; kvh = kvh_; pb = pb_; kstride = Z1W; vstride = Z1W;
        klo = (pb - 4) >> 1; if (klo < 0) klo = 0; int khi = (pb + 4) >> 1; if (khi > 255) khi = 255; n = khi - klo + 1;
        nt = (n + 1 + 1) & ~1;
        const int hq = kvh * 8 + wv;
        slope_l2 = __builtin_amdgcn_exp2f(-0.25f * (float)(hq + 1)) * LOG2E; sink_l2 = sinks[hq] * LOG2E; }
    __device__ __forceinline__ int krow0(int t) const { return (t == 0 || t > n) ? RMETA + 16 * b : b * SEQ + (klo + t - 1) * 64; }
    __device__ __forceinline__ const bf16* kbase(int t) const { return Z + (size_t)krow0(t) * Z1W + 2048 + kvh * 64; }
    __device__ __forceinline__ const bf16* vbase(int t) const { return Z + (size_t)krow0(t) * Z1W + 2304 + kvh * 64; }
    __device__ __forceinline__ const bf16* qptr(int r) const { return Z + (size_t)(b * SEQ + 32 * pb + (r & 31)) * Z1W + (kvh * 8 + (r >> 5)) * 64; }
    __device__ __forceinline__ bf16* optr(int r) const { return O + (size_t)(b * SEQ + 32 * pb + (r & 31)) * AOW + (kvh * 8 + (r >> 5)) * 64; }
    __device__ __forceinline__ bool ovalid(int) const { return true; }
    __device__ __forceinline__ bool needs_xform(int) const { return true; }
    __device__ __forceinline__ void xform(f32x16& p0, f32x16& p1, int t, int, int r32, int hi) const {
        if (t == 0) { mask_meta(p0, p1); return; }
        if (t > n) { mask_all(p0, p1); return; }
        const int rel = 64 * (klo + t - 1) - 32 * pb;
        const int d0 = rel - r32;
        if (rel == -96 || rel == -64 || rel == 32 || rel == 64) {
            const float sg = rel < 0 ? slope_l2 : -slope_l2;
            const float sb0 = sg * (float)(d0 + 4 * hi), sb1 = sb0 + sg * 32.f;
#pragma unroll
            for (int i = 0; i < 16; ++i) p0[i] = __builtin_fmaf(sg, (float)((i & 3) + 8 * (i >> 2)), p0[i] + sb0);
#pragma unroll
            for (int i = 0; i < 16; ++i) p1[i] = __builtin_fmaf(sg, (float)((i & 3) + 8 * (i >> 2)), p1[i] + sb1);
            return;
        }
        if (rel == -32 || rel == 0) {
#pragma unroll
            for (int i = 0; i < 16; ++i) { int d = d0 + crow(i, hi); d = max(d, -d); p0[i] = p0[i] - slope_l2 * (float)d; }
#pragma unroll
            for (int i = 0; i < 16; ++i) { int d = d0 + 32 + crow(i, hi); d = max(d, -d); p1[i] = p1[i] - slope_l2 * (float)d; }
            return;
        }
#pragma unroll
        for (int i = 0; i < 16; ++i) { int d = d0 + crow(i, hi); d = max(d, -d); const int m = min(max(d - 128, 0), 1); p0[i] = (p0[i] - slope_l2 * (float)d) + NEGBIG * (float)m; }
#pragma unroll
        for (int i = 0; i < 16; ++i) { int d = d0 + 32 + crow(i, hi); d = max(d, -d); const int m = min(max(d - 128, 0), 1); p1[i] = (p1[i] - slope_l2 * (float)d) + NEGBIG * (float)m; }
    }
    __device__ __forceinline__ float sink_term(float m) const { return __builtin_amdgcn_exp2f(sink_l2 - m); }
    __device__ __forceinline__ bool partial() const { return false; }
    __device__ __forceinline__ float* pptr(int) const { return nullptr; }
    __device__ __forceinline__ void qfix(bf16x8*, int, int) const {}
};
#undef SBAR
}

struct Params {
    const float* x; const float* meta; const float* norm_mix; const float* norm_ffn; const float* norm_final;
    const float* ab_w_in; const float* ab_q_norm; const float* ab_kv_norm; const float* ab_w_uq; const float* ab_w_ukv; const float* ab_rpb; const float* ab_w_out;
    const float* c_w_in; const float* c_sinks; const float* c_w_out;
    const float* ec_w_router; const float* ec_w_gate; const float* ec_w_up; const float* ec_w_down;
    float* out; unsigned char* ws;
};

__device__ __forceinline__ void load_row(const float* row, int lane, f32x4 (&v)[8]) {
    const f32x4* r = (const f32x4*)row + lane;
#pragma unroll
    for (int j = 0; j < 8; ++j) v[j] = r[64 * j];
}
__device__ __forceinline__ void load_row_bf16(const bf16* row, int lane, f32x4 (&v)[8]) {
    const u32x2* r = (const u32x2*)row + lane;
#pragma unroll
    for (int j = 0; j < 8; ++j) { const u32x2 w = r[64 * j]; v[j] = (f32x4){bflo(w.x), bfhi(w.x), bflo(w.y), bfhi(w.y)}; }
}
__device__ __forceinline__ void store_row_bf16(bf16* row, int lane, const f32x4 (&v)[8]) {
    u32x2* o8 = (u32x2*)row + lane;
#pragma unroll
    for (int j = 0; j < 8; ++j) { u32x2 w; w.x = pk2(v[j].x, v[j].y); w.y = pk2(v[j].z, v[j].w); o8[64 * j] = w; }
}
__device__ __forceinline__ float row_rs(const f32x4 (&v)[8]) {
    float s = 0.f;
#pragma unroll
    for (int j = 0; j < 8; ++j) s += (v[j].x * v[j].x + v[j].y * v[j].y) + (v[j].z * v[j].z + v[j].w * v[j].w);
    return 1.0f / sqrtf(wave_sum(s) * (1.f / D) + EPS);
}
__device__ __forceinline__ void store_norm_bf16(bf16* urow, int lane, const f32x4 (&v)[8], float rs, const float* g) {
    const f32x4* gp = (const f32x4*)g + lane; u32x2* o8 = (u32x2*)urow + lane;
#pragma unroll
    for (int j = 0; j < 8; ++j) { const f32x4 gg = gp[64 * j]; u32x2 w; w.x = pk2(v[j].x * rs * gg.x, v[j].y * rs * gg.y); w.y = pk2(v[j].z * rs * gg.z, v[j].w * rs * gg.w); o8[64 * j] = w; }
}
__device__ __forceinline__ void store_zero_bf16(bf16* urow, int lane) {
    u32x2* o8 = (u32x2*)urow + lane;
#pragma unroll
    for (int j = 0; j < 8; ++j) o8[64 * j] = (u32x2){0u, 0u};
}

__device__ __forceinline__ void transpose_item(const float* src, int srcN, int k0, int n0, bf16* dst, int dstK, int dst_row0, const float* kscale, LAS float*, int lane) {
    const int kg = lane >> 4, ng = lane & 15;
    f32x4 v[2][8];
#pragma unroll
    for (int half = 0; half < 2; ++half) { const int kk0 = k0 + 32 * half + 8 * kg;
#pragma unroll
        for (int j = 0; j < 8; ++j) v[half][j] = *(const f32x4*)(src + (size_t)(kk0 + j) * srcN + n0 + 4 * ng); }
#pragma unroll
    for (int half = 0; half < 2; ++half) {
        const int kk0 = k0 + 32 * half + 8 * kg;
        if (kscale) {
#pragma unroll
            for (int j = 0; j < 8; ++j) v[half][j] = v[half][j] * kscale[kk0 + j]; }
#pragma unroll
        for (int q = 0; q < 4; ++q) { u32x4 o; o.x = pk2(v[half][0][q], v[half][1][q]); o.y = pk2(v[half][2][q], v[half][3][q]); o.z = pk2(v[half][4][q], v[half][5][q]); o.w = pk2(v[half][6][q], v[half][7][q]);
            *(u32x4*)(dst + (size_t)(dst_row0 + 4 * ng + q) * dstK + kk0) = o; }
    }
}
template <class Map>
__device__ __forceinline__ void transpose_matrix(const float* W, int K, int N, bf16* WT, const float* kscale, LAS float* scr, int gw, int ngw, int lane, const Map& map) {
    const int nkb = K / 64, nnb = N / 64, items = nkb * nnb;
    for (int it = gw; it < items; it += ngw) { const int kb = it / nnb, nb = it % nnb; transpose_item(W, N, kb * 64, nb * 64, WT, K, map(nb * 64), kscale, scr, lane); }
}
__device__ __forceinline__ void convert_experts(const float* wg, const float* wu, const float* wd, const float* gk, bf16* Wgu, bf16* Wd, LAS float* scr, int gw, int ngw, int lane, int lo, int hi) {
    constexpr int PER = 32 * 32;
    for (int it = lo + gw; it < hi; it += ngw) {
        const int e = it / (3 * PER), r = it % (3 * PER), which = r / PER, q = r % PER, kb = q / 32, nb = q % 32, n0 = nb * 64;
        const size_t eoff = (size_t)e * D * D;
        if (which == 0) transpose_item(wg + eoff, D, kb * 64, n0, Wgu + (size_t)e * 4096 * D, D, (n0 >> 7) * 256 + (n0 & 127), gk, scr, lane);
        else if (which == 1) transpose_item(wu + eoff, D, kb * 64, n0, Wgu + (size_t)e * 4096 * D, D, (n0 >> 7) * 256 + 128 + (n0 & 127), gk, scr, lane);
        else transpose_item(wd + eoff, D, kb * 64, n0, Wd + eoff, D, n0, nullptr, scr, lane);
    }
}

constexpr int CV_ITEMS = NE * 3 * 32 * 32, CV_TAIL_PER_CU = 80;
constexpr int CV_TOPK = 224 * 30;
constexpr int CV_CHUNK = 64;
constexpr int CV_IN0 = (256 - (129 * 17) % 256) * CV_TAIL_PER_CU, CV_OUT = (256 - (129 * 8) % 256) * CV_TAIL_PER_CU, CV_IN1 = (256 - (129 * 10) % 256) * CV_TAIL_PER_CU;
constexpr int CV_MAIN0 = CV_ITEMS - CV_IN0 - CV_OUT - CV_TOPK;
#ifndef PHASES
#define PHASES 0xffffffffu
#endif
#define EN(k) (((PHASES) >> (k)) & 1u)
#define PH_IDS() int tid = threadIdx.x; asm volatile("" : "+v"(tid)); const int lane = tid & 63, wave = __builtin_amdgcn_readfirstlane(tid >> 6), gw = vcu * NWAVES + wave; (void)lane; (void)wave; (void)gw; WSL()
__global__ void __launch_bounds__(NTHREADS, 2) fwd_kernel(Params P) {
    extern __shared__ __attribute__((aligned(16))) unsigned char lds[];
    LAS unsigned char* ldsl = (LAS unsigned char*)lds;
    volatile LAS unsigned* MISC = (volatile LAS unsigned*)(ldsl + MISC_OFF);
    const int G = gridDim.x, bx = blockIdx.x;
    const int vcu = (G % 8 == 0) ? (bx % 8) * (G / 8) + bx / 8 : bx;
    const int NGW = G * NWAVES;
    unsigned* ctl = (unsigned*)(P.ws + WS_CTL);
    for (int u = threadIdx.x; u < 64; u += NTHREADS) MISC[u] = 0u;
    __syncthreads();
    XcdBarrier bar = xcd_barrier_post(ctl + CW_BAR, MISC + 8);
#define GRID_BAR() xcd_barrier(bar)

#define WSL() GAS unsigned char* wsg_ = (GAS unsigned char*)P.ws; asm volatile("" : "+s"(wsg_)); unsigned char* wsl = (unsigned char*)wsg_
#define rope ((float*)(wsl + WS_ROPE))
#define rsq ((float*)(wsl + WS_RSQ))
#define rskv ((float*)(wsl + WS_RSKV))
#define aff ((float*)(wsl + WS_AFF))
#define tokslot ((int*)(wsl + WS_TOKSLOT))
#define slottok ((int*)(wsl + WS_SLOTTOK))
#define xgate ((float*)(wsl + WS_XGATE))
#define xmap ((int*)(wsl + WS_XMAP))
#define rsf ((float*)(wsl + WS_RSF))
#define xrs ((float*)(wsl + WS_XRS))
#define rsm ((float*)(wsl + WS_RSM))
#define Win0 ((bf16*)(wsl + WS_WIN0))
#define Wuq ((bf16*)(wsl + WS_WUQ))
#define Wukv ((bf16*)(wsl + WS_WUKV))
#define Wout0 ((bf16*)(wsl + WS_WOUT0))
#define Win1 ((bf16*)(wsl + WS_WIN1))
#define Wout1 ((bf16*)(wsl + WS_WOUT1))
#define Wgu ((bf16*)(wsl + WS_WGU))
#define Wd ((bf16*)(wsl + WS_WD))
#define Hm ((bf16*)(wsl + WS_H))
#define U ((bf16*)(wsl + WS_U))
#define Z ((bf16*)(wsl + WS_Z))
#define Qb ((bf16*)(wsl + WS_Q))
#define Kc ((bf16*)(wsl + WS_KC))
#define Vm ((bf16*)(wsl + WS_VM))
#define AO ((bf16*)(wsl + WS_AO))
#define XS ((bf16*)(wsl + WS_XS))
#define HMID ((bf16*)(wsl + WS_HMID))

    if (EN(0)) {
        PH_IDS();
        LAS float* scr = (LAS float*)(ldsl + wave * 16640);
        transpose_matrix(P.ab_w_in, D, 4160, Win0, nullptr, scr, gw, NGW, lane, [](int n0) { return n0 < 1024 ? n0 : (n0 < 1088 ? 4096 + (n0 - 1024) : n0 - 64); });
        transpose_matrix(P.ab_w_uq, 512, 1536, Wuq, P.ab_q_norm, scr, gw, NGW, lane, [](int n0) { return n0; });
        transpose_matrix(P.ab_w_ukv, 512, 2048, Wukv, P.ab_kv_norm, scr, gw, NGW, lane, [](int n0) { return n0; });
        transpose_matrix(P.ab_w_out, D, D, Wout0, nullptr, scr, gw, NGW, lane, [](int n0) { return n0; });
        transpose_matrix(P.c_w_in, D, Z1W, Win1, P.norm_mix + D, scr, gw, NGW, lane, [](int n0) { return n0; });
        transpose_matrix(P.c_w_out, D, D, Wout1, nullptr, scr, gw, NGW, lane, [](int n0) { return n0; });
        if (G != 256) convert_experts(P.ec_w_gate, P.ec_w_up, P.ec_w_down, P.norm_ffn, Wgu, Wd, scr, gw, NGW, lane, 0, CV_ITEMS);
        for (int row = NTOK + gw * 64 + lane; row < NR; row += NGW * 64) rsm[row] = 0.f;
        for (int i = gw * 64 + lane; i < 192 * D / 8; i += NGW * 64) ((u32x4*)(Win0 + (size_t)4160 * D))[i] = (u32x4){0u, 0u, 0u, 0u};
        for (int row = gw; row < NR; row += NGW) {
            bf16* urow = U + (size_t)row * D;
            if (row < NTOK) {
                const float* src = row < RMETA ? P.x + (size_t)row * D : P.meta + (size_t)((row - RMETA) & 15) * D;
                f32x4 v[8]; load_row(src, lane, v);
                const float rs = row_rs(v); store_norm_bf16(urow, lane, v, rs, P.norm_mix);
            } else store_zero_bf16(urow, lane);
        }
        for (int i = gw * 64 + lane; i < LTOK * 32; i += NGW * 64) {
            const int pos = i >> 5, j = i & 31;
            double f = 1.0; { double r = 0.74989420933245582730;   for (int q = 0; q < j; ++q) f *= r; }
            const double rev = (double)pos * f * 0.15915494309189533577;
            const float fr = (float)(rev - __builtin_floor(rev));
            rope[2 * i] = __builtin_amdgcn_cosf(fr); rope[2 * i + 1] = __builtin_amdgcn_sinf(fr);
        }
    }
    GRID_BAR();

    for (int layer = 0; layer < 2; ++layer) {
        if (EN(1)) {
            WSL();
            const int nN = layer == 0 ? 17 : 10, ldz = layer == 0 ? ZW : Z1W;
            pg8::Gemm g{layer == 0 ? U : Hm, layer == 0 ? Win0 : Win1, D, D, D};
            pg8::TileOrder S; S.init(NR / 256, nN, G, bx, 0);
            pg8::EpiBf16S E{Z, ldz, layer == 0 ? nullptr : rsm, layer == 0 ? 4 : 0, 8, layer == 0 ? C_NA : C_SWA};
            pg8::gemm_phase(ldsl, g, S, E);
            if (G == 256) {
                const int rem = (129 * nN) % 256;
                if (bx >= rem) { PH_IDS(); const int cnt = layer == 0 ? CV_IN0 : CV_IN1, base = CV_ITEMS - CV_OUT - cnt; const size_t lo = (size_t)layer * NE * D * D;
                    convert_experts(P.ec_w_gate + lo, P.ec_w_up + lo, P.ec_w_down + lo, P.norm_ffn + (size_t)layer * D, Wgu, Wd, (LAS float*)ldsl, (bx - rem) * NWAVES + wave, (256 - rem) * NWAVES, lane, base, base + cnt); }
            }
        }
        GRID_BAR();
        if (layer == 0) {
            if (EN(2)) { PH_IDS();
                const int sub = lane >> 4, l16 = lane & 15;
                for (int row4 = gw * 4; row4 < NR; row4 += NGW * 4) {
                    const int row = row4 + sub;
                    const bf16* zr = Z + (size_t)row * ZW;
                    u32x4 a[4], bq[4];
#pragma unroll
                    for (int i = 0; i < 4; ++i) { a[i] = *(const u32x4*)(zr + ZQL + 128 * i + 8 * l16); bq[i] = *(const u32x4*)(zr + ZKVL + 128 * i + 8 * l16); }
                    const int pos = row < RMETA ? NMETA + (row & (SEQ - 1)) : ((row - RMETA) & 15);
                    const unsigned x1w = *(const unsigned*)(zr + ZKR + 2 * l16), x2w = *(const unsigned*)(zr + ZKR + 32 + 2 * l16);
                    const f32x4 cs = *(const f32x4*)(rope + 2 * (pos * 32 + 2 * l16));
                    float s1 = 0.f, s2 = 0.f;
#pragma unroll
                    for (int i = 0; i < 4; ++i)
#pragma unroll
                        for (int q = 0; q < 4; ++q) { const float a0 = bflo(a[i][q]), a1 = bfhi(a[i][q]), b0 = bflo(bq[i][q]), b1 = bfhi(bq[i][q]); s1 += a0 * a0 + a1 * a1; s2 += b0 * b0 + b1 * b1; }
#pragma unroll
                    for (int o = 1; o < 16; o <<= 1) { s1 += __shfl_xor(s1, o); s2 += __shfl_xor(s2, o); }
                    if (l16 == 0) { rsq[row] = C_MLA / sqrtf(s1 * (1.f / 512) + EPS); rskv[row] = 1.0f / sqrtf(s2 * (1.f / 512) + EPS); }
                    const float z = row < NTOK ? 1.f : 0.f;
                    const float x1a = bflo(x1w) * z, x1b = bfhi(x1w) * z, x2a = bflo(x2w) * z, x2b = bfhi(x2w) * z;
                    const unsigned w1 = pk2(x1a * cs[0] - x2a * cs[1], x1b * cs[2] - x2b * cs[3]), w2 = pk2(x2a * cs[0] + x1a * cs[1], x2b * cs[2] + x1b * cs[3]);
                    bf16* kr = Kc + (size_t)row * KCW + 128 + 2 * l16;
#pragma unroll
                    for (int h = 0; h < 8; ++h) { *(unsigned*)(kr + h * 192) = w1; *(unsigned*)(kr + h * 192 + 32) = w2; }
                } }
            GRID_BAR();
            if (EN(3)) {
                WSL();
                pg8::Gemm g{Z + ZQL, Wuq, ZW, 512, 512};
                pg8::TileOrder S; S.init(NR / 256, 6, G, bx, 0);
                pg8::EpiBf16S E{Qb, QW, rsq, 0, 0, 1.f};
                pg8::gemm_phase(ldsl, g, S, E);
            }
            if (EN(4)) {
                WSL();
                pg8::Gemm g{Z + ZKVL, Wukv, ZW, 512, 512};
                pg8::TileOrder S; S.init(NR / 256, 8, G, G == 256 ? (bx + 248) & 255 : bx, 0);
                pg8::EpiKV E{Kc, Vm, rskv};
                pg8::gemm_phase(ldsl, g, S, E);
            }
            GRID_BAR();
            {
                WSL();
                constexpr int N_MLA = 1024 + 128, N_NA = 1040;
                float* tab = (float*)(lds + 3 * 16384 + 3 * 16384 + 2048);
                float* PART = (float*)(wsl + WS_PART);
                unsigned* ticket = (unsigned*)(wsl + WS_CTL) + CW_TICKET;
                for (int u0 = vcu; ; ) {
                    int u;
                    if (u0 < 1024) { u = u0; u0 += G; }
                    else {
                        if (threadIdx.x == 0) MISC[16] = 1024u + __hip_atomic_fetch_add(ticket, 1u, __ATOMIC_RELAXED, __HIP_MEMORY_SCOPE_AGENT);
                        __syncthreads();
                        u = (int)MISC[16];
                        if (u >= N_MLA + N_NA) {
                            const int c = u - (N_MLA + N_NA);
                            if (G != 256 || c >= (CV_MAIN0 + CV_CHUNK - 1) / CV_CHUNK) break;
                            const int ln = threadIdx.x & 63, wv = __builtin_amdgcn_readfirstlane((int)threadIdx.x >> 6), hi_ = (c + 1) * CV_CHUNK < CV_MAIN0 ? (c + 1) * CV_CHUNK : CV_MAIN0;
                            convert_experts(P.ec_w_gate, P.ec_w_up, P.ec_w_down, P.norm_ffn, Wgu, Wd, (LAS float*)ldsl, wv, NWAVES, ln, c * CV_CHUNK, hi_);
                            __syncthreads();
                            continue;
                        }
                    }
                    if (u < N_MLA) { if (EN(6)) {
                        int b, h, qb, sp; if (u < 1024) { const int bh = u >> 6; b = bh >> 3; h = bh & 7; qb = u & 63; sp = -1; } else { const int v = u - 1024; const int bh = v >> 3; b = bh >> 3; h = bh & 7; qb = 64; sp = v & 7; }
                        att::PolMLA pol; pol.init(Kc, Vm, Qb, AO, PART, rope, b, h, qb, sp);
                        att::attn_unit<192, 128>(pol, (char*)lds); }
                    } else if (EN(7)) {
                        const int v = u - N_MLA; int b, h, qb; if (v < 1024) { const int bh = v >> 6; b = bh >> 3; h = bh & 7; qb = v & 63; } else { const int bh = v - 1024; b = bh >> 3; h = bh & 7; qb = 64; }
                        for (int i = threadIdx.x; i < 15 * 31; i += NTHREADS) tab[i] = P.ab_rpb[h * 465 + i] * LOG2E;
                        __syncthreads();
                        att::PolNA pol; pol.init(Z, AO, tab, b, h, qb);
                        att::attn_unit<128, 128>(pol, (char*)lds);
                    }
                }
            }
            GRID_BAR();
            {
                PH_IDS();
                const float* PART = (const float*)(wsl + WS_PART);
                for (int it = gw; it < 2 * 8 * 16; it += NGW) {
                    const int row = it & 15, bh = it >> 4, b = bh >> 3, h = bh & 7;
                    const float* pp = PART + ((size_t)(bh * 8) * 16 + row) * 132;
                    float M = -3e38f;
#pragma unroll
                    for (int sp = 0; sp < 8; ++sp) M = fmaxf(M, pp[(size_t)sp * 16 * 132 + 128]);
                    float L = 0.f, o0 = 0.f, o1 = 0.f;
#pragma unroll
                    for (int sp = 0; sp < 8; ++sp) { const float* q = pp + (size_t)sp * 16 * 132; const float w = __builtin_amdgcn_exp2f(q[128] - M); L += w * q[129]; o0 += w * q[lane]; o1 += w * q[64 + lane]; }
                    const float rl = 1.0f / L; bf16* op = AO + (size_t)(RMETA + 16 * b + row) * AOW + h * 128;
                    op[lane] = (bf16)f2bf(o0 * rl); op[64 + lane] = (bf16)f2bf(o1 * rl);
                }
            }
        } else {
            WSL();
            if (EN(8)) {
                const int wv = __builtin_amdgcn_readfirstlane((int)threadIdx.x >> 6);
                for (int u = vcu; u < 4096; u += G) {
                    att::PolSWAG pol; pol.init(Z, AO, P.c_sinks, u >> 11, (u >> 9) & 3, u & 511, wv);
                    att::attn_unit<64, 64>(pol, (char*)lds);
                }
                for (int u = vcu; u < 64; u += G) {
                    att::PolSWA pol; pol.init(Z, AO, P.c_sinks, u >> 5, u & 31, 64);
                    att::attn_unit<64, 64>(pol, (char*)lds);
                }
            }
        }
        GRID_BAR();
        if (EN(9)) {
            WSL();
            pg8::Gemm g{AO, layer == 0 ? Wout0 : Wout1, AOW, D, D};
            pg8::TileOrder S; S.init(NR / 256, 8, G, bx, 0);
            pg8::EpiResid E{Hm, D, layer == 0 ? P.x : nullptr, P.meta};
            pg8::gemm_phase(ldsl, g, S, E);
            if (G == 256) {
                const int rem = (129 * 8) % 256;
                if (bx >= rem) { PH_IDS(); const size_t lo = (size_t)layer * NE * D * D;
                    convert_experts(P.ec_w_gate + lo, P.ec_w_up + lo, P.ec_w_down + lo, P.norm_ffn + (size_t)layer * D, Wgu, Wd, (LAS float*)ldsl, (bx - rem) * NWAVES + wave, (256 - rem) * NWAVES, lane, CV_ITEMS - CV_OUT, CV_ITEMS); }
            }
        }
        GRID_BAR();
        if (EN(10)) {
            PH_IDS();
            LAS float* wb = (LAS float*)ldsl;
            LAS float* red = (LAS float*)(ldsl + 131072);
            const float* wsrc = P.ec_w_router + (size_t)layer * D * NE; const float* gf = P.norm_ffn + (size_t)layer * D;
            for (int i = tid; i < D * 4; i += NTHREADS) { const int k = i >> 2, eg = i & 3; const f32x4 w4 = *(const f32x4*)(wsrc + (size_t)k * NE + 4 * eg) * gf[k];
                const int base = ((k >> 2) * 16 + 4 * eg) * 4 + (k & 3);
                wb[base] = w4.x; wb[base + 4] = w4.y; wb[base + 8] = w4.z; wb[base + 12] = w4.w; }
            __syncthreads();
            const int r = lane & 15, kq = lane >> 4;
            u32x4 hv[8];
            { const bf16* hp = Hm + (size_t)(vcu * 16 + r) * D + 256 * wave + 8 * kq;
#pragma unroll
              for (int i = 0; i < 8; ++i) hv[i] = *(const u32x4*)(hp + 32 * i); }
            for (int blk = vcu; blk < NTOK / 16; blk += G) {
                const int row0 = blk * 16;
                f32x4 acc = {0.f, 0.f, 0.f, 0.f}; float ss = 0.f;
#pragma unroll
                for (int i = 0; i < 8; ++i) {
                    const LAS f32x4* bp = (const LAS f32x4*)wb + (((wave * 8 + i) * 4 + kq) * 2) * 16 + r;
                    const f32x4 b0 = bp[0], b1 = bp[16];
                    const float a0 = bflo(hv[i].x), a1 = bfhi(hv[i].x), a2 = bflo(hv[i].y), a3 = bfhi(hv[i].y), a4 = bflo(hv[i].z), a5 = bfhi(hv[i].z), a6 = bflo(hv[i].w), a7 = bfhi(hv[i].w);
                    acc = __builtin_amdgcn_mfma_f32_16x16x4f32(a0, b0.x, acc, 0, 0, 0); acc = __builtin_amdgcn_mfma_f32_16x16x4f32(a1, b0.y, acc, 0, 0, 0);
                    acc = __builtin_amdgcn_mfma_f32_16x16x4f32(a2, b0.z, acc, 0, 0, 0); acc = __builtin_amdgcn_mfma_f32_16x16x4f32(a3, b0.w, acc, 0, 0, 0);
                    acc = __builtin_amdgcn_mfma_f32_16x16x4f32(a4, b1.x, acc, 0, 0, 0); acc = __builtin_amdgcn_mfma_f32_16x16x4f32(a5, b1.y, acc, 0, 0, 0);
                    acc = __builtin_amdgcn_mfma_f32_16x16x4f32(a6, b1.z, acc, 0, 0, 0); acc = __builtin_amdgcn_mfma_f32_16x16x4f32(a7, b1.w, acc, 0, 0, 0);
                    ss += (a0 * a0 + a1 * a1) + (a2 * a2 + a3 * a3) + (a4 * a4 + a5 * a5) + (a6 * a6 + a7 * a7);
                }
                if (blk + G < NTOK / 16) {
                    const bf16* hp = Hm + (size_t)((blk + G) * 16 + r) * D + 256 * wave + 8 * kq;
#pragma unroll
                    for (int i = 0; i < 8; ++i) hv[i] = *(const u32x4*)(hp + 32 * i); }
                ss += __shfl_xor(ss, 16); ss += __shfl_xor(ss, 32);
                LAS float* rw = red + wave * 272;
                *(LAS f32x4*)(rw + 4 * lane) = acc;
                if (lane < 16) rw[256 + lane] = ss;
                __syncthreads();
                if (wave == 0) {
                    f32x4 lg = {0.f, 0.f, 0.f, 0.f}; float sq[4] = {0.f, 0.f, 0.f, 0.f};
#pragma unroll
                    for (int w = 0; w < 8; ++w) { lg = lg + *(const LAS f32x4*)(red + w * 272 + 4 * lane);
#pragma unroll
                        for (int j = 0; j < 4; ++j) sq[j] += red[w * 272 + 256 + 4 * kq + j]; }
#pragma unroll
                    for (int j = 0; j < 4; ++j) {
                        const int row = row0 + 4 * kq + j; const float rs = 1.0f / sqrtf(sq[j] * (1.f / D) + EPS);
                        const float x = lg[j] * rs;
                        float mx = x; mx = fmaxf(mx, __shfl_xor(mx, 1)); mx = fmaxf(mx, __shfl_xor(mx, 2)); mx = fmaxf(mx, __shfl_xor(mx, 4)); mx = fmaxf(mx, __shfl_xor(mx, 8));
                        const float p = __expf(x - mx); float sum = p;
                        sum += __shfl_xor(sum, 1); sum += __shfl_xor(sum, 2); sum += __shfl_xor(sum, 4); sum += __shfl_xor(sum, 8);
                        const int b = row < RMETA ? (row >> 14) : ((row - RMETA) >> 4); const int tok = row < RMETA ? NMETA + (row & (SEQ - 1)) : ((row - RMETA) & 15);
                        aff[(size_t)(b * NE + r) * LTOK + tok] = p / sum;
                        if (r == 0) rsf[row] = rs;
                    }
                }
                __syncthreads();
            }
        }
        GRID_BAR();
        if (EN(11) && vcu < 32) {
            PH_IDS();
            const int be = vcu, b = be >> 4, e = be & 15;
            LAS unsigned* keys = (LAS unsigned*)ldsl;
            LAS unsigned* hist = (LAS unsigned*)(ldsl + 66560);
            LAS unsigned* sh = (LAS unsigned*)(ldsl + 66560 + 1024);
            const float* av = aff + (size_t)be * LTOK;
            for (int i = tid; i < LTOK; i += NTHREADS) keys[i] = __float_as_uint(av[i]);
            __syncthreads();
            const int i0 = tid * 33, i1 = (i0 + 33 < LTOK) ? i0 + 33 : LTOK;
            unsigned kv[33];
#pragma unroll
            for (int q = 0; q < 33; ++q) kv[q] = (i0 + q < LTOK) ? keys[i0 + q] : 0u;
            unsigned T = 0u;
            for (int bit = 30; bit >= 0; --bit) {
                const unsigned cand = T | (1u << bit); unsigned c = 0u;
#pragma unroll
                for (int q = 0; q < 33; ++q) c += 1u - ((kv[q] - cand) >> 31);
#pragma unroll
                for (int o = 1; o < 64; o <<= 1) c += __shfl_xor(c, o);
                LAS unsigned* slot = sh + 32 + (bit & 1) * 8;
                if (lane == 0) slot[wave] = c;
                __syncthreads();
                unsigned tot = 0u;
#pragma unroll
                for (int w = 0; w < 8; ++w) tot += slot[w];
                T |= (1u - ((tot - (unsigned)CAP) >> 31)) << bit;
            }
            unsigned cgt = 0u, ceq = 0u;
#pragma unroll
            for (int q = 0; q < 33; ++q) { const unsigned k = kv[q]; cgt += k > T ? 1u : 0u; ceq += (k == T && i0 + q < LTOK) ? 1u : 0u; }
            unsigned pk = cgt | (ceq << 16), incl = pk;
#pragma unroll
            for (int o = 1; o < 64; o <<= 1) { const unsigned t = __shfl_up(incl, o); if (lane >= o) incl += t; }
            if (lane == 63) sh[16 + wave] = incl;
            __syncthreads();
            unsigned wbase = 0u, totgt = 0u;
            for (int w = 0; w < 8; ++w) { const unsigned x = sh[16 + w]; totgt += x & 0xffffu; if (w < wave) wbase += x; }
            const unsigned krem = (unsigned)CAP - totgt;
            const unsigned excl = wbase + incl - pk;
            unsigned ngt = excl & 0xffffu, neq = excl >> 16;
            int* tsl = tokslot + (size_t)be * LTOK; int* stk = slottok + (size_t)be * CAP; float* xg = xgate + (size_t)e * XPE + b * CAP; int* xm = xmap + (size_t)e * XPE + b * CAP; float* xr = xrs + (size_t)e * XPE + b * CAP;
            for (int i = i0; i < i1; ++i) { const unsigned k = keys[i]; bool sel = k > T; if (k == T) { sel = neq < krem; }
                int slot = -1;
                if (sel) { slot = (int)(ngt + (neq < krem ? neq : krem)); if (slot < CAP) { const int trow = i < NMETA ? RMETA + 16 * b + i : b * SEQ + (i - NMETA); stk[slot] = trow; xm[slot] = trow; xg[slot] = __uint_as_float(k); xr[slot] = rsf[trow]; } else slot = -1; }
                if (k > T) ++ngt; if (k == T) ++neq;
                tsl[i] = slot; }
            if (b == 1) for (int i = tid; i < XPE - 2 * CAP; i += NTHREADS) { xgate[(size_t)e * XPE + 2 * CAP + i] = 0.f; xmap[(size_t)e * XPE + 2 * CAP + i] = NR - 1; xrs[(size_t)e * XPE + 2 * CAP + i] = 0.f; }
        }
        else if (EN(11) && G == 256) {
            PH_IDS(); const int cin = layer == 0 ? CV_IN0 : CV_IN1, hi_ = CV_ITEMS - CV_OUT - cin; const size_t lo = (size_t)layer * NE * D * D;
            convert_experts(P.ec_w_gate + lo, P.ec_w_up + lo, P.ec_w_down + lo, P.norm_ffn + (size_t)layer * D, Wgu, Wd, (LAS float*)ldsl, (vcu - 32) * NWAVES + wave, 224 * NWAVES, lane, hi_ - CV_TOPK, hi_);
        }
        GRID_BAR();
        if (EN(13)) {
            WSL();
            pg8::Gemm g{Hm, Wgu, D, D, D, xmap};
            pg8::TileOrder S; S.init(XROWS / 256, 16, G, bx, 17);
            pg8::EpiSwiGLU E{HMID, D, xrs};
            pg8::gemm_phase<true>(ldsl, g, S, E);
        }
        GRID_BAR();
        if (EN(14)) {
            WSL();
            pg8::Gemm g{HMID, Wd, D, D, D};
            pg8::TileOrder S; S.init(XROWS / 256, 8, G, bx, 17);
            pg8::EpiBf16S E{XS, D, nullptr, 0, 0, 1.f};
            pg8::gemm_phase(ldsl, g, S, E);
        }
        GRID_BAR();
        if (EN(15)) {
            PH_IDS();
            const float* gn = layer == 0 ? P.norm_mix + D : P.norm_final;
            for (int row = gw; row < (layer == 0 ? NTOK : RMETA); row += NGW) {
                const int b = row < RMETA ? (row >> 14) : ((row - RMETA) >> 4); const int tok = row < RMETA ? NMETA + (row & (SEQ - 1)) : ((row - RMETA) & 15);
                f32x4 v[8]; bf16* hrow = Hm + (size_t)row * D; load_row_bf16(hrow, lane, v);
                int sl[NE];
#pragma unroll
                for (int e = 0; e < NE; ++e) sl[e] = tokslot[(size_t)(b * NE + e) * LTOK + tok];
                int cnt = 0, o0 = 0, o1 = 0, o2 = 0, o3 = 0;
#pragma unroll
                for (int e = 0; e < NE; ++e) {
                    const int s = __builtin_amdgcn_readfirstlane(sl[e]); const int ok = s >= 0 ? 1 : 0, xr_ = e * XPE + b * CAP + s;
                    o0 = (ok && cnt == 0) ? xr_ : o0; o1 = (ok && cnt == 1) ? xr_ : o1; o2 = (ok && cnt == 2) ? xr_ : o2; o3 = (ok && cnt == 3) ? xr_ : o3; cnt += ok;
                }
                { o1 = cnt > 1 ? o1 : o0; o2 = cnt > 2 ? o2 : o0; o3 = cnt > 3 ? o3 : o0;
                  const float w0 = cnt > 0 ? xgate[o0] : 0.f, w1 = cnt > 1 ? xgate[o1] : 0.f, w2 = cnt > 2 ? xgate[o2] : 0.f, w3 = cnt > 3 ? xgate[o3] : 0.f;
                  const u32x2* p0 = (const u32x2*)(XS + (size_t)o0 * D) + lane; const u32x2* p1 = (const u32x2*)(XS + (size_t)o1 * D) + lane;
                  const u32x2* p2 = (const u32x2*)(XS + (size_t)o2 * D) + lane; const u32x2* p3 = (const u32x2*)(XS + (size_t)o3 * D) + lane;
                  u32x2 y0[8], y1[8], y2[8], y3[8];
#pragma unroll
                  for (int j = 0; j < 8; ++j) { y0[j] = p0[64 * j]; y1[j] = p1[64 * j]; y2[j] = p2[64 * j]; y3[j] = p3[64 * j]; }
#pragma unroll
                  for (int j = 0; j < 8; ++j) {
                      v[j].x += (w0 * bflo(y0[j].x) + w1 * bflo(y1[j].x)) + (w2 * bflo(y2[j].x) + w3 * bflo(y3[j].x)); v[j].y += (w0 * bfhi(y0[j].x) + w1 * bfhi(y1[j].x)) + (w2 * bfhi(y2[j].x) + w3 * bfhi(y3[j].x));
                      v[j].z += (w0 * bflo(y0[j].y) + w1 * bflo(y1[j].y)) + (w2 * bflo(y2[j].y) + w3 * bflo(y3[j].y)); v[j].w += (w0 * bfhi(y0[j].y) + w1 * bfhi(y1[j].y)) + (w2 * bfhi(y2[j].y) + w3 * bfhi(y3[j].y)); } }
                if (cnt > 4) {
                    int seen = 0;
#pragma unroll
                    for (int e = 0; e < NE; ++e) {
                        const int s = __builtin_amdgcn_readfirstlane(sl[e]);
                        if (s >= 0) { if (seen >= 4) { const int xr_ = e * XPE + b * CAP + s; const float gt = xgate[xr_]; const u32x2* yp = (const u32x2*)(XS + (size_t)xr_ * D) + lane;
#pragma unroll
                            for (int j = 0; j < 8; ++j) { const u32x2 w = yp[64 * j]; v[j].x += gt * bflo(w.x); v[j].y += gt * bfhi(w.x); v[j].z += gt * bflo(w.y); v[j].w += gt * bfhi(w.y); } }
                          ++seen; }
                    }
                }
                const float rs = row_rs(v);
                if (layer == 0) {
                    store_row_bf16(hrow, lane, v);
                    if (lane == 0) rsm[row] = rs;
                } else {
                    const f32x4* gp = (const f32x4*)gn + lane; f32x4* op = (f32x4*)(P.out + (size_t)row * D) + lane;
#pragma unroll
                    for (int j = 0; j < 8; ++j) op[64 * j] = v[j] * rs * gp[64 * j];
                }
            }
            if (layer == 0) {
                LAS float* scr = (LAS float*)(ldsl + wave * 16640);
                const size_t lo = (size_t)NE * D * D;
                convert_experts(P.ec_w_gate + lo, P.ec_w_up + lo, P.ec_w_down + lo, P.norm_ffn + D, Wgu, Wd, scr, gw, NGW, lane, 0, G == 256 ? CV_ITEMS - CV_IN1 - CV_OUT - CV_TOPK : CV_ITEMS);
            }
        }
        if (layer == 0) GRID_BAR();
    }
#undef GRID_BAR
}

extern "C" void kernel_launch(void* const* d_in, const int* in_sizes, int n_in, void* d_out, int out_size, void* d_ws, size_t ws_size, hipStream_t stream) {
    static int grid = 0;
    if (grid == 0) {
        if (n_in != 19 || ws_size < WS_END) { fprintf(stderr, "kernel_launch: unexpected n_in %d / ws %zu (need %zu)\n", n_in, ws_size, (size_t)WS_END); grid = -1; return; }
        int dev = 0, cus = 0, per_cu = 0;
        if (hipGetDevice(&dev) != hipSuccess || hipDeviceGetAttribute(&cus, hipDeviceAttributeMultiprocessorCount, dev) != hipSuccess) { grid = -1; return; }
        if (hipFuncSetAttribute((const void*)fwd_kernel, hipFuncAttributeMaxDynamicSharedMemorySize, LDS_BYTES) != hipSuccess) { fprintf(stderr, "kernel_launch: hipFuncSetAttribute failed\n"); grid = -1; return; }
        if (hipOccupancyMaxActiveBlocksPerMultiprocessor(&per_cu, (const void*)fwd_kernel, NTHREADS, LDS_BYTES) != hipSuccess || per_cu < 1) { fprintf(stderr, "kernel_launch: occupancy query reports %d\n", per_cu); }
        (void)hipGetLastError();
        grid = cus;
    }
    if (grid < 0) return;
    if (hipMemsetAsync((char*)d_ws + WS_CTL, 0, CTL_BYTES, stream) != hipSuccess) return;
    Params p{};
    p.x = (const float*)d_in[0]; p.meta = (const float*)d_in[1]; p.norm_mix = (const float*)d_in[2]; p.norm_ffn = (const float*)d_in[3]; p.norm_final = (const float*)d_in[4];
    p.ab_w_in = (const float*)d_in[5]; p.ab_q_norm = (const float*)d_in[6]; p.ab_kv_norm = (const float*)d_in[7]; p.ab_w_uq = (const float*)d_in[8]; p.ab_w_ukv = (const float*)d_in[9];
    p.ab_rpb = (const float*)d_in[10]; p.ab_w_out = (const float*)d_in[11]; p.c_w_in = (const float*)d_in[12]; p.c_sinks = (const float*)d_in[13]; p.c_w_out = (const float*)d_in[14];
    p.ec_w_router = (const float*)d_in[15]; p.ec_w_gate = (const float*)d_in[16]; p.ec_w_up = (const float*)d_in[17]; p.ec_w_down = (const float*)d_in[18];
    p.out = (float*)d_out; p.ws = (unsigned char*)d_ws;
    hipLaunchKernelGGL(fwd_kernel, dim3(grid), dim3(NTHREADS), LDS_BYTES, stream, p);
    const hipError_t le = hipPeekAtLastError();
    if (le != hipSuccess) fprintf(stderr, "kernel_launch: launch failed: %s\n", hipGetErrorName(le));
}
```

```cpp
#include <hip/hip_runtime.h>
#include <cstdio>
#include <cstdint>

#define GAS __attribute__((address_space(1)))
#define LAS __attribute__((address_space(3)))
typedef unsigned short bf16;
typedef short bf16x8 __attribute__((ext_vector_type(8)));
typedef short s16x4 __attribute__((ext_vector_type(4)));
typedef float f32x2 __attribute__((ext_vector_type(2)));
typedef float f32x4 __attribute__((ext_vector_type(4)));
typedef float f32x16 __attribute__((ext_vector_type(16)));
typedef unsigned u32x2 __attribute__((ext_vector_type(2)));
typedef unsigned u32x4 __attribute__((ext_vector_type(4)));

constexpr int D = 2048, NBATCH = 2, SEQ = 16384, NMETA = 16, LTOK = 16400, NTOK = 32800, NR = 33024, RMETA = 32768;
constexpr int ZW = 4352, ZQL = 0, ZKVL = 512, ZNAQ = 1024, ZNAK = 2048, ZNAV = 3072, ZKR = 4096;
constexpr int QW = 1536, KCW = 1536, VMW = 1024, Z1W = 2560, AOW = 2048;
constexpr int NE = 16, CAP = 2050, XPE = 4352, XROWS = NE * XPE;
constexpr float EPS = 1e-6f, LOG2E = 1.4426950408889634f;
constexpr float C_MLA = 0.07216878364870322f * LOG2E, C_NA = 0.08838834764831845f * LOG2E, C_SWA = 0.125f * LOG2E;
constexpr int NWAVES = 8, NTHREADS = 512;

constexpr size_t al256(size_t x) { return (x + 255) & ~(size_t)255; }
constexpr size_t WS_CTL = 0, CTL_BYTES = 1u << 20;
constexpr size_t WS_ROPE = WS_CTL + CTL_BYTES;
constexpr size_t WS_RSQ = al256(WS_ROPE + (size_t)LTOK * 32 * 2 * 4);
constexpr size_t WS_RSKV = al256(WS_RSQ + (size_t)NR * 4);
constexpr size_t WS_AFF = al256(WS_RSKV + (size_t)NR * 4);
constexpr size_t WS_TOKSLOT = al256(WS_AFF + (size_t)32 * LTOK * 4);
constexpr size_t WS_SLOTTOK = al256(WS_TOKSLOT + (size_t)32 * LTOK * 4);
constexpr size_t WS_XGATE = al256(WS_SLOTTOK + (size_t)32 * CAP * 4);
constexpr size_t WS_XMAP = al256(WS_XGATE + (size_t)XROWS * 4);
constexpr size_t WS_PART = al256(WS_XMAP + (size_t)XROWS * 4);
constexpr size_t WS_WIN0 = al256(WS_PART + (size_t)2 * 8 * 8 * 16 * 132 * 4);
constexpr size_t WS_WUQ = al256(WS_WIN0 + (size_t)ZW * D * 2);
constexpr size_t WS_WUKV = al256(WS_WUQ + (size_t)1536 * 512 * 2);
constexpr size_t WS_WOUT0 = al256(WS_WUKV + (size_t)2048 * 512 * 2);
constexpr size_t WS_WIN1 = al256(WS_WOUT0 + (size_t)D * D * 2);
constexpr size_t WS_WOUT1 = al256(WS_WIN1 + (size_t)Z1W * D * 2);
constexpr size_t WS_WGU = al256(WS_WOUT1 + (size_t)D * D * 2);
constexpr size_t WS_WD = al256(WS_WGU + (size_t)NE * 4096 * D * 2);
constexpr size_t WS_H = al256(WS_WD + (size_t)NE * D * D * 2);
constexpr size_t WS_RSF = al256(WS_H + (size_t)NR * D * 2);
constexpr size_t WS_XRS = al256(WS_RSF + (size_t)NR * 4);
constexpr size_t WS_RSM = al256(WS_XRS + (size_t)XROWS * 4);
static_assert(WS_RSM + (size_t)NR * 4 <= WS_H + (size_t)NR * D * 4, "h region");
constexpr size_t WS_U = al256(WS_H + (size_t)NR * D * 4);
constexpr size_t WS_R = al256(WS_U + (size_t)NR * D * 2);
constexpr size_t WS_Z = WS_R;
constexpr size_t WS_Q = al256(WS_Z + (size_t)NR * ZW * 2);
constexpr size_t WS_KC = al256(WS_Q + (size_t)NR * QW * 2);
constexpr size_t WS_VM = al256(WS_KC + (size_t)NR * KCW * 2);
constexpr size_t WS_AO = al256(WS_VM + (size_t)NR * VMW * 2);
constexpr size_t WS_END_ATT = al256(WS_AO + (size_t)NR * AOW * 2);
constexpr size_t WS_XS = WS_R;
constexpr size_t WS_HMID = al256(WS_XS + (size_t)XROWS * D * 2);
constexpr size_t WS_END_MOE = al256(WS_HMID + (size_t)XROWS * D * 2);
constexpr size_t WS_END = WS_END_ATT > WS_END_MOE ? WS_END_ATT : WS_END_MOE;
static_assert(WS_END < (size_t)2000 * 1024 * 1024, "workspace map must fit 2 GiB with margin");

constexpr int CW_BAR = 4096, CW_TICKET = 65536;

constexpr int LDS_BYTES = 147456;
constexpr int MISC_OFF = 147456 - 256;

__device__ __forceinline__ unsigned f2bf(float f) { unsigned u = __builtin_bit_cast(unsigned, f); return (u + 0x7fffu + ((u >> 16) & 1u)) >> 16; }
__device__ __forceinline__ unsigned pk2(float lo, float hi) { return f2bf(lo) | (f2bf(hi) << 16); }
__device__ __forceinline__ float bf2f(unsigned short x) { return __builtin_bit_cast(float, (unsigned)x << 16); }
__device__ __forceinline__ float bflo(unsigned w) { return __builtin_bit_cast(float, w << 16); }
__device__ __forceinline__ float bfhi(unsigned w) { return __builtin_bit_cast(float, w & 0xffff0000u); }
__device__ __forceinline__ float wave_sum(float v) {
#pragma unroll
    for (int o = 1; o < 64; o <<= 1) v += __shfl_xor(v, o);
    return v;
}
#define LDS_WAIT() asm volatile("s_waitcnt lgkmcnt(0)" ::: "memory")

#define XB_TMO      128
#define XB_XCNT(j)  (256  + 64 * (j))
#define XB_XSUB(j)  (1280 + 64 * (j))
#define XB_XGEN(j)  (2304 + 64 * (j))
#define XB_TOP      3328
#define XB_TOPGEN   3392
#define XCD_BAR_WORDS 3456
#define XB_SPIN_CAP (1u << 22)

__device__ __forceinline__ unsigned xb_ld(unsigned* p)              { return __hip_atomic_load(p, __ATOMIC_RELAXED, __HIP_MEMORY_SCOPE_AGENT); }
__device__ __forceinline__ unsigned xb_add(unsigned* p, unsigned v) { return __hip_atomic_fetch_add(p, v, __ATOMIC_RELAXED, __HIP_MEMORY_SCOPE_AGENT); }
__device__ __forceinline__ unsigned xb_xcc_id() { return (unsigned)__builtin_amdgcn_readfirstlane((int)((unsigned)__builtin_amdgcn_s_getreg((3 << 11) | 20) & 0xFu)); }
#define XB_SPIN(cond, bar) do { unsigned _sp = 0; while (cond) { __builtin_amdgcn_s_sleep(1); \
    if ((++_sp & 255u) == 0u) { if (xb_ld(&(bar)[XB_TMO])) break; if (_sp > XB_SPIN_CAP) { atomicAdd(&(bar)[XB_TMO], 1u); break; } } } } while (0)

struct XcdBarrier { unsigned* bar; unsigned x; volatile LAS unsigned* st; };

__device__ __forceinline__ XcdBarrier xcd_barrier_post(unsigned* bar, volatile LAS unsigned* st) {
    XcdBarrier b; b.bar = bar; b.x = xb_xcc_id(); b.st = st;
    if (threadIdx.x == 0) (void)xb_add(&bar[XB_XCNT(b.x)], 1u);
    return b;
}
__device__ __forceinline__ void xcd_barrier_complete(unsigned* bar, unsigned x, unsigned& nloc, unsigned& nx) {
    const unsigned G = gridDim.x * gridDim.y * gridDim.z;
    unsigned sum, cnt, mine, sp = 0u;
    for (;;) {
        sum = 0u; cnt = 0u; mine = 0u;
#pragma unroll
        for (unsigned j = 0; j < 16; ++j) { const unsigned c = xb_ld(&bar[XB_XCNT(j)]); sum += c; cnt += (c > 0u) ? 1u : 0u; mine = (j == x) ? c : mine; }
        if (sum == G) break;
        __builtin_amdgcn_s_sleep(1);
        if ((++sp & 255u) == 0u) { if (xb_ld(&bar[XB_TMO])) break; if (sp > XB_SPIN_CAP) { atomicAdd(&bar[XB_TMO], 1u); break; } }
    }
    nloc = mine > 0u ? mine : 1u; nx = cnt > 0u ? cnt : 1u;
}
__device__ __forceinline__ void xcd_barrier(const XcdBarrier& b) {
    asm volatile("s_waitcnt vmcnt(0)" ::: "memory");
    __syncthreads();
    if (threadIdx.x == 0) {
        unsigned* bar = b.bar; asm volatile("" : "+s"(bar));
        __builtin_amdgcn_s_waitcnt(0);
        const unsigned bx_ = xb_xcc_id();
        unsigned nloc = b.st[0], nx = b.st[1];
        if (nloc == 0u) { xcd_barrier_complete(bar, bx_, nloc, nx); b.st[0] = nloc; b.st[1] = nx; }
        const unsigned old = xb_add(&bar[XB_XSUB(bx_)], 1u);
        const unsigned gen = old / nloc;
        if (old + 1u == (gen + 1u) * nloc) {
            __builtin_amdgcn_fence(__ATOMIC_RELEASE, "agent");
            asm volatile("s_waitcnt vmcnt(0)" ::: "memory");
            const unsigned og = xb_add(&bar[XB_TOP], 1u);
            const unsigned tg = og / nx;
            if (og + 1u == (tg + 1u) * nx) xb_add(&bar[XB_TOPGEN], 1u);
            else XB_SPIN(xb_ld(&bar[XB_TOPGEN]) == tg, bar);
            __builtin_amdgcn_fence(__ATOMIC_ACQUIRE, "agent");
            xb_add(&bar[XB_XGEN(bx_)], 1u);
            asm volatile("s_waitcnt vmcnt(0)" ::: "memory");
        } else {
            XB_SPIN(xb_ld(&bar[XB_XGEN(bx_)]) == gen, bar);
            __builtin_amdgcn_fence(__ATOMIC_ACQUIRE, "agent");
            asm volatile("s_waitcnt vmcnt(0)" ::: "memory");
        }
    }
    __syncthreads();
}

namespace pg8 {
constexpr int BM = 256, BK = 64, HALF = 128, HTB = HALF * BK * 2, STAGE_BYTES = 8 * HTB, NXCD = 8, WGM = 8;
__host__ __device__ __forceinline__ int lds_byte(int r, int c) { const int st = (r >> 4) * 2 + (c >> 5), rr = r & 15, cc = c & 31, ob = rr * 64 + cc * 2; return st * 1024 + (ob ^ (((ob >> 9) & 1) << 5)); }
__host__ __device__ __forceinline__ void stage_rc(int b, int& R, int& C) { const int st = b / 1024, sb = b % 1024, swz = sb ^ (((sb >> 9) & 1) << 5); R = (st >> 1) * 16 + swz / 64; C = (st & 1) * 32 + (swz % 64) / 2; }
__host__ __device__ __forceinline__ int perm32(int rho) { const int n = rho >> 4, i = rho & 15; return 8 * (i >> 2) + 4 * n + (i & 3); }

struct Unit { int pm, pn, pb; };
struct Gemm { const bf16* A; const bf16* Bt; int lda, ldb, K; const int* amap; };

struct TileOrder {
    int nM, nN, nwg, G, c, grp;
    __device__ void init(int nM_, int nN_, int G_, int c_, int grp_) { nM = nM_; nN = nN_; nwg = nM * nN; G = G_; c = c_; grp = grp_; }
    __device__ bool next(int i, Unit& u) const {
        const long L = (long)i * G + c; if (L >= nwg) return false;
        int wgid = (int)L; { const int q = nwg / NXCD, r = nwg % NXCD, xcd = wgid % NXCD, off = wgid / NXCD; wgid = (xcd < r ? xcd * (q + 1) : r * (q + 1) + (xcd - r) * q) + off; }
        const int nig = WGM * nN, gid = wgid / nig, fm = gid * WGM, gsz = (nM - fm) < WGM ? (nM - fm) : WGM;
        u.pm = fm + ((wgid % nig) % gsz); u.pn = (wgid % nig) / gsz; u.pb = grp ? (u.pm / grp) * nN + u.pn : u.pn; return true;
    }
};

__device__ __forceinline__ unsigned cvt_pk_bf16(float lo, float hi) { unsigned r; asm volatile("v_cvt_pk_bf16_f32 %0, %1, %2" : "=v"(r) : "v"(lo), "v"(hi)); return r; }

struct EpiBf16S {
    static constexpr bool PERM = true;
    bf16* O; int ldc; const float* rowscale; int cs_lo, cs_hi; float cscale;
    __device__ __forceinline__ void operator()(const f32x4 (&acc)[2][2][4][2], const Unit& u, int wr, int wc, int fr, int fq) const {
        const int row0 = u.pm * BM + wr * 64 + fr, col0 = u.pn * BM + wc * 32 + 8 * fq;
        const float cs = (u.pn >= cs_lo && u.pn < cs_hi) ? cscale : 1.f;
#pragma unroll
        for (int ai = 0; ai < 2; ++ai)
#pragma unroll
            for (int m = 0; m < 4; ++m) { const int row = row0 + ai * HALF + m * 16; const float s = (rowscale ? rowscale[row] : 1.f) * cs; bf16* rowp = O + (size_t)row * ldc + col0;
#pragma unroll
                for (int bj = 0; bj < 2; ++bj) { const f32x4 v0 = acc[ai][bj][m][0] * s, v1 = acc[ai][bj][m][1] * s;
                    u32x4 w; w.x = cvt_pk_bf16(v0[0], v0[1]); w.y = cvt_pk_bf16(v0[2], v0[3]); w.z = cvt_pk_bf16(v1[0], v1[1]); w.w = cvt_pk_bf16(v1[2], v1[3]);
                    *(u32x4*)(rowp + bj * HALF) = w; } }
    }
};
struct EpiKV {
    static constexpr bool PERM = true;
    bf16* Kc; bf16* Vm; const float* rowscale;
    __device__ __forceinline__ void operator()(const f32x4 (&acc)[2][2][4][2], const Unit& u, int wr, int wc, int fr, int fq) const {
        const int row0 = u.pm * BM + wr * 64 + fr, cc = wc * 32 + 8 * fq;
#pragma unroll
        for (int ai = 0; ai < 2; ++ai)
#pragma unroll
            for (int m = 0; m < 4; ++m) { const int row = row0 + ai * HALF + m * 16; const float s = rowscale[row];
#pragma unroll
                for (int bj = 0; bj < 2; ++bj) { const f32x4 v0 = acc[ai][bj][m][0] * s, v1 = acc[ai][bj][m][1] * s;
                    u32x4 w; w.x = cvt_pk_bf16(v0[0], v0[1]); w.y = cvt_pk_bf16(v0[2], v0[3]); w.z = cvt_pk_bf16(v1[0], v1[1]); w.w = cvt_pk_bf16(v1[2], v1[3]);
                    bf16* p = bj == 0 ? Kc + (size_t)row * KCW + u.pn * 192 + cc : Vm + (size_t)row * VMW + u.pn * 128 + cc;
                    *(u32x4*)p = w; } }
    }
};
struct EpiResid {
    static constexpr bool PERM = true;
    bf16* Hm; int ldc; const float* X; const float* Mt;
    __device__ __forceinline__ void operator()(const f32x4 (&acc)[2][2][4][2], const Unit& u, int wr, int wc, int fr, int fq) const {
        const int row0 = u.pm * BM + wr * 64 + fr, col0 = u.pn * BM + wc * 32 + 8 * fq;
#pragma unroll
        for (int ai = 0; ai < 2; ++ai)
#pragma unroll
            for (int m = 0; m < 4; ++m) { const int row = row0 + ai * HALF + m * 16; bf16* rowp = Hm + (size_t)row * ldc + col0;
                if (X) {
                    const float* sp = (row < RMETA ? X + (size_t)row * ldc : Mt + (size_t)((row - RMETA) & 15) * ldc) + col0; const float z = row < NTOK ? 1.f : 0.f;
#pragma unroll
                    for (int bj = 0; bj < 2; ++bj) { const f32x4 v0 = *(const f32x4*)(sp + bj * HALF) * z + acc[ai][bj][m][0], v1 = *(const f32x4*)(sp + bj * HALF + 4) * z + acc[ai][bj][m][1];
                        u32x4 w; w.x = cvt_pk_bf16(v0[0], v0[1]); w.y = cvt_pk_bf16(v0[2], v0[3]); w.z = cvt_pk_bf16(v1[0], v1[1]); w.w = cvt_pk_bf16(v1[2], v1[3]);
                        *(u32x4*)(rowp + bj * HALF) = w; }
                } else {
#pragma unroll
                    for (int bj = 0; bj < 2; ++bj) { const u32x4 s = *(const u32x4*)(rowp + bj * HALF);
                        const f32x4 v0 = (f32x4){bflo(s.x), bfhi(s.x), bflo(s.y), bfhi(s.y)} + acc[ai][bj][m][0], v1 = (f32x4){bflo(s.z), bfhi(s.z), bflo(s.w), bfhi(s.w)} + acc[ai][bj][m][1];
                        u32x4 w; w.x = cvt_pk_bf16(v0[0], v0[1]); w.y = cvt_pk_bf16(v0[2], v0[3]); w.z = cvt_pk_bf16(v1[0], v1[1]); w.w = cvt_pk_bf16(v1[2], v1[3]);
                        *(u32x4*)(rowp + bj * HALF) = w; }
                }
            }
    }
};
struct EpiSwiGLU {
    static constexpr bool PERM = true;
    bf16* O; int ldc; const float* rowscale;
    __device__ __forceinline__ void operator()(const f32x4 (&acc)[2][2][4][2], const Unit& u, int wr, int wc, int fr, int fq) const {
        const int row0 = u.pm * BM + wr * 64 + fr, col0 = u.pn * HALF + wc * 32 + 8 * fq;
#pragma unroll
        for (int ai = 0; ai < 2; ++ai)
#pragma unroll
            for (int m = 0; m < 4; ++m) { const int row = row0 + ai * HALF + m * 16; bf16* rowp = O + (size_t)row * ldc + col0; float r[8]; const float rs = rowscale[row];
#pragma unroll
                for (int n = 0; n < 2; ++n)
#pragma unroll
                    for (int j = 0; j < 4; ++j) { const float g = acc[ai][0][m][n][j] * rs, up = acc[ai][1][m][n][j] * rs;
                        const float sg = g * __builtin_amdgcn_rcpf(1.f + __builtin_amdgcn_exp2f(-g * LOG2E)); r[n * 4 + j] = sg * up; }
                u32x4 w; w.x = cvt_pk_bf16(r[0], r[1]); w.y = cvt_pk_bf16(r[2], r[3]); w.z = cvt_pk_bf16(r[4], r[5]); w.w = cvt_pk_bf16(r[6], r[7]);
                *(u32x4*)rowp = w; }
    }
};

template <bool GATHER = false, class Epi, class Sched>
__device__ __forceinline__ void gemm_phase(LAS unsigned char* lds, const Gemm g, const Sched& S, const Epi& E) {
    int tid_ = threadIdx.x; asm volatile("" : "+v"(tid_));
    const int tid = tid_, wid = __builtin_amdgcn_readfirstlane(tid >> 6), lane = tid & 63, wr = wid >> 2, wc = wid & 3, fr = lane & 15, fq = lane >> 4;
    const int K = g.K, nt = K / BK;
    unsigned voffA[2], voffB[2];
#pragma unroll
    for (int i = 0; i < 2; ++i) { int R, C; stage_rc(tid * 16 + i * 8192, R, C); const int Rb = Epi::PERM ? ((R & ~31) + perm32(R & 31)) : R;
        voffA[i] = (unsigned)(R * g.lda + C) * 2u; voffB[i] = (unsigned)(Rb * g.ldb + C) * 2u; }
    int RA[2], CA[2];
#pragma unroll
    for (int i = 0; i < 2; ++i) stage_rc(tid * 16 + i * 8192, RA[i], CA[i]);
    unsigned offC[2][2], offN[2][2]; int rawN[2][2];
#define PG8_GRAW(pm_) do { _Pragma("unroll") for (int h_ = 0; h_ < 2; ++h_) _Pragma("unroll") for (int i_ = 0; i_ < 2; ++i_) rawN[h_][i_] = g.amap[(pm_) * BM + h_ * HALF + RA[i_]]; } while (0)
#define PG8_GCONV(dst) do { _Pragma("unroll") for (int h_ = 0; h_ < 2; ++h_) _Pragma("unroll") for (int i_ = 0; i_ < 2; ++i_) dst[h_][i_] = (unsigned)(rawN[h_][i_] * g.lda + CA[i_]) * 2u; } while (0)
    const size_t kstep = (size_t)(BK * 2);
    const size_t hstepA = (size_t)HALF * g.lda * 2, hstepB = (size_t)HALF * g.ldb * 2;
    const size_t tstepA = 2 * hstepA, tstepB = 2 * hstepB;
    const unsigned ldsw = (unsigned)wid * 1024u;
    const int aoff = lds_byte(wr * 64 + fr, fq * 8), boff = lds_byte(wc * 32 + fr, fq * 8);
#define PG8_SA(b, h) (((b) * 2 + (h)) * HTB)
#define PG8_SB(b, h) ((4 + (b) * 2 + (h)) * HTB)
#define PG8_STAGE(bufoff, gbase, voff) do { _Pragma("unroll") for (int _i = 0; _i < 2; ++_i) \
        __builtin_amdgcn_global_load_lds((const unsigned*)((const char*)(gbase) + (voff)[_i]), (LAS unsigned*)(lds + (bufoff) + ldsw + _i * 8192), 16, 0, 0); } while (0)
#define PG8_LDA(dst, b, h) do { _Pragma("unroll") for (int m = 0; m < 4; ++m) _Pragma("unroll") for (int k = 0; k < 2; ++k) dst[m][k] = *(const LAS bf16x8*)(lds + PG8_SA(b, h) + aoff + m * 2048 + k * 1024); } while (0)
#define PG8_LDB(dst, b, h) do { _Pragma("unroll") for (int n = 0; n < 2; ++n) _Pragma("unroll") for (int k = 0; k < 2; ++k) dst[n][k] = *(const LAS bf16x8*)(lds + PG8_SB(b, h) + boff + n * 2048 + k * 1024); } while (0)
#define PG8_MMA(ai, bj, At, Bt) do { __builtin_amdgcn_s_setprio(1); _Pragma("unroll") for (int m = 0; m < 4; ++m) _Pragma("unroll") for (int n = 0; n < 2; ++n) _Pragma("unroll") for (int k = 0; k < 2; ++k) \
        acc[ai][bj][m][n] = __builtin_amdgcn_mfma_f32_16x16x32_bf16(Bt[n][k], At[m][k], acc[ai][bj][m][n], 0, 0, 0); __builtin_amdgcn_s_setprio(0); } while (0)
#define PG8_WAIT_V(n) asm volatile("s_waitcnt vmcnt(" #n ")" ::: "memory")
#define PG8_WAIT_L(n) asm volatile("s_waitcnt lgkmcnt(" #n ")" ::: "memory")
#define PG8_BAR __builtin_amdgcn_s_barrier()
#define PG8_SCHED __builtin_amdgcn_sched_barrier(0)
    Unit cur, nxt; int ui = 0;
    if (!S.next(0, cur)) return;
    f32x4 acc[2][2][4][2];
#pragma unroll
    for (int a = 0; a < 2; ++a)
#pragma unroll
        for (int b = 0; b < 2; ++b)
#pragma unroll
            for (int m = 0; m < 4; ++m)
#pragma unroll
                for (int n = 0; n < 2; ++n) acc[a][b][m][n] = (f32x4){0.f, 0.f, 0.f, 0.f};
    bf16x8 At[4][2], B0[2][2], B1[2][2];
    const char* cA = GATHER ? (const char*)g.A : (const char*)g.A + (size_t)cur.pm * tstepA; const char* cB = (const char*)g.Bt + (size_t)cur.pb * tstepB;
    if constexpr (GATHER) { PG8_GRAW(cur.pm); PG8_GCONV(offC); }
#define PG8_STAGE_A(bufoff, kbase, h_, offs) do { if constexpr (GATHER) { PG8_STAGE(bufoff, kbase, offs[h_]); } else { PG8_STAGE(bufoff, (kbase) + (h_) * hstepA, voffA); } } while (0)
    PG8_STAGE(PG8_SB(0, 0), cB, voffB); PG8_STAGE(PG8_SB(0, 1), cB + hstepB, voffB); PG8_STAGE_A(PG8_SA(0, 0), cA, 0, offC); PG8_STAGE_A(PG8_SA(0, 1), cA, 1, offC);
    if (wr == 1) PG8_BAR;
    PG8_WAIT_V(2); PG8_BAR;
    PG8_STAGE(PG8_SB(1, 0), cB + kstep, voffB); PG8_STAGE_A(PG8_SA(1, 0), cA + kstep, 0, offC); PG8_STAGE(PG8_SB(1, 1), cB + hstepB + kstep, voffB);
    PG8_WAIT_V(6); PG8_BAR;
    for (;;) {
        const bool has_next = S.next(ui + 1, nxt);
        const char* nA = GATHER ? cA : (has_next ? (const char*)g.A + (size_t)nxt.pm * tstepA : cA); const char* nB = has_next ? (const char*)g.Bt + (size_t)nxt.pb * tstepB : cB;
        if constexpr (GATHER) { if (has_next) PG8_GRAW(nxt.pm); }
        for (int t = 0; t < nt; t += 2) {
            const bool last = (t == nt - 2);
            const char* a1 = cA + (size_t)(t + 1) * kstep;
            const char* a2 = last ? nA : cA + (size_t)(t + 2) * kstep; const char* b2 = last ? nB : cB + (size_t)(t + 2) * kstep;
            unsigned off2[2][2];
            if constexpr (GATHER) { if (last && has_next) { PG8_GCONV(offN); } else if (last) { _Pragma("unroll") for (int h_ = 0; h_ < 2; ++h_) _Pragma("unroll") for (int i_ = 0; i_ < 2; ++i_) offN[h_][i_] = offC[h_][i_]; }
                _Pragma("unroll") for (int h_ = 0; h_ < 2; ++h_) _Pragma("unroll") for (int i_ = 0; i_ < 2; ++i_) off2[h_][i_] = last ? offN[h_][i_] : offC[h_][i_]; }
            const char* a3 = a2 + kstep; const char* b3 = b2 + kstep;
            PG8_LDB(B0, 0, 0); PG8_LDB(B1, 0, 1); PG8_SCHED; PG8_LDA(At, 0, 0); PG8_STAGE_A(PG8_SA(1, 1), a1, 1, offC);
            PG8_WAIT_V(8); PG8_WAIT_L(0); PG8_BAR; PG8_MMA(0, 0, At, B0); PG8_MMA(0, 1, At, B1); PG8_BAR; PG8_SCHED;
            PG8_LDA(At, 0, 1); PG8_STAGE(PG8_SB(0, 0), b2, voffB); PG8_STAGE(PG8_SB(0, 1), b2 + hstepB, voffB); PG8_STAGE_A(PG8_SA(0, 0), a2, 0, off2);
            PG8_WAIT_V(8); PG8_WAIT_L(0); PG8_BAR; PG8_MMA(1, 0, At, B0); PG8_MMA(1, 1, At, B1); PG8_BAR; PG8_SCHED;
            PG8_LDB(B0, 1, 0); PG8_LDB(B1, 1, 1); PG8_SCHED; PG8_LDA(At, 1, 0); PG8_STAGE_A(PG8_SA(0, 1), a2, 1, off2);
            PG8_WAIT_V(8); PG8_WAIT_L(0); PG8_BAR; PG8_MMA(0, 0, At, B0); PG8_MMA(0, 1, At, B1); PG8_BAR; PG8_SCHED;
            PG8_LDA(At, 1, 1); PG8_STAGE(PG8_SB(1, 0), b3, voffB); PG8_STAGE(PG8_SB(1, 1), b3 + hstepB, voffB); PG8_STAGE_A(PG8_SA(1, 0), a3, 0, off2);
            PG8_WAIT_V(8); PG8_WAIT_L(0); PG8_BAR; PG8_MMA(1, 0, At, B0); PG8_MMA(1, 1, At, B1); PG8_BAR; PG8_SCHED;
        }
        if (wr == 0) PG8_BAR;
        E(acc, cur, wr, wc, fr, fq);
        if (!has_next) break;
#pragma unroll
        for (int a = 0; a < 2; ++a)
#pragma unroll
            for (int b = 0; b < 2; ++b)
#pragma unroll
                for (int m = 0; m < 4; ++m)
#pragma unroll
                    for (int n = 0; n < 2; ++n) acc[a][b][m][n] = (f32x4){0.f, 0.f, 0.f, 0.f};
        cur = nxt; cA = nA; cB = nB; ++ui;
        if constexpr (GATHER) { _Pragma("unroll") for (int h_ = 0; h_ < 2; ++h_) _Pragma("unroll") for (int i_ = 0; i_ < 2; ++i_) offC[h_][i_] = offN[h_][i_]; }
        if (wr == 1) PG8_BAR;
    }
    PG8_WAIT_V(0);
    PG8_BAR;
#undef PG8_SA
#undef PG8_SB
#undef PG8_STAGE
#undef PG8_STAGE_A
#undef PG8_GRAW
#undef PG8_GCONV
#undef PG8_LDA
#undef PG8_LDB
#undef PG8_MMA
#undef PG8_WAIT_V
#undef PG8_WAIT_L
#undef PG8_BAR
#undef PG8_SCHED
}
}

namespace att {
#define SBAR() __builtin_amdgcn_sched_barrier(0)
constexpr float NEGBIG = -1e30f, THR = 8.f;
__device__ __forceinline__ int crow(int r, int hi) { return (r & 3) + 8 * (r >> 2) + 4 * hi; }
typedef __bf16 bf16x2_t __attribute__((ext_vector_type(2)));
__device__ __forceinline__ unsigned cvtpk(float lo, float hi) { f32x2 v = {lo, hi}; bf16x2_t b = __builtin_convertvector(v, bf16x2_t); return __builtin_bit_cast(unsigned, b); }

__device__ __forceinline__ void partialSM(f32x16& p0, f32x16& p1, float& m_reg, float& alpha) {
    float pmax = p0[0];
#pragma unroll
    for (int r = 1; r < 16; ++r) pmax = fmaxf(pmax, p0[r]);
#pragma unroll
    for (int r = 0; r < 16; ++r) pmax = fmaxf(pmax, p1[r]);
    { auto rr = __builtin_amdgcn_permlane32_swap(__float_as_uint(pmax), __float_as_uint(pmax), false, false);
      pmax = fmaxf(__uint_as_float(rr[0]), __uint_as_float(rr[1])); }
    float mn;
    if (__builtin_expect(__all(pmax - m_reg <= THR), 1)) { mn = m_reg; alpha = 1.f; }
    else { mn = fmaxf(m_reg, pmax); alpha = __builtin_amdgcn_exp2f(m_reg - mn); m_reg = mn; }
#pragma unroll
    for (int r = 0; r < 16; ++r) { p0[r] = p0[r] - mn; p1[r] = p1[r] - mn; }
#pragma unroll
    for (int r = 0; r < 16; ++r) p0[r] = __builtin_amdgcn_exp2f(p0[r]);
}
__device__ __forceinline__ void finishSM(f32x16& p0, f32x16& p1, float alpha, float& l_reg, bf16x8& pa0, bf16x8& pa1, bf16x8& pa2, bf16x8& pa3) {
#pragma unroll
    for (int r = 0; r < 16; ++r) p1[r] = __builtin_amdgcn_exp2f(p1[r]);
    float ps = 0;
#pragma unroll
    for (int r = 0; r < 16; ++r) ps += p0[r];
#pragma unroll
    for (int r = 0; r < 16; ++r) ps += p1[r];
    { auto rr = __builtin_amdgcn_permlane32_swap(__float_as_uint(ps), __float_as_uint(ps), false, false);
      ps = __uint_as_float(rr[0]) + __uint_as_float(rr[1]); }
    l_reg = l_reg * alpha + ps;
#define PK4(P, BASE, OUT) do { unsigned a0 = cvtpk(P[BASE + 0], P[BASE + 1]), a1 = cvtpk(P[BASE + 2], P[BASE + 3]);   \
    unsigned b0 = cvtpk(P[BASE + 4], P[BASE + 5]), b1 = cvtpk(P[BASE + 6], P[BASE + 7]);                              \
    auto r0 = __builtin_amdgcn_permlane32_swap(a0, b0, false, false); auto r1 = __builtin_amdgcn_permlane32_swap(a1, b1, false, false); \
    u32x4 w = {r0[0], r1[0], r0[1], r1[1]}; OUT = __builtin_bit_cast(bf16x8, w); } while (0)
    PK4(p0, 0, pa0); PK4(p0, 8, pa1); PK4(p1, 0, pa2); PK4(p1, 8, pa3);
#undef PK4
}
template <int NQC>
__device__ __forceinline__ void qkt(f32x16& p0, f32x16& p1, const char* Ks, const bf16x8* qr, int r32, int hi) {
    p0 = f32x16{}; p1 = f32x16{};
#pragma unroll
    for (int d0 = 0; d0 < NQC; ++d0) { const int c = 2 * d0 + hi; const int a = c * 1024 + ((r32 ^ (c & 7)) << 4);
        const bf16x8 b0 = *reinterpret_cast<const bf16x8*>(Ks + a);
        const bf16x8 b1 = *reinterpret_cast<const bf16x8*>(Ks + a + 512);
        p0 = __builtin_amdgcn_mfma_f32_32x32x16_bf16(b0, qr[d0], p0, 0, 0, 0);
        p1 = __builtin_amdgcn_mfma_f32_32x32x16_bf16(b1, qr[d0], p1, 0, 0, 0); }
}
template <int NDB> __device__ __forceinline__ int v_st(int k, int c) { const int kk = (k & ~0xC) | ((k & 4) << 1) | ((k & 8) >> 1); return ((kk >> 3) * NDB + (c >> 5)) * 512 + ((kk & 7) * 32 + (c & 31)) * 2; }
__device__ __forceinline__ int v_rd_base(int lane) { return ((lane & 3) << 3) | (((lane >> 2) & 3) << 6) | (((lane >> 4) & 1) << 5) | (((lane >> 5) & 1) << 8); }
template <int NDB> constexpr int v_rd_off(int d0, int ks, int half) { return d0 * 512 + ks * (NDB * 1024) + half * (NDB * 512); }
template <int OFF> __device__ __forceinline__ s16x4 tr_read(int vb) { s16x4 r; asm volatile("ds_read_b64_tr_b16 %0, %1 offset:%2" : "=&v"(r) : "v"(vb), "i"(OFF) : "memory"); return r; }
template <int D0, int NDB> __device__ __forceinline__ void pv_one(f32x16& od, int vb, bf16x8 pa0, bf16x8 pa1, bf16x8 pa2, bf16x8 pa3) {
    const s16x4 l0 = tr_read<v_rd_off<NDB>(D0, 0, 0)>(vb), h0 = tr_read<v_rd_off<NDB>(D0, 0, 1)>(vb), l1 = tr_read<v_rd_off<NDB>(D0, 1, 0)>(vb), h1 = tr_read<v_rd_off<NDB>(D0, 1, 1)>(vb);
    const s16x4 l2 = tr_read<v_rd_off<NDB>(D0, 2, 0)>(vb), h2 = tr_read<v_rd_off<NDB>(D0, 2, 1)>(vb), l3 = tr_read<v_rd_off<NDB>(D0, 3, 0)>(vb), h3 = tr_read<v_rd_off<NDB>(D0, 3, 1)>(vb);
    asm volatile("s_waitcnt lgkmcnt(0)" ::: "memory"); SBAR();
#define PK(L, H) (bf16x8){L[0], L[1], L[2], L[3], H[0], H[1], H[2], H[3]}
    od = __builtin_amdgcn_mfma_f32_32x32x16_bf16(pa0, PK(l0, h0), od, 0, 0, 0);
    od = __builtin_amdgcn_mfma_f32_32x32x16_bf16(pa1, PK(l1, h1), od, 0, 0, 0);
    od = __builtin_amdgcn_mfma_f32_32x32x16_bf16(pa2, PK(l2, h2), od, 0, 0, 0);
    od = __builtin_amdgcn_mfma_f32_32x32x16_bf16(pa3, PK(l3, h3), od, 0, 0, 0);
#undef PK
}
template <int NDB> __device__ __forceinline__ void pv_all(f32x16* o, int vb, bf16x8 pa0, bf16x8 pa1, bf16x8 pa2, bf16x8 pa3) {
    pv_one<0, NDB>(o[0], vb, pa0, pa1, pa2, pa3); pv_one<1, NDB>(o[1], vb, pa0, pa1, pa2, pa3);
    if constexpr (NDB == 4) { pv_one<2, NDB>(o[2], vb, pa0, pa1, pa2, pa3); pv_one<3, NDB>(o[3], vb, pa0, pa1, pa2, pa3); }
}
__device__ __forceinline__ void mask_meta(f32x16& p0, f32x16& p1) {
#pragma unroll
    for (int r = 8; r < 16; ++r) p0[r] = NEGBIG;
#pragma unroll
    for (int r = 0; r < 16; ++r) p1[r] = NEGBIG;
}
__device__ __forceinline__ void mask_all(f32x16& p0, f32x16& p1) {
#pragma unroll
    for (int r = 0; r < 16; ++r) { p0[r] = NEGBIG; p1[r] = NEGBIG; }
}

template <int DQK, int DV, class P>
__device__ __forceinline__ void attn_unit(const P& pol, char* lds) {
    constexpr int NQC = DQK / 16, NDB = DV / 32, KB = 64 * DQK * 2, VB = 64 * DV * 2;
    constexpr int KCH = DQK / 8, VCH = DV / 8, NKS = (64 * KCH) / 512, NVS = (64 * VCH) / 512;
    int tid_ = threadIdx.x; asm volatile("" : "+v"(tid_));
    const int tid = tid_, wid = tid >> 6, lane = tid & 63, r32 = lane & 31, hi = lane >> 5;
    char* V_lds = lds; char* K_lds = lds + 3 * VB;
    float* ws = (float*)(lds + 3 * VB + 3 * KB) + wid * 64; float* li_l = ws; float* al_l = ws + 32;
    float m_reg = NEGBIG, l_reg = 0.f; f32x16 o[NDB];
#pragma unroll
    for (int d = 0; d < NDB; ++d) o[d] = f32x16{};
    bf16x8 qr[NQC];
    { const bf16* Qw = pol.qptr(wid * 32 + r32) + hi * 8;
#pragma unroll
      for (int d0 = 0; d0 < NQC; ++d0) qr[d0] = *reinterpret_cast<const bf16x8*>(Qw + d0 * 16); }
    pol.qfix(qr, wid * 32 + r32, hi);
    const int vb0 = (int)(uintptr_t)V_lds + v_rd_base(lane);
    bf16x8 ks[NKS], vs[NVS];
    const int srow = tid >> 3, c0 = tid & 7;
    const unsigned koff = (unsigned)(srow * pol.kstride + c0 * 8) * 2u, voff = (unsigned)(srow * pol.vstride + c0 * 8) * 2u;
    const int kst = c0 * 1024 + ((srow ^ c0) << 4), vst = v_st<NDB>(srow, c0 * 8);
    static_assert(NKS == KCH / 8 && NVS == VCH / 8, "staging map");
#define SLOAD(t) do { const char* kb_ = (const char*)pol.kbase(t) + koff; const char* vb_ = (const char*)pol.vbase(t) + voff; \
    _Pragma("unroll") for (int i = 0; i < NKS; ++i) ks[i] = *reinterpret_cast<const bf16x8*>(kb_ + i * 128); \
    _Pragma("unroll") for (int i = 0; i < NVS; ++i) vs[i] = *reinterpret_cast<const bf16x8*>(vb_ + i * 128); } while (0)
#define SWRITE(b) do { \
    _Pragma("unroll") for (int i = 0; i < NKS; ++i) *reinterpret_cast<bf16x8*>(K_lds + (b) * KB + kst + i * 8192) = ks[i]; \
    _Pragma("unroll") for (int i = 0; i < NVS; ++i) *reinterpret_cast<bf16x8*>(V_lds + (b) * VB + vst + i * 1024) = vs[i]; } while (0)
#define RESC(a) do { if (__any((a) < 1.f)) { if (hi == 0) al_l[r32] = (a); asm volatile("s_waitcnt lgkmcnt(0)" ::: "memory"); \
    _Pragma("unroll") for (int d = 0; d < NDB; ++d) _Pragma("unroll") for (int r = 0; r < 16; ++r) o[d][r] *= al_l[crow(r, hi)]; } } while (0)
#define XFORM(pa_, pb_, t) do { if (pol.needs_xform(t)) pol.xform(pa_, pb_, (t), wid, r32, hi); } while (0)
    f32x16 pA0, pA1, pB0, pB1; float alA, alB; bf16x8 pa0, pa1, pa2, pa3; const int NT = pol.nt;
    if constexpr (DQK <= 128) {
        bf16x8 ks2[NKS], vs2[NVS];
        SLOAD(0);
        { const char* kb_ = (const char*)pol.kbase(1) + koff; const char* vb_ = (const char*)pol.vbase(1) + voff;
#pragma unroll
          for (int i = 0; i < NKS; ++i) ks2[i] = *reinterpret_cast<const bf16x8*>(kb_ + i * 128);
#pragma unroll
          for (int i = 0; i < NVS; ++i) vs2[i] = *reinterpret_cast<const bf16x8*>(vb_ + i * 128); }
        asm volatile("s_waitcnt vmcnt(0)" ::: "memory"); SWRITE(0);
#pragma unroll
        for (int i = 0; i < NKS; ++i) *reinterpret_cast<bf16x8*>(K_lds + KB + kst + i * 8192) = ks2[i];
#pragma unroll
        for (int i = 0; i < NVS; ++i) *reinterpret_cast<bf16x8*>(V_lds + VB + vst + i * 1024) = vs2[i];
        __syncthreads();
        qkt<NQC>(pA0, pA1, K_lds, qr, r32, hi); XFORM(pA0, pA1, 0); partialSM(pA0, pA1, m_reg, alA);
    } else {
    SLOAD(0); asm volatile("s_waitcnt vmcnt(0)" ::: "memory"); SWRITE(0); __syncthreads();
    qkt<NQC>(pA0, pA1, K_lds, qr, r32, hi); XFORM(pA0, pA1, 0); partialSM(pA0, pA1, m_reg, alA);
    SLOAD(1); asm volatile("s_waitcnt vmcnt(0)" ::: "memory"); SWRITE(1); __syncthreads();
    }
    int bprev = 0, bcur = 1, bnext = 2;
#define ROT3() do { bprev = bcur; bcur = bnext; bnext = (bnext == 2) ? 0 : bnext + 1; } while (0)
    for (int j = 1; j + 1 < NT; j += 2) {
        SBAR(); qkt<NQC>(pB0, pB1, K_lds + bcur * KB, qr, r32, hi);
        finishSM(pA0, pA1, alA, l_reg, pa0, pa1, pa2, pa3); SBAR();
        SLOAD(j + 1); SBAR();
        pv_all<NDB>(o, vb0 + bprev * VB, pa0, pa1, pa2, pa3); XFORM(pB0, pB1, j); partialSM(pB0, pB1, m_reg, alB);
        asm volatile("s_waitcnt vmcnt(0)" ::: "memory"); SWRITE(bnext);
        RESC(alB); __syncthreads(); ROT3();
        SBAR(); qkt<NQC>(pA0, pA1, K_lds + bcur * KB, qr, r32, hi);
        finishSM(pB0, pB1, alB, l_reg, pa0, pa1, pa2, pa3); SBAR();
        SLOAD(j + 2); SBAR();
        pv_all<NDB>(o, vb0 + bprev * VB, pa0, pa1, pa2, pa3); XFORM(pA0, pA1, j + 1); partialSM(pA0, pA1, m_reg, alA);
        asm volatile("s_waitcnt vmcnt(0)" ::: "memory"); SWRITE(bnext);
        RESC(alA); __syncthreads(); ROT3();
    }
    SBAR(); qkt<NQC>(pB0, pB1, K_lds + bcur * KB, qr, r32, hi);
    finishSM(pA0, pA1, alA, l_reg, pa0, pa1, pa2, pa3); SBAR();
    pv_all<NDB>(o, vb0 + bprev * VB, pa0, pa1, pa2, pa3); XFORM(pB0, pB1, NT - 1); partialSM(pB0, pB1, m_reg, alB);
    RESC(alB);
    finishSM(pB0, pB1, alB, l_reg, pa0, pa1, pa2, pa3); SBAR();
    pv_all<NDB>(o, vb0 + bcur * VB, pa0, pa1, pa2, pa3);
#undef ROT3
    l_reg += pol.sink_term(m_reg);
    if (pol.partial()) {
        if (wid == 0) {
            if (lane < 16) { float* pp = pol.pptr(lane); pp[128] = m_reg; pp[129] = l_reg; }
#pragma unroll
            for (int r = 0; r < 8; ++r) { float* pp = pol.pptr(crow(r, hi));
#pragma unroll
                for (int d0 = 0; d0 < NDB; ++d0) pp[d0 * 32 + r32] = o[d0][r]; }
        }
    } else {
    if (hi == 0) li_l[r32] = l_reg; asm volatile("s_waitcnt lgkmcnt(0)" ::: "memory");
    float rli[16];
#pragma unroll
    for (int r = 0; r < 16; ++r) rli[r] = __builtin_amdgcn_rcpf(li_l[crow(r, hi)]);
#pragma unroll
    for (int r = 0; r < 16; ++r) { const int orow = wid * 32 + crow(r, hi);
        if (pol.ovalid(orow)) { bf16* op = pol.optr(orow);
#pragma unroll
            for (int d0 = 0; d0 < NDB; ++d0) op[d0 * 32 + r32] = (bf16)f2bf(o[d0][r] * rli[r]); } }
    }
    __syncthreads();
#undef SLOAD
#undef SWRITE
#undef RESC
#undef XFORM
}

__device__ __forceinline__ int unit_row(int b, int qb, int r) { int row = qb < 64 ? b * SEQ + qb * 256 + r : RMETA + 16 * b + r; return row < NR ? row : NR - 1; }

struct PolMLA {
    const bf16 *Kc, *Vm, *Q; bf16* O; float* part; const float* rope_; int b, h, qb, nt, kstride, vstride, split;
    __device__ __forceinline__ void init(const bf16* Kc_, const bf16* Vm_, const bf16* Q_, bf16* O_, float* part_, const float* rope__, int b_, int h_, int qb_, int split_) {
        Kc = Kc_; Vm = Vm_; Q = Q_; O = O_; part = part_; rope_ = rope__; b = b_; h = h_; qb = qb_; split = split_; kstride = KCW; vstride = VMW;
        nt = split < 0 ? 258 : (split == 0 ? 34 : 32); }
    __device__ __forceinline__ int krow0(int t) const {
        if (split < 0) return (t == 0 || t == 257) ? RMETA + 16 * b : b * SEQ + (t - 1) * 64;
        if (split == 0) return (t == 0 || t == 33) ? RMETA + 16 * b : b * SEQ + (t - 1) * 64;
        return b * SEQ + (32 * split + t) * 64; }
    __device__ __forceinline__ const bf16* kbase(int t) const { return Kc + (size_t)krow0(t) * KCW + h * 192; }
    __device__ __forceinline__ const bf16* vbase(int t) const { return Vm + (size_t)krow0(t) * VMW + h * 128; }
    __device__ __forceinline__ const bf16* qptr(int r) const { return Q + (size_t)unit_row(b, qb, r) * QW + h * 192; }
    __device__ __forceinline__ bf16* optr(int r) const { return O + (size_t)unit_row(b, qb, r) * AOW + h * 128; }
    __device__ __forceinline__ bool ovalid(int r) const { return qb < 64 || r < 16; }
    __device__ __forceinline__ bool needs_xform(int t) const { return split < 0 ? (t == 0 || t == 257) : (split == 0 && (t == 0 || t == 33)); }
    __device__ __forceinline__ void xform(f32x16& p0, f32x16& p1, int t, int, int, int) const { if (t == 0) mask_meta(p0, p1); else mask_all(p0, p1); }
    __device__ __forceinline__ float sink_term(float) const { return 0.f; }
    __device__ __forceinline__ bool partial() const { return split >= 0; }
    __device__ __forceinline__ void qfix(bf16x8* qr, int r, int hi) const {
        const int row = unit_row(b, qb, r); const int pos = row < RMETA ? NMETA + (row & (SEQ - 1)) : ((row - RMETA) & 15);
        const float* rp = rope_ + 2 * (size_t)(pos * 32);
#pragma unroll
        for (int blk = 0; blk < 2; ++blk) { const f32x4* cs = (const f32x4*)(rp + 2 * (16 * blk + 8 * hi)); f32x4 t[4];
#pragma unroll
            for (int q = 0; q < 4; ++q) t[q] = cs[q];
            bf16x8 x1 = qr[8 + blk], x2 = qr[10 + blk];
#pragma unroll
            for (int e = 0; e < 8; ++e) { const float c = t[e >> 1][(e & 1) * 2], sn = t[e >> 1][(e & 1) * 2 + 1];
                const float a = bf2f((unsigned short)x1[e]), bb = bf2f((unsigned short)x2[e]);
                x1[e] = (short)f2bf(a * c - bb * sn); x2[e] = (short)f2bf(bb * c + a * sn); }
            qr[8 + blk] = x1; qr[10 + blk] = x2; } }
    __device__ __forceinline__ float* pptr(int r) const { return part + ((size_t)((b * 8 + h) * 8 + split) * 16 + r) * 132; }
};

struct PolNA {
    const bf16* Z; bf16* O; const float* tab; int b, h, qb, nt, kstride, vstride, glo, n;
    __device__ __forceinline__ void init(const bf16* Z_, bf16* O_, const float* tab_, int b_, int h_, int qb_) {
        Z = Z_; O = O_; tab = tab_; b = b_; h = h_; qb = qb_; kstride = ZW; vstride = ZW;
        if (qb < 64) { int lo = 4 * qb - 4; lo = lo < 0 ? 0 : (lo > 248 ? 248 : lo); int hi_ = 4 * qb + 3 - 4; hi_ = hi_ < 0 ? 0 : (hi_ > 248 ? 248 : hi_); hi_ += 7; glo = lo; n = hi_ - lo + 1; }
        else { glo = 0; n = 0; }
        nt = (n + 1 + 1) & ~1; }
    __device__ __forceinline__ int krow0(int t) const { return (t == 0 || t > n) ? RMETA + 16 * b : b * SEQ + (glo + t - 1) * 64; }
    __device__ __forceinline__ const bf16* kbase(int t) const { return Z + (size_t)krow0(t) * ZW + ZNAK + h * 128; }
    __device__ __forceinline__ const bf16* vbase(int t) const { return Z + (size_t)krow0(t) * ZW + ZNAV + h * 128; }
    __device__ __forceinline__ const bf16* qptr(int r) const { return Z + (size_t)unit_row(b, qb, r) * ZW + ZNAQ + h * 128; }
    __device__ __forceinline__ bf16* optr(int r) const { return O + (size_t)unit_row(b, qb, r) * AOW + 1024 + h * 128; }
    __device__ __forceinline__ bool ovalid(int r) const { return qb < 64 || r < 16; }
    __device__ __forceinline__ bool needs_xform(int) const { return true; }
    __device__ __forceinline__ void xform(f32x16& p0, f32x16& p1, int t, int wid, int r32, int hi) const {
        if (t == 0) { mask_meta(p0, p1); return; }
        if (t > n) { mask_all(p0, p1); return; }
        const int g = glo + t - 1, r = 4 * qb + (wid >> 1), c = 32 * (wid & 1) + r32;
        int rs = r - 4; rs = rs < 0 ? 0 : (rs > 248 ? 248 : rs);
        if (g < rs || g >= rs + 8) { mask_all(p0, p1); return; }
        int cs = c - 8; cs = cs < 0 ? 0 : (cs > 48 ? 48 : cs);
        const float* trow = tab + (g - r + 7) * 31 + 15 - c;
#pragma unroll
        for (int i = 0; i < 16; ++i) { const int kc = crow(i, hi); const bool ok = kc >= cs && kc < cs + 16; const int kcc = ok ? kc : c;
            const float bv = trow[kcc]; p0[i] = ok ? p0[i] + bv : NEGBIG; }
#pragma unroll
        for (int i = 0; i < 16; ++i) { const int kc = 32 + crow(i, hi); const bool ok = kc >= cs && kc < cs + 16; const int kcc = ok ? kc : c;
            const float bv = trow[kcc]; p1[i] = ok ? p1[i] + bv : NEGBIG; }
    }
    __device__ __forceinline__ float sink_term(float) const { return 0.f; }
    __device__ __forceinline__ bool partial() const { return false; }
    __device__ __forceinline__ float* pptr(int) const { return nullptr; }
    __device__ __forceinline__ void qfix(bf16x8*, int, int) const {}
};

struct PolSWA {
    const bf16* Z; bf16* O; int b, hq, qb, nt, kstride, vstride, klo, n; float slope_l2, sink_l2;
    __device__ __forceinline__ void init(const bf16* Z_, bf16* O_, const float* sinks, int b_, int hq_, int qb_) {
        Z = Z_; O = O_; b = b_; hq = hq_; qb = qb_; kstride = Z1W; vstride = Z1W;
        if (qb < 64) { klo = 4 * qb - 2; if (klo < 0) klo = 0; int khi = 4 * qb + 5; if (khi > 255) khi = 255; n = khi - klo + 1; }
        else { klo = 0; n = 2; }
        nt = (n + 1 + 1) & ~1;
        slope_l2 = __builtin_amdgcn_exp2f(-0.25f * (float)(hq + 1)) * LOG2E; sink_l2 = sinks[hq] * LOG2E; }
    __device__ __forceinline__ int krow0(int t) const { return (t == 0 || t > n) ? RMETA + 16 * b : b * SEQ + (klo + t - 1) * 64; }
    __device__ __forceinline__ const bf16* kbase(int t) const { return Z + (size_t)krow0(t) * Z1W + 2048 + (hq >> 3) * 64; }
    __device__ __forceinline__ const bf16* vbase(int t) const { return Z + (size_t)krow0(t) * Z1W + 2304 + (hq >> 3) * 64; }
    __device__ __forceinline__ const bf16* qptr(int r) const { return Z + (size_t)unit_row(b, qb, r) * Z1W + hq * 64; }
    __device__ __forceinline__ bf16* optr(int r) const { return O + (size_t)unit_row(b, qb, r) * AOW + hq * 64; }
    __device__ __forceinline__ bool ovalid(int r) const { return qb < 64 || r < 16; }
    __device__ __forceinline__ bool needs_xform(int) const { return true; }
    __device__ __forceinline__ void xform(f32x16& p0, f32x16& p1, int t, int wid, int r32, int hi) const {
        if (t == 0) { mask_meta(p0, p1); return; }
        if (t > n) { mask_all(p0, p1); return; }
        const int kt = klo + t - 1;
        if (qb < 64) {
            const int d0 = 64 * kt - (256 * qb + 32 * wid + r32);
#pragma unroll
            for (int i = 0; i < 16; ++i) { int d = d0 + crow(i, hi); d = max(d, -d); const int m = min(max(d - 128, 0), 1); p0[i] = (p0[i] - slope_l2 * (float)d) + NEGBIG * (float)m; }
#pragma unroll
            for (int i = 0; i < 16; ++i) { int d = d0 + 32 + crow(i, hi); d = max(d, -d); const int m = min(max(d - 128, 0), 1); p1[i] = (p1[i] - slope_l2 * (float)d) + NEGBIG * (float)m; }
        } else {
            const int qi = 32 * wid + r32, j0 = 64 * kt;
#pragma unroll
            for (int i = 0; i < 16; ++i) { const int j = j0 + crow(i, hi); const int m = min(max(16 + j - qi - 128, 0), 1); p0[i] = p0[i] + NEGBIG * (float)m; }
#pragma unroll
            for (int i = 0; i < 16; ++i) { const int j = j0 + 32 + crow(i, hi); const int m = min(max(16 + j - qi - 128, 0), 1); p1[i] = p1[i] + NEGBIG * (float)m; }
        }
    }
    __device__ __forceinline__ float sink_term(float m) const { return __builtin_amdgcn_exp2f(sink_l2 - m); }
    __device__ __forceinline__ bool partial() const { return false; }
    __device__ __forceinline__ float* pptr(int) const { return nullptr; }
    __device__ __forceinline__ void qfix(bf16x8*, int, int) const {}
};
struct PolSWAG {
    const bf16* Z; bf16* O; int b, kvh, pb, nt, kstride, vstride, klo, n; float slope_l2, sink_l2;
    __device__ __forceinline__ void init(const bf16* Z_, bf16* O_, const float* sinks, int b_, int kvh_, int pb_, int wv) {
        Z = Z_; O = O_; b = b_; kvh = kvh_; pb = pb_; kstride = Z1W; vstride = Z1W;
        klo = (pb - 4) >> 1; if (klo < 0) klo = 0; int khi = (pb + 4) >> 1; if (khi > 255) khi = 255; n = khi - klo + 1;
        nt = (n + 1 + 1) & ~1;
        const int hq = kvh * 8 + wv;
        slope_l2 = __builtin_amdgcn_exp2f(-0.25f * (float)(hq + 1)) * LOG2E; sink_l2 = sinks[hq] * LOG2E; }
    __device__ __forceinline__ int krow0(int t) const { return (t == 0 || t > n) ? RMETA + 16 * b : b * SEQ + (klo + t - 1) * 64; }
    __device__ __forceinline__ const bf16* kbase(int t) const { return Z + (size_t)krow0(t) * Z1W + 2048 + kvh * 64; }
    __device__ __forceinline__ const bf16* vbase(int t) const { return Z + (size_t)krow0(t) * Z1W + 2304 + kvh * 64; }
    __device__ __forceinline__ const bf16* qptr(int r) const { return Z + (size_t)(b * SEQ + 32 * pb + (r & 31)) * Z1W + (kvh * 8 + (r >> 5)) * 64; }
    __device__ __forceinline__ bf16* optr(int r) const { return O + (size_t)(b * SEQ + 32 * pb + (r & 31)) * AOW + (kvh * 8 + (r >> 5)) * 64; }
    __device__ __forceinline__ bool ovalid(int) const { return true; }
    __device__ __forceinline__ bool needs_xform(int) const { return true; }
    __device__ __forceinline__ void xform(f32x16& p0, f32x16& p1, int t, int, int r32, int hi) const {
        if (t == 0) { mask_meta(p0, p1); return; }
        if (t > n) { mask_all(p0, p1); return; }
        const int rel = 64 * (klo + t - 1) - 32 * pb;
        const int d0 = rel - r32;
        if (rel == -96 || rel == -64 || rel == 32 || rel == 64) {
            const float sg = rel < 0 ? slope_l2 : -slope_l2;
            const float sb0 = sg * (float)(d0 + 4 * hi), sb1 = sb0 + sg * 32.f;
#pragma unroll
            for (int i = 0; i < 16; ++i) p0[i] = __builtin_fmaf(sg, (float)((i & 3) + 8 * (i >> 2)), p0[i] + sb0);
#pragma unroll
            for (int i = 0; i < 16; ++i) p1[i] = __builtin_fmaf(sg, (float)((i & 3) + 8 * (i >> 2)), p1[i] + sb1);
            return;
        }
        if (rel == -32 || rel == 0) {
#pragma unroll
            for (int i = 0; i < 16; ++i) { int d = d0 + crow(i, hi); d = max(d, -d); p0[i] = p0[i] - slope_l2 * (float)d; }
#pragma unroll
            for (int i = 0; i < 16; ++i) { int d = d0 + 32 + crow(i, hi); d = max(d, -d); p1[i] = p1[i] - slope_l2 * (float)d; }
            return;
        }
#pragma unroll
        for (int i = 0; i < 16; ++i) { int d = d0 + crow(i, hi); d = max(d, -d); const int m = min(max(d - 128, 0), 1); p0[i] = (p0[i] - slope_l2 * (float)d) + NEGBIG * (float)m; }
#pragma unroll
        for (int i = 0; i < 16; ++i) { int d = d0 + 32 + crow(i, hi); d = max(d, -d); const int m = min(max(d - 128, 0), 1); p1[i] = (p1[i] - slope_l2 * (float)d) + NEGBIG * (float)m; }
    }
    __device__ __forceinline__ float sink_term(float m) const { return __builtin_amdgcn_exp2f(sink_l2 - m); }
    __device__ __forceinline__ bool partial() const { return false; }
    __device__ __forceinline__ float* pptr(int) const { return nullptr; }
    __device__ __forceinline__ void qfix(bf16x8*, int, int) const {}
};
#undef SBAR
}

struct Params {
    const float* x; const float* meta; const float* norm_mix; const float* norm_ffn; const float* norm_final;
    const float* ab_w_in; const float* ab_q_norm; const float* ab_kv_norm; const float* ab_w_uq; const float* ab_w_ukv; const float* ab_rpb; const float* ab_w_out;
    const float* c_w_in; const float* c_sinks; const float* c_w_out;
    const float* ec_w_router; const float* ec_w_gate; const float* ec_w_up; const float* ec_w_down;
    float* out; unsigned char* ws;
};

__device__ __forceinline__ void load_row(const float* row, int lane, f32x4 (&v)[8]) {
    const f32x4* r = (const f32x4*)row + lane;
#pragma unroll
    for (int j = 0; j < 8; ++j) v[j] = r[64 * j];
}
__device__ __forceinline__ void load_row_bf16(const bf16* row, int lane, f32x4 (&v)[8]) {
    const u32x2* r = (const u32x2*)row + lane;
#pragma unroll
    for (int j = 0; j < 8; ++j) { const u32x2 w = r[64 * j]; v[j] = (f32x4){bflo(w.x), bfhi(w.x), bflo(w.y), bfhi(w.y)}; }
}
__device__ __forceinline__ void store_row_bf16(bf16* row, int lane, const f32x4 (&v)[8]) {
    u32x2* o8 = (u32x2*)row + lane;
#pragma unroll
    for (int j = 0; j < 8; ++j) { u32x2 w; w.x = pk2(v[j].x, v[j].y); w.y = pk2(v[j].z, v[j].w); o8[64 * j] = w; }
}
__device__ __forceinline__ float row_rs(const f32x4 (&v)[8]) {
    float s = 0.f;
#pragma unroll
    for (int j = 0; j < 8; ++j) s += (v[j].x * v[j].x + v[j].y * v[j].y) + (v[j].z * v[j].z + v[j].w * v[j].w);
    return 1.0f / sqrtf(wave_sum(s) * (1.f / D) + EPS);
}
__device__ __forceinline__ void store_norm_bf16(bf16* urow, int lane, const f32x4 (&v)[8], float rs, const float* g) {
    const f32x4* gp = (const f32x4*)g + lane; u32x2* o8 = (u32x2*)urow + lane;
#pragma unroll
    for (int j = 0; j < 8; ++j) { const f32x4 gg = gp[64 * j]; u32x2 w; w.x = pk2(v[j].x * rs * gg.x, v[j].y * rs * gg.y); w.y = pk2(v[j].z * rs * gg.z, v[j].w * rs * gg.w); o8[64 * j] = w; }
}
__device__ __forceinline__ void store_zero_bf16(bf16* urow, int lane) {
    u32x2* o8 = (u32x2*)urow + lane;
#pragma unroll
    for (int j = 0; j < 8; ++j) o8[64 * j] = (u32x2){0u, 0u};
}

__device__ __forceinline__ void transpose_item(const float* src, int srcN, int k0, int n0, bf16* dst, int dstK, int dst_row0, const float* kscale, LAS float*, int lane) {
    const int kg = lane >> 4, ng = lane & 15;
    f32x4 v[2][8];
#pragma unroll
    for (int half = 0; half < 2; ++half) { const int kk0 = k0 + 32 * half + 8 * kg;
#pragma unroll
        for (int j = 0; j < 8; ++j) v[half][j] = *(const f32x4*)(src + (size_t)(kk0 + j) * srcN + n0 + 4 * ng); }
#pragma unroll
    for (int half = 0; half < 2; ++half) {
        const int kk0 = k0 + 32 * half + 8 * kg;
        if (kscale) {
#pragma unroll
            for (int j = 0; j < 8; ++j) v[half][j] = v[half][j] * kscale[kk0 + j]; }
#pragma unroll
        for (int q = 0; q < 4; ++q) { u32x4 o; o.x = pk2(v[half][0][q], v[half][1][q]); o.y = pk2(v[half][2][q], v[half][3][q]); o.z = pk2(v[half][4][q], v[half][5][q]); o.w = pk2(v[half][6][q], v[half][7][q]);
            *(u32x4*)(dst + (size_t)(dst_row0 + 4 * ng + q) * dstK + kk0) = o; }
    }
}
template <class Map>
__device__ __forceinline__ void transpose_matrix(const float* W, int K, int N, bf16* WT, const float* kscale, LAS float* scr, int gw, int ngw, int lane, const Map& map) {
    const int nkb = K / 64, nnb = N / 64, items = nkb * nnb;
    for (int it = gw; it < items; it += ngw) { const int kb = it / nnb, nb = it % nnb; transpose_item(W, N, kb * 64, nb * 64, WT, K, map(nb * 64), kscale, scr, lane); }
}
__device__ __forceinline__ void convert_experts(const float* wg, const float* wu, const float* wd, const float* gk, bf16* Wgu, bf16* Wd, LAS float* scr, int gw, int ngw, int lane, int lo, int hi) {
    constexpr int PER = 32 * 32;
    for (int ip = lo + gw; ip < hi; ip += ngw) {
        const int it = ip < 8192 ? (ip >> 11) * (3 * PER) + (ip & 2047) : (ip < 12288 ? ((ip - 8192) >> 10) * (3 * PER) + 2 * PER + ((ip - 8192) & 1023) : ip);
        const int e = it / (3 * PER), r = it % (3 * PER), which = r / PER, q = r % PER, kb = q / 32, nb = q % 32, n0 = nb * 64;
        const size_t eoff = (size_t)e * D * D;
        if (which == 0) transpose_item(wg + eoff, D, kb * 64, n0, Wgu + (size_t)e * 4096 * D, D, (n0 >> 7) * 256 + (n0 & 127), gk, scr, lane);
        else if (which == 1) transpose_item(wu + eoff, D, kb * 64, n0, Wgu + (size_t)e * 4096 * D, D, (n0 >> 7) * 256 + 128 + (n0 & 127), gk, scr, lane);
        else transpose_item(wd + eoff, D, kb * 64, n0, Wd + eoff, D, n0, nullptr, scr, lane);
    }
}

constexpr int CV_ITEMS = NE * 3 * 32 * 32, CV_TAIL_PER_CU = 80;
constexpr int CV_TOPK = 224 * 30;
constexpr int CV_CHUNK = 64;
constexpr int CV_IN0 = (256 - (129 * 17) % 256) * CV_TAIL_PER_CU, CV_OUT = (256 - (129 * 8) % 256) * CV_TAIL_PER_CU, CV_IN1 = (256 - (129 * 10) % 256) * 48;
constexpr int CV_MAIN0 = CV_ITEMS - CV_IN0 - CV_OUT - CV_TOPK;
constexpr int CV_DN = 8192;
#ifndef PHASES
#define PHASES 0xffffffffu
#endif
#define EN(k) (((PHASES) >> (k)) & 1u)
#define PH_IDS() int tid = threadIdx.x; asm volatile("" : "+v"(tid)); const int lane = tid & 63, wave = __builtin_amdgcn_readfirstlane(tid >> 6), gw = vcu * NWAVES + wave; (void)lane; (void)wave; (void)gw; WSL()
__global__ void __launch_bounds__(NTHREADS, 2) fwd_kernel(Params P) {
    extern __shared__ __attribute__((aligned(16))) unsigned char lds[];
    LAS unsigned char* ldsl = (LAS unsigned char*)lds;
    volatile LAS unsigned* MISC = (volatile LAS unsigned*)(ldsl + MISC_OFF);
    const int G = gridDim.x, bx = blockIdx.x;
    const int vcu = (G % 8 == 0) ? (bx % 8) * (G / 8) + bx / 8 : bx;
    const int NGW = G * NWAVES;
    unsigned* ctl = (unsigned*)(P.ws + WS_CTL);
    for (int u = threadIdx.x; u < 64; u += NTHREADS) MISC[u] = 0u;
    __syncthreads();
    XcdBarrier bar = xcd_barrier_post(ctl + CW_BAR, MISC + 8);
#define GRID_BAR() xcd_barrier(bar)

#define WSL() GAS unsigned char* wsg_ = (GAS unsigned char*)P.ws; asm volatile("" : "+s"(wsg_)); unsigned char* wsl = (unsigned char*)wsg_
#define rope ((float*)(wsl + WS_ROPE))
#define rsq ((float*)(wsl + WS_RSQ))
#define rskv ((float*)(wsl + WS_RSKV))
#define aff ((float*)(wsl + WS_AFF))
#define tokslot ((int*)(wsl + WS_TOKSLOT))
#define slottok ((int*)(wsl + WS_SLOTTOK))
#define xgate ((float*)(wsl + WS_XGATE))
#define xmap ((int*)(wsl + WS_XMAP))
#define rsf ((float*)(wsl + WS_RSF))
#define xrs ((float*)(wsl + WS_XRS))
#define rsm ((float*)(wsl + WS_RSM))
#define Win0 ((bf16*)(wsl + WS_WIN0))
#define Wuq ((bf16*)(wsl + WS_WUQ))
#define Wukv ((bf16*)(wsl + WS_WUKV))
#define Wout0 ((bf16*)(wsl + WS_WOUT0))
#define Win1 ((bf16*)(wsl + WS_WIN1))
#define Wout1 ((bf16*)(wsl + WS_WOUT1))
#define Wgu ((bf16*)(wsl + WS_WGU))
#define Wd ((bf16*)(wsl + WS_WD))
#define Hm ((bf16*)(wsl + WS_H))
#define U ((bf16*)(wsl + WS_U))
#define Z ((bf16*)(wsl + WS_Z))
#define Qb ((bf16*)(wsl + WS_Q))
#define Kc ((bf16*)(wsl + WS_KC))
#define Vm ((bf16*)(wsl + WS_VM))
#define AO ((bf16*)(wsl + WS_AO))
#define XS ((bf16*)(wsl + WS_XS))
#define HMID ((bf16*)(wsl + WS_HMID))

    if (EN(0)) {
        PH_IDS();
        LAS float* scr = (LAS float*)(ldsl + wave * 16640);
        transpose_matrix(P.ab_w_in, D, 4160, Win0, nullptr, scr, gw, NGW, lane, [](int n0) { return n0 < 1024 ? n0 : (n0 < 1088 ? 4096 + (n0 - 1024) : n0 - 64); });
        transpose_matrix(P.ab_w_uq, 512, 1536, Wuq, P.ab_q_norm, scr, gw, NGW, lane, [](int n0) { return n0; });
        transpose_matrix(P.ab_w_ukv, 512, 2048, Wukv, P.ab_kv_norm, scr, gw, NGW, lane, [](int n0) { return n0; });
        transpose_matrix(P.ab_w_out, D, D, Wout0, nullptr, scr, gw, NGW, lane, [](int n0) { return n0; });
        transpose_matrix(P.c_w_in, D, Z1W, Win1, P.norm_mix + D, scr, gw, NGW, lane, [](int n0) { return n0; });
        transpose_matrix(P.c_w_out, D, D, Wout1, nullptr, scr, gw, NGW, lane, [](int n0) { return n0; });
        if (G != 256) convert_experts(P.ec_w_gate, P.ec_w_up, P.ec_w_down, P.norm_ffn, Wgu, Wd, scr, gw, NGW, lane, 0, CV_ITEMS);
        for (int row = NTOK + gw * 64 + lane; row < NR; row += NGW * 64) rsm[row] = 0.f;
        for (int i = gw * 64 + lane; i < 192 * D / 8; i += NGW * 64) ((u32x4*)(Win0 + (size_t)4160 * D))[i] = (u32x4){0u, 0u, 0u, 0u};
        for (int row = gw; row < NR; row += NGW) {
            bf16* urow = U + (size_t)row * D;
            if (row < NTOK) {
                const float* src = row < RMETA ? P.x + (size_t)row * D : P.meta + (size_t)((row - RMETA) & 15) * D;
                f32x4 v[8]; load_row(src, lane, v);
                const float rs = row_rs(v); store_norm_bf16(urow, lane, v, rs, P.norm_mix);
            } else store_zero_bf16(urow, lane);
        }
        for (int i = gw * 64 + lane; i < LTOK * 32; i += NGW * 64) {
            const int pos = i >> 5, j = i & 31;
            double f = 1.0; { double r = 0.74989420933245582730;   for (int q = 0; q < j; ++q) f *= r; }
            const double rev = (double)pos * f * 0.15915494309189533577;
            const float fr = (float)(rev - __builtin_floor(rev));
            rope[2 * i] = __builtin_amdgcn_cosf(fr); rope[2 * i + 1] = __builtin_amdgcn_sinf(fr);
        }
    }
    GRID_BAR();

    for (int layer = 0; layer < 2; ++layer) {
        if (EN(1)) {
            WSL();
            const int nN = layer == 0 ? 17 : 10, ldz = layer == 0 ? ZW : Z1W;
            pg8::Gemm g{layer == 0 ? U : Hm, layer == 0 ? Win0 : Win1, D, D, D};
            pg8::TileOrder S; S.init(NR / 256, nN, G, bx, 0);
            pg8::EpiBf16S E{Z, ldz, layer == 0 ? nullptr : rsm, layer == 0 ? 4 : 0, 8, layer == 0 ? C_NA : C_SWA};
            pg8::gemm_phase(ldsl, g, S, E);
            if (G == 256) {
                const int rem = (129 * nN) % 256;
                if (bx >= rem) { PH_IDS(); const int cnt = layer == 0 ? CV_IN0 : CV_IN1, base = CV_ITEMS - CV_OUT - cnt; const size_t lo = (size_t)layer * NE * D * D;
                    convert_experts(P.ec_w_gate + lo, P.ec_w_up + lo, P.ec_w_down + lo, P.norm_ffn + (size_t)layer * D, Wgu, Wd, (LAS float*)ldsl, (bx - rem) * NWAVES + wave, (256 - rem) * NWAVES, lane, base, base + cnt); }
            }
        }
        GRID_BAR();
        if (layer == 0) {
            if (EN(2)) { PH_IDS();
                const int sub = lane >> 4, l16 = lane & 15;
                for (int row4 = gw * 4; row4 < NR; row4 += NGW * 4) {
                    const int row = row4 + sub;
                    const bf16* zr = Z + (size_t)row * ZW;
                    u32x4 a[4], bq[4];
#pragma unroll
                    for (int i = 0; i < 4; ++i) { a[i] = *(const u32x4*)(zr + ZQL + 128 * i + 8 * l16); bq[i] = *(const u32x4*)(zr + ZKVL + 128 * i + 8 * l16); }
                    const int pos = row < RMETA ? NMETA + (row & (SEQ - 1)) : ((row - RMETA) & 15);
                    const unsigned x1w = *(const unsigned*)(zr + ZKR + 2 * l16), x2w = *(const unsigned*)(zr + ZKR + 32 + 2 * l16);
                    const f32x4 cs = *(const f32x4*)(rope + 2 * (pos * 32 + 2 * l16));
                    float s1 = 0.f, s2 = 0.f;
#pragma unroll
                    for (int i = 0; i < 4; ++i)
#pragma unroll
                        for (int q = 0; q < 4; ++q) { const float a0 = bflo(a[i][q]), a1 = bfhi(a[i][q]), b0 = bflo(bq[i][q]), b1 = bfhi(bq[i][q]); s1 += a0 * a0 + a1 * a1; s2 += b0 * b0 + b1 * b1; }
#pragma unroll
                    for (int o = 1; o < 16; o <<= 1) { s1 += __shfl_xor(s1, o); s2 += __shfl_xor(s2, o); }
                    if (l16 == 0) { rsq[row] = C_MLA / sqrtf(s1 * (1.f / 512) + EPS); rskv[row] = 1.0f / sqrtf(s2 * (1.f / 512) + EPS); }
                    const float z = row < NTOK ? 1.f : 0.f;
                    const float x1a = bflo(x1w) * z, x1b = bfhi(x1w) * z, x2a = bflo(x2w) * z, x2b = bfhi(x2w) * z;
                    const unsigned w1 = pk2(x1a * cs[0] - x2a * cs[1], x1b * cs[2] - x2b * cs[3]), w2 = pk2(x2a * cs[0] + x1a * cs[1], x2b * cs[2] + x1b * cs[3]);
                    bf16* kr = Kc + (size_t)row * KCW + 128 + 2 * l16;
#pragma unroll
                    for (int h = 0; h < 8; ++h) { *(unsigned*)(kr + h * 192) = w1; *(unsigned*)(kr + h * 192 + 32) = w2; }
                } }
            GRID_BAR();
            if (EN(3)) {
                WSL();
                pg8::Gemm g{Z + ZQL, Wuq, ZW, 512, 512};
                pg8::TileOrder S; S.init(NR / 256, 6, G, bx, 0);
                pg8::EpiBf16S E{Qb, QW, rsq, 0, 0, 1.f};
                pg8::gemm_phase(ldsl, g, S, E);
            }
            if (EN(4)) {
                WSL();
                pg8::Gemm g{Z + ZKVL, Wukv, ZW, 512, 512};
                pg8::TileOrder S; S.init(NR / 256, 8, G, G == 256 ? (bx + 248) & 255 : bx, 0);
                pg8::EpiKV E{Kc, Vm, rskv};
                pg8::gemm_phase(ldsl, g, S, E);
            }
            GRID_BAR();
            {
                WSL();
                constexpr int N_MLA = 1024 + 128, N_NA = 1040;
                float* tab = (float*)(lds + 3 * 16384 + 3 * 16384 + 2048);
                float* PART = (float*)(wsl + WS_PART);
                unsigned* ticket = (unsigned*)(wsl + WS_CTL) + CW_TICKET;
                for (int u0 = vcu; ; ) {
                    int u;
                    if (u0 < 1024) { u = u0; u0 += G; }
                    else {
                        if (threadIdx.x == 0) MISC[16] = 1024u + __hip_atomic_fetch_add(ticket, 1u, __ATOMIC_RELAXED, __HIP_MEMORY_SCOPE_AGENT);
                        __syncthreads();
                        u = (int)MISC[16];
                        if (u >= N_MLA + N_NA) {
                            const int c = u - (N_MLA + N_NA);
                            if (G != 256 || c >= (CV_MAIN0 + CV_CHUNK - 1) / CV_CHUNK) break;
                            const int ln = threadIdx.x & 63, wv = __builtin_amdgcn_readfirstlane((int)threadIdx.x >> 6), hi_ = (c + 1) * CV_CHUNK < CV_MAIN0 ? (c + 1) * CV_CHUNK : CV_MAIN0;
                            convert_experts(P.ec_w_gate, P.ec_w_up, P.ec_w_down, P.norm_ffn, Wgu, Wd, (LAS float*)ldsl, wv, NWAVES, ln, c * CV_CHUNK, hi_);
                            __syncthreads();
                            continue;
                        }
                    }
                    if (u < N_MLA) { if (EN(6)) {
                        int b, h, qb, sp; if (u < 1024) { const int bh = u >> 6; b = bh >> 3; h = bh & 7; qb = u & 63; sp = -1; } else { const int v = u - 1024; const int bh = v >> 3; b = bh >> 3; h = bh & 7; qb = 64; sp = v & 7; }
                        att::PolMLA pol; pol.init(Kc, Vm, Qb, AO, PART, rope, b, h, qb, sp);
                        att::attn_unit<192, 128>(pol, (char*)lds); }
                    } else if (EN(7)) {
                        const int v = u - N_MLA; int b, h, qb; if (v < 1024) { const int bh = v >> 6; b = bh >> 3; h = bh & 7; qb = v & 63; } else { const int bh = v - 1024; b = bh >> 3; h = bh & 7; qb = 64; }
                        for (int i = threadIdx.x; i < 15 * 31; i += NTHREADS) tab[i] = P.ab_rpb[h * 465 + i] * LOG2E;
                        __syncthreads();
                        att::PolNA pol; pol.init(Z, AO, tab, b, h, qb);
                        att::attn_unit<128, 128>(pol, (char*)lds);
                    }
                }
            }
            GRID_BAR();
            {
                PH_IDS();
                const float* PART = (const float*)(wsl + WS_PART);
                for (int it = gw; it < 2 * 8 * 16; it += NGW) {
                    const int row = it & 15, bh = it >> 4, b = bh >> 3, h = bh & 7;
                    const float* pp = PART + ((size_t)(bh * 8) * 16 + row) * 132;
                    float M = -3e38f;
#pragma unroll
                    for (int sp = 0; sp < 8; ++sp) M = fmaxf(M, pp[(size_t)sp * 16 * 132 + 128]);
                    float L = 0.f, o0 = 0.f, o1 = 0.f;
#pragma unroll
                    for (int sp = 0; sp < 8; ++sp) { const float* q = pp + (size_t)sp * 16 * 132; const float w = __builtin_amdgcn_exp2f(q[128] - M); L += w * q[129]; o0 += w * q[lane]; o1 += w * q[64 + lane]; }
                    const float rl = 1.0f / L; bf16* op = AO + (size_t)(RMETA + 16 * b + row) * AOW + h * 128;
                    op[lane] = (bf16)f2bf(o0 * rl); op[64 + lane] = (bf16)f2bf(o1 * rl);
                }
            }
        } else {
            WSL();
            if (EN(8)) {
                const int wv = __builtin_amdgcn_readfirstlane((int)threadIdx.x >> 6);
                for (int u = vcu; u < 4096; u += G) {
                    att::PolSWAG pol; pol.init(Z, AO, P.c_sinks, u >> 11, (u >> 9) & 3, u & 511, wv);
                    att::attn_unit<64, 64>(pol, (char*)lds);
                }
                for (int u = vcu; u < 64; u += G) {
                    att::PolSWA pol; pol.init(Z, AO, P.c_sinks, u >> 5, u & 31, 64);
                    att::attn_unit<64, 64>(pol, (char*)lds);
                }
            }
        }
        GRID_BAR();
        if (EN(9)) {
            WSL();
            pg8::Gemm g{AO, layer == 0 ? Wout0 : Wout1, AOW, D, D};
            pg8::TileOrder S; S.init(NR / 256, 8, G, bx, 0);
            pg8::EpiResid E{Hm, D, layer == 0 ? P.x : nullptr, P.meta};
            pg8::gemm_phase(ldsl, g, S, E);
            if (G == 256) {
                const int rem = (129 * 8) % 256;
                if (bx >= rem) { PH_IDS(); const size_t lo = (size_t)layer * NE * D * D;
                    convert_experts(P.ec_w_gate + lo, P.ec_w_up + lo, P.ec_w_down + lo, P.norm_ffn + (size_t)layer * D, Wgu, Wd, (LAS float*)ldsl, (bx - rem) * NWAVES + wave, (256 - rem) * NWAVES, lane, CV_ITEMS - CV_OUT, CV_ITEMS); }
            }
        }
        GRID_BAR();
        if (EN(10)) {
            PH_IDS();
            LAS float* wb = (LAS float*)ldsl;
            LAS float* red = (LAS float*)(ldsl + 131072);
            const float* wsrc = P.ec_w_router + (size_t)layer * D * NE; const float* gf = P.norm_ffn + (size_t)layer * D;
            for (int i = tid; i < D * 4; i += NTHREADS) { const int k = i >> 2, eg = i & 3; const f32x4 w4 = *(const f32x4*)(wsrc + (size_t)k * NE + 4 * eg) * gf[k];
                const int base = ((k >> 2) * 16 + 4 * eg) * 4 + (k & 3);
                wb[base] = w4.x; wb[base + 4] = w4.y; wb[base + 8] = w4.z; wb[base + 12] = w4.w; }
            __syncthreads();
            const int r = lane & 15, kq = lane >> 4;
            u32x4 hv[8];
            { const bf16* hp = Hm + (size_t)(vcu * 16 + r) * D + 256 * wave + 8 * kq;
#pragma unroll
              for (int i = 0; i < 8; ++i) hv[i] = *(const u32x4*)(hp + 32 * i); }
            for (int blk = vcu; blk < NTOK / 16; blk += G) {
                const int row0 = blk * 16;
                f32x4 acc = {0.f, 0.f, 0.f, 0.f}; float ss = 0.f;
#pragma unroll
                for (int i = 0; i < 8; ++i) {
                    const LAS f32x4* bp = (const LAS f32x4*)wb + (((wave * 8 + i) * 4 + kq) * 2) * 16 + r;
                    const f32x4 b0 = bp[0], b1 = bp[16];
                    const float a0 = bflo(hv[i].x), a1 = bfhi(hv[i].x), a2 = bflo(hv[i].y), a3 = bfhi(hv[i].y), a4 = bflo(hv[i].z), a5 = bfhi(hv[i].z), a6 = bflo(hv[i].w), a7 = bfhi(hv[i].w);
                    acc = __builtin_amdgcn_mfma_f32_16x16x4f32(a0, b0.x, acc, 0, 0, 0); acc = __builtin_amdgcn_mfma_f32_16x16x4f32(a1, b0.y, acc, 0, 0, 0);
                    acc = __builtin_amdgcn_mfma_f32_16x16x4f32(a2, b0.z, acc, 0, 0, 0); acc = __builtin_amdgcn_mfma_f32_16x16x4f32(a3, b0.w, acc, 0, 0, 0);
                    acc = __builtin_amdgcn_mfma_f32_16x16x4f32(a4, b1.x, acc, 0, 0, 0); acc = __builtin_amdgcn_mfma_f32_16x16x4f32(a5, b1.y, acc, 0, 0, 0);
                    acc = __builtin_amdgcn_mfma_f32_16x16x4f32(a6, b1.z, acc, 0, 0, 0); acc = __builtin_amdgcn_mfma_f32_16x16x4f32(a7, b1.w, acc, 0, 0, 0);
                    ss += (a0 * a0 + a1 * a1) + (a2 * a2 + a3 * a3) + (a4 * a4 + a5 * a5) + (a6 * a6 + a7 * a7);
                }
                if (blk + G < NTOK / 16) {
                    const bf16* hp = Hm + (size_t)((blk + G) * 16 + r) * D + 256 * wave + 8 * kq;
#pragma unroll
                    for (int i = 0; i < 8; ++i) hv[i] = *(const u32x4*)(hp + 32 * i); }
                ss += __shfl_xor(ss, 16); ss += __shfl_xor(ss, 32);
                LAS float* rw = red + wave * 272;
                *(LAS f32x4*)(rw + 4 * lane) = acc;
                if (lane < 16) rw[256 + lane] = ss;
                __syncthreads();
                if (wave == 0) {
                    f32x4 lg = {0.f, 0.f, 0.f, 0.f}; float sq[4] = {0.f, 0.f, 0.f, 0.f};
#pragma unroll
                    for (int w = 0; w < 8; ++w) { lg = lg + *(const LAS f32x4*)(red + w * 272 + 4 * lane);
#pragma unroll
                        for (int j = 0; j < 4; ++j) sq[j] += red[w * 272 + 256 + 4 * kq + j]; }
#pragma unroll
                    for (int j = 0; j < 4; ++j) {
                        const int row = row0 + 4 * kq + j; const float rs = 1.0f / sqrtf(sq[j] * (1.f / D) + EPS);
                        const float x = lg[j] * rs;
                        float mx = x; mx = fmaxf(mx, __shfl_xor(mx, 1)); mx = fmaxf(mx, __shfl_xor(mx, 2)); mx = fmaxf(mx, __shfl_xor(mx, 4)); mx = fmaxf(mx, __shfl_xor(mx, 8));
                        const float p = __expf(x - mx); float sum = p;
                        sum += __shfl_xor(sum, 1); sum += __shfl_xor(sum, 2); sum += __shfl_xor(sum, 4); sum += __shfl_xor(sum, 8);
                        const int b = row < RMETA ? (row >> 14) : ((row - RMETA) >> 4); const int tok = row < RMETA ? NMETA + (row & (SEQ - 1)) : ((row - RMETA) & 15);
                        aff[(size_t)(b * NE + r) * LTOK + tok] = p / sum;
                        if (r == 0) rsf[row] = rs;
                    }
                }
                __syncthreads();
            }
        }
        GRID_BAR();
        if (EN(11) && vcu < 32) {
            PH_IDS();
            const int be = vcu, b = be >> 4, e = be & 15;
            LAS unsigned* keys = (LAS unsigned*)ldsl;
            LAS unsigned* hist = (LAS unsigned*)(ldsl + 66560);
            LAS unsigned* sh = (LAS unsigned*)(ldsl + 66560 + 1024);
            const float* av = aff + (size_t)be * LTOK;
            for (int i = tid; i < LTOK; i += NTHREADS) keys[i] = __float_as_uint(av[i]);
            __syncthreads();
            const int i0 = tid * 33, i1 = (i0 + 33 < LTOK) ? i0 + 33 : LTOK;
            unsigned kv[33];
#pragma unroll
            for (int q = 0; q < 33; ++q) kv[q] = (i0 + q < LTOK) ? keys[i0 + q] : 0u;
            unsigned T = 0u;
            for (int bit = 30; bit >= 0; --bit) {
                const unsigned cand = T | (1u << bit); unsigned c = 0u;
#pragma unroll
                for (int q = 0; q < 33; ++q) c += 1u - ((kv[q] - cand) >> 31);
#pragma unroll
                for (int o = 1; o < 64; o <<= 1) c += __shfl_xor(c, o);
                LAS unsigned* slot = sh + 32 + (bit & 1) * 8;
                if (lane == 0) slot[wave] = c;
                __syncthreads();
                unsigned tot = 0u;
#pragma unroll
                for (int w = 0; w < 8; ++w) tot += slot[w];
                T |= (1u - ((tot - (unsigned)CAP) >> 31)) << bit;
            }
            unsigned cgt = 0u, ceq = 0u;
#pragma unroll
            for (int q = 0; q < 33; ++q) { const unsigned k = kv[q]; cgt += k > T ? 1u : 0u; ceq += (k == T && i0 + q < LTOK) ? 1u : 0u; }
            unsigned pk = cgt | (ceq << 16), incl = pk;
#pragma unroll
            for (int o = 1; o < 64; o <<= 1) { const unsigned t = __shfl_up(incl, o); if (lane >= o) incl += t; }
            if (lane == 63) sh[16 + wave] = incl;
            __syncthreads();
            unsigned wbase = 0u, totgt = 0u;
            for (int w = 0; w < 8; ++w) { const unsigned x = sh[16 + w]; totgt += x & 0xffffu; if (w < wave) wbase += x; }
            const unsigned krem = (unsigned)CAP - totgt;
            const unsigned excl = wbase + incl - pk;
            unsigned ngt = excl & 0xffffu, neq = excl >> 16;
            int* tsl = tokslot + (size_t)be * LTOK; int* stk = slottok + (size_t)be * CAP; float* xg = xgate + (size_t)e * XPE + b * CAP; int* xm = xmap + (size_t)e * XPE + b * CAP; float* xr = xrs + (size_t)e * XPE + b * CAP;
            for (int i = i0; i < i1; ++i) { const unsigned k = keys[i]; bool sel = k > T; if (k == T) { sel = neq < krem; }
                int slot = -1;
                if (sel) { slot = (int)(ngt + (neq < krem ? neq : krem)); if (slot < CAP) { const int trow = i < NMETA ? RMETA + 16 * b + i : b * SEQ + (i - NMETA); stk[slot] = trow; xm[slot] = trow; xg[slot] = __uint_as_float(k); xr[slot] = rsf[trow]; } else slot = -1; }
                if (k > T) ++ngt; if (k == T) ++neq;
                tsl[i] = slot; }
            if (b == 1) for (int i = tid; i < XPE - 2 * CAP; i += NTHREADS) { xgate[(size_t)e * XPE + 2 * CAP + i] = 0.f; xmap[(size_t)e * XPE + 2 * CAP + i] = NR - 1; xrs[(size_t)e * XPE + 2 * CAP + i] = 0.f; }
        }
        else if (EN(11) && G == 256) {
            PH_IDS(); const int cin = layer == 0 ? CV_IN0 : CV_IN1, hi_ = CV_ITEMS - CV_OUT - cin; const size_t lo = (size_t)layer * NE * D * D;
            convert_experts(P.ec_w_gate + lo, P.ec_w_up + lo, P.ec_w_down + lo, P.norm_ffn + (size_t)layer * D, Wgu, Wd, (LAS float*)ldsl, (vcu - 32) * NWAVES + wave, 224 * NWAVES, lane, hi_ - CV_TOPK, hi_);
        }
        GRID_BAR();
        if (EN(13)) {
            WSL();
            pg8::Gemm g{Hm, Wgu, D, D, D, xmap};
            pg8::TileOrder S; S.init(XROWS / 256, 16, G, bx, 17);
            pg8::EpiSwiGLU E{HMID, D, xrs};
            pg8::gemm_phase<true>(ldsl, g, S, E);
        }
        GRID_BAR();
        if (EN(14)) {
            WSL();
            pg8::Gemm g{HMID, Wd, D, D, D};
            pg8::TileOrder S; S.init(XROWS / 256, 8, G, bx, 17);
            pg8::EpiBf16S E{XS, D, nullptr, 0, 0, 1.f};
            pg8::gemm_phase(ldsl, g, S, E);
            if (layer == 0 && G == 256 && bx >= (XROWS / 256 * 8) % 256) {
                PH_IDS(); const int rem = (XROWS / 256 * 8) % 256; const size_t lo = (size_t)NE * D * D;
                convert_experts(P.ec_w_gate + lo, P.ec_w_up + lo, P.ec_w_down + lo, P.norm_ffn + D, Wgu, Wd, (LAS float*)ldsl, (bx - rem) * NWAVES + wave, (256 - rem) * NWAVES, lane, 0, CV_DN);
            }
        }
        GRID_BAR();
        if (EN(15)) {
            PH_IDS();
            const float* gn = layer == 0 ? P.norm_mix + D : P.norm_final;
            for (int row = gw; row < (layer == 0 ? NTOK : RMETA); row += NGW) {
                const int b = row < RMETA ? (row >> 14) : ((row - RMETA) >> 4); const int tok = row < RMETA ? NMETA + (row & (SEQ - 1)) : ((row - RMETA) & 15);
                f32x4 v[8]; bf16* hrow = Hm + (size_t)row * D; load_row_bf16(hrow, lane, v);
                int sl[NE];
#pragma unroll
                for (int e = 0; e < NE; ++e) sl[e] = tokslot[(size_t)(b * NE + e) * LTOK + tok];
                int cnt = 0, o0 = 0, o1 = 0, o2 = 0, o3 = 0;
#pragma unroll
                for (int e = 0; e < NE; ++e) {
                    const int s = __builtin_amdgcn_readfirstlane(sl[e]); const int ok = s >= 0 ? 1 : 0, xr_ = e * XPE + b * CAP + s;
                    o0 = (ok && cnt == 0) ? xr_ : o0; o1 = (ok && cnt == 1) ? xr_ : o1; o2 = (ok && cnt == 2) ? xr_ : o2; o3 = (ok && cnt == 3) ? xr_ : o3; cnt += ok;
                }
                { o1 = cnt > 1 ? o1 : o0; o2 = cnt > 2 ? o2 : o0; o3 = cnt > 3 ? o3 : o0;
                  const float w0 = cnt > 0 ? xgate[o0] : 0.f, w1 = cnt > 1 ? xgate[o1] : 0.f, w2 = cnt > 2 ? xgate[o2] : 0.f, w3 = cnt > 3 ? xgate[o3] : 0.f;
                  const u32x2* p0 = (const u32x2*)(XS + (size_t)o0 * D) + lane; const u32x2* p1 = (const u32x2*)(XS + (size_t)o1 * D) + lane;
                  const u32x2* p2 = (const u32x2*)(XS + (size_t)o2 * D) + lane; const u32x2* p3 = (const u32x2*)(XS + (size_t)o3 * D) + lane;
                  u32x2 y0[8], y1[8], y2[8], y3[8];
#pragma unroll
                  for (int j = 0; j < 8; ++j) { y0[j] = p0[64 * j]; y1[j] = p1[64 * j]; y2[j] = p2[64 * j]; y3[j] = p3[64 * j]; }
#pragma unroll
                  for (int j = 0; j < 8; ++j) {
                      v[j].x += (w0 * bflo(y0[j].x) + w1 * bflo(y1[j].x)) + (w2 * bflo(y2[j].x) + w3 * bflo(y3[j].x)); v[j].y += (w0 * bfhi(y0[j].x) + w1 * bfhi(y1[j].x)) + (w2 * bfhi(y2[j].x) + w3 * bfhi(y3[j].x));
                      v[j].z += (w0 * bflo(y0[j].y) + w1 * bflo(y1[j].y)) + (w2 * bflo(y2[j].y) + w3 * bflo(y3[j].y)); v[j].w += (w0 * bfhi(y0[j].y) + w1 * bfhi(y1[j].y)) + (w2 * bfhi(y2[j].y) + w3 * bfhi(y3[j].y)); } }
                if (cnt > 4) {
                    int seen = 0;
#pragma unroll
                    for (int e = 0; e < NE; ++e) {
                        const int s = __builtin_amdgcn_readfirstlane(sl[e]);
                        if (s >= 0) { if (seen >= 4) { const int xr_ = e * XPE + b * CAP + s; const float gt = xgate[xr_]; const u32x2* yp = (const u32x2*)(XS + (size_t)xr_ * D) + lane;
#pragma unroll
                            for (int j = 0; j < 8; ++j) { const u32x2 w = yp[64 * j]; v[j].x += gt * bflo(w.x); v[j].y += gt * bfhi(w.x); v[j].z += gt * bflo(w.y); v[j].w += gt * bfhi(w.y); } }
                          ++seen; }
                    }
                }
                const float rs = row_rs(v);
                if (layer == 0) {
                    store_row_bf16(hrow, lane, v);
                    if (lane == 0) rsm[row] = rs;
                } else {
                    const f32x4* gp = (const f32x4*)gn + lane; f32x4* op = (f32x4*)(P.out + (size_t)row * D) + lane;
#pragma unroll
                    for (int j = 0; j < 8; ++j) op[64 * j] = v[j] * rs * gp[64 * j];
                }
            }
            if (layer == 0) {
                LAS float* scr = (LAS float*)(ldsl + wave * 16640);
                const size_t lo = (size_t)NE * D * D;
                convert_experts(P.ec_w_gate + lo, P.ec_w_up + lo, P.ec_w_down + lo, P.norm_ffn + D, Wgu, Wd, scr, gw, NGW, lane, G == 256 ? CV_DN : 0, G == 256 ? CV_ITEMS - CV_IN1 - CV_OUT - CV_TOPK : CV_ITEMS);
            }
        }
        if (layer == 0) GRID_BAR();
    }
#undef GRID_BAR
}

extern "C" void kernel_launch(void* const* d_in, const int* in_sizes, int n_in, void* d_out, int out_size, void* d_ws, size_t ws_size, hipStream_t stream) {
    static int grid = 0;
    if (grid == 0) {
        if (n_in != 19 || ws_size < WS_END) { fprintf(stderr, "kernel_launch: unexpected n_in %d / ws %zu (need %zu)\n", n_in, ws_size, (size_t)WS_END); grid = -1; return; }
        int dev = 0, cus = 0, per_cu = 0;
        if (hipGetDevice(&dev) != hipSuccess || hipDeviceGetAttribute(&cus, hipDeviceAttributeMultiprocessorCount, dev) != hipSuccess) { grid = -1; return; }
        if (hipFuncSetAttribute((const void*)fwd_kernel, hipFuncAttributeMaxDynamicSharedMemorySize, LDS_BYTES) != hipSuccess) { fprintf(stderr, "kernel_launch: hipFuncSetAttribute failed\n"); grid = -1; return; }
        if (hipOccupancyMaxActiveBlocksPerMultiprocessor(&per_cu, (const void*)fwd_kernel, NTHREADS, LDS_BYTES) != hipSuccess || per_cu < 1) { fprintf(stderr, "kernel_launch: occupancy query reports %d\n", per_cu); }
        (void)hipGetLastError();
        grid = cus;
    }
    if (grid < 0) return;
    if (hipMemsetAsync((char*)d_ws + WS_CTL, 0, CTL_BYTES, stream) != hipSuccess) return;
    Params p{};
    p.x = (const float*)d_in[0]; p.meta = (const float*)d_in[1]; p.norm_mix = (const float*)d_in[2]; p.norm_ffn = (const float*)d_in[3]; p.norm_final = (const float*)d_in[4];
    p.ab_w_in = (const float*)d_in[5]; p.ab_q_norm = (const float*)d_in[6]; p.ab_kv_norm = (const float*)d_in[7]; p.ab_w_uq = (const float*)d_in[8]; p.ab_w_ukv = (const float*)d_in[9];
    p.ab_rpb = (const float*)d_in[10]; p.ab_w_out = (const float*)d_in[11]; p.c_w_in = (const float*)d_in[12]; p.c_sinks = (const float*)d_in[13]; p.c_w_out = (const float*)d_in[14];
    p.ec_w_router = (const float*)d_in[15]; p.ec_w_gate = (const float*)d_in[16]; p.ec_w_up = (const float*)d_in[17]; p.ec_w_down = (const float*)d_in[18];
    p.out = (float*)d_out; p.ws = (unsigned char*)d_ws;
    hipLaunchKernelGGL(fwd_kernel, dim3(grid), dim3(NTHREADS), LDS_BYTES, stream, p);
    const hipError_t le = hipPeekAtLastError();
    if (le != hipSuccess) fprintf(stderr, "kernel_launch: launch failed: %s\n", hipGetErrorName(le));
}
```
